# Optimizing an MI355X kernel written in HIP

```python
import jax, jax.numpy as jnp
from jax import lax
import numpy as np

D_MODEL = 1024
BATCH = 2
SEQ = 8192
DEPTH = 2

HEAD_DIM = 64
BLK = 128
ROPE_THETA = 500000.0
ROT_DIM = HEAD_DIM // 4
EPS = 1e-6
SGU_GROUPS = 8
SGU_WIDTH = SGU_GROUPS * HEAD_DIM
SGU_CHUNK = 128
DIL_GROUPS = ((128, 1), (512, 4), (2048, 16))
DIL_HPG = 4
DIL_HEADS = DIL_HPG * len(DIL_GROUPS)
DIL_WIDTH = DIL_HEADS * HEAD_DIM
SWA_Q_HEADS = 16
SWA_KV_HEADS = 2
SWA_WINDOW = 128
N_GROUPS = 4
EXPERTS_PER_GROUP = 8
N_EXPERTS = N_GROUPS * EXPERTS_PER_GROUP
EXPERT_FF = 256
TOP_K = 2
MOE_BLOCK = 128
N_EVEN = (DEPTH + 1) // 2
N_ODD = DEPTH // 2
IN_EVEN = 2 * SGU_WIDTH + 3 * DIL_WIDTH
OUT_EVEN = SGU_WIDTH + DIL_HPG * HEAD_DIM
EVEN_SPLITS = (SGU_WIDTH, 2 * SGU_WIDTH, 2 * SGU_WIDTH + DIL_WIDTH, 2 * SGU_WIDTH + 2 * DIL_WIDTH)
IN_ODD = (SWA_Q_HEADS + 2 * SWA_KV_HEADS) * HEAD_DIM
OUT_ODD = SWA_Q_HEADS * HEAD_DIM
ODD_SPLITS = (SWA_Q_HEADS * HEAD_DIM, (SWA_Q_HEADS + SWA_KV_HEADS) * HEAD_DIM)

kernel_name = "hybrid_sgu_dilated_swa_sink_hmoe"


def rms_norm(x, g):
    xf = x.astype(jnp.float32)
    y = xf * lax.rsqrt(jnp.mean(xf * xf, axis=-1, keepdims=True) + EPS)
    return (y * g.astype(jnp.float32)).astype(x.dtype)


def rope_tables(positions):
    inv = ROPE_THETA ** (-jnp.arange(0, ROT_DIM, 2, dtype=jnp.float32) / ROT_DIM)
    ang = positions.astype(jnp.float32)[..., None] * inv
    return jnp.cos(ang)[:, :, None, :], jnp.sin(ang)[:, :, None, :]


def partial_rope(x, cos, sin):
    xf = x.astype(jnp.float32)
    half = ROT_DIM // 2
    x1, x2, rest = xf[..., :half], xf[..., half:ROT_DIM], xf[..., ROT_DIM:]
    out = jnp.concatenate([x1 * cos - x2 * sin, x2 * cos + x1 * sin, rest], axis=-1)
    return out.astype(x.dtype)


def qk_prep(t, g, cos, sin):
    return partial_rope(rms_norm(t, g), cos, sin)


def banded_attention(q, k, v, max_rel, sinks=None):
    B, L, H, Dh = q.shape
    Hk = k.shape[2]
    rep = H // Hk
    nb = L // BLK
    qb = q.reshape(B, nb, BLK, Hk, rep, Dh)
    kb = k.reshape(B, nb, BLK, Hk, Dh)
    vb = v.reshape(B, nb, BLK, Hk, Dh)
    pad = ((0, 0), (1, 0), (0, 0), (0, 0), (0, 0))
    kk = jnp.concatenate([jnp.pad(kb, pad)[:, :-1], kb], axis=2)
    vv = jnp.concatenate([jnp.pad(vb, pad)[:, :-1], vb], axis=2)
    s = jnp.einsum('bnqgrd,bnkgd->bngrqk', qb, kk,
                   preferred_element_type=jnp.float32) * (Dh ** -0.5)
    i = jnp.arange(BLK)[:, None]
    j = jnp.arange(2 * BLK)[None, :]
    rel = BLK + i - j
    kpos = jnp.arange(nb)[:, None, None] * BLK + j[None] - BLK
    mask = ((rel >= 0) & (rel <= max_rel))[None] & (kpos >= 0)
    s = jnp.where(mask[None, :, None, None], s, -jnp.inf)
    m = jnp.max(s, axis=-1, keepdims=True)
    if sinks is not None:
        sk = sinks.astype(jnp.float32).reshape(1, 1, Hk, rep, 1, 1)
        m = jnp.maximum(m, sk)
    p = jnp.exp(s - m)
    denom = jnp.sum(p, axis=-1, keepdims=True)
    if sinks is not None:
        denom = denom + jnp.exp(sk - m)
    o = jnp.einsum('bngrqk,bnkgd->bnqgrd', (p / denom).astype(v.dtype), vv)
    lse = (m + jnp.log(denom))[..., 0]
    lse = lse.transpose(0, 1, 4, 2, 3).reshape(B, L, H)
    return o.reshape(B, L, H, Dh), lse


def dilated_attention(q, k, v):
    B, S, _, Dh = q.shape
    outs, lses = [], []
    for g, (window, dil) in enumerate(DIL_GROUPS):
        hs = slice(g * DIL_HPG, (g + 1) * DIL_HPG)
        L = S // dil
        Lp = -(-L // BLK) * BLK

        def to_sub(t):
            t = t[:, :, hs].reshape(B, L, dil, DIL_HPG, Dh).transpose(0, 2, 1, 3, 4)
            t = t.reshape(B * dil, L, DIL_HPG, Dh)
            return jnp.pad(t, ((0, 0), (0, Lp - L), (0, 0), (0, 0)))

        o, lse = banded_attention(to_sub(q), to_sub(k), to_sub(v), window // dil)
        o = o[:, :L].reshape(B, dil, L, DIL_HPG, Dh).transpose(0, 2, 1, 3, 4).reshape(B, S, DIL_HPG, Dh)
        lse = lse[:, :L].reshape(B, dil, L, DIL_HPG).transpose(0, 2, 1, 3).reshape(B, S, DIL_HPG)
        outs.append(o)
        lses.append(lse)
    alpha = jax.nn.softmax(jnp.stack(lses), axis=0)
    return jnp.einsum('gbsh,gbshd->bshd', alpha.astype(q.dtype), jnp.stack(outs))


def spatial_gating(u, v, g_norm, w_s, b_s):
    B, S, _ = u.shape
    u = jax.nn.gelu(u)
    v = rms_norm(jax.nn.gelu(v), g_norm)
    vc = v.reshape(B, S // SGU_CHUNK, SGU_CHUNK, SGU_GROUPS, HEAD_DIM)
    w = w_s * jnp.tril(jnp.ones((SGU_CHUNK, SGU_CHUNK), dtype=w_s.dtype))
    s = jnp.einsum('gts,bcsgd->bctgd', w, vc) + b_s.T[:, :, None]
    return u * s.reshape(B, S, SGU_WIDTH)


def even_mixer(h, cos, sin, w_in, w_out, sgu_norm, sgu_w, sgu_b, qn, kn):
    B, S, _ = h.shape
    u, v, q, k, val = jnp.split(h @ w_in, EVEN_SPLITS, axis=-1)
    a = spatial_gating(u, v, sgu_norm, sgu_w, sgu_b)
    q = qk_prep(q.reshape(B, S, DIL_HEADS, HEAD_DIM), qn, cos, sin)
    k = qk_prep(k.reshape(B, S, DIL_HEADS, HEAD_DIM), kn, cos, sin)
    b = dilated_attention(q, k, val.reshape(B, S, DIL_HEADS, HEAD_DIM)).reshape(B, S, -1)
    return jnp.concatenate([a, b], axis=-1) @ w_out


def odd_mixer(h, cos, sin, w_in, w_out, qn, kn, sinks):
    B, S, _ = h.shape
    q, k, v = jnp.split(h @ w_in, ODD_SPLITS, axis=-1)
    q = qk_prep(q.reshape(B, S, SWA_Q_HEADS, HEAD_DIM), qn, cos, sin)
    k = qk_prep(k.reshape(B, S, SWA_KV_HEADS, HEAD_DIM), kn, cos, sin)
    v = v.reshape(B, S, SWA_KV_HEADS, HEAD_DIM)
    o, _ = banded_attention(q, k, v, SWA_WINDOW - 1, sinks)
    return o.reshape(B, S, -1) @ w_out


def hier_moe(h, w_rg, b_rg, w_re, b_re, w_gate, w_up, w_down):
    B, S, D = h.shape
    T = B * S
    x = h.reshape(T, D)
    xf = x.astype(jnp.float32)
    lg = xf @ w_rg.astype(jnp.float32) + b_rg.astype(jnp.float32)
    gi = jnp.argmax(lg, axis=-1)
    p_top = jnp.take_along_axis(jax.nn.softmax(lg, axis=-1), gi[:, None], axis=-1)
    le = jnp.einsum('td,gde->tge', xf, w_re.astype(jnp.float32)) + b_re.astype(jnp.float32)
    idx = jnp.broadcast_to(gi[:, None, None], (T, 1, EXPERTS_PER_GROUP))
    le = jnp.take_along_axis(le, idx, axis=1)[:, 0]
    top_p, top_i = lax.top_k(jax.nn.softmax(le, axis=-1), TOP_K)
    gate = p_top * top_p / jnp.sum(top_p, axis=-1, keepdims=True)
    eid = gi[:, None] * EXPERTS_PER_GROUP + top_i

    P = T * TOP_K
    flat_e = eid.reshape(-1)
    flat_tok = jnp.repeat(jnp.arange(T, dtype=jnp.int32), TOP_K)
    order = jnp.argsort(flat_e)
    se, stok, sw = flat_e[order], flat_tok[order], gate.reshape(-1)[order]
    counts = jnp.bincount(flat_e, length=N_EXPERTS)
    padded = (counts + MOE_BLOCK - 1) // MOE_BLOCK * MOE_BLOCK
    pad_end = jnp.cumsum(padded)
    pad_start = pad_end - padded
    start = jnp.cumsum(counts) - counts
    dest = pad_start[se] + (jnp.arange(P) - start[se])
    R = P + N_EXPERTS * MOE_BLOCK
    nblk = R // MOE_BLOCK
    buf = jnp.zeros((R, D), x.dtype).at[dest].set(x[stok])
    blk_e = jnp.clip(jnp.searchsorted(pad_end, jnp.arange(nblk) * MOE_BLOCK, side='right'),
                     0, N_EXPERTS - 1)

    def run_block(args):
        xb, e = args
        hid = jax.nn.silu(xb @ w_gate[e]) * (xb @ w_up[e])
        return hid @ w_down[e]

    out = lax.map(run_block, (buf.reshape(nblk, MOE_BLOCK, D), blk_e)).reshape(R, D)
    y = jax.ops.segment_sum(out[dest] * sw[:, None].astype(out.dtype), stok, num_segments=T)
    return y.reshape(B, S, D)


def setup_inputs(seed: int = 0) -> dict:
    key = jax.random.key(seed)
    ks = jax.random.split(key, 24)
    f32 = jnp.float32

    def nrm(k, shape, scale):
        return jax.random.normal(k, shape, f32) * scale

    def gain(k, shape):
        return 1.0 + 0.02 * jax.random.normal(k, shape, f32)

    x = jax.random.normal(ks[0], (BATCH, SEQ, D_MODEL), f32)
    positions = jnp.broadcast_to(jnp.arange(SEQ, dtype=jnp.int32), (BATCH, SEQ))
    return {
        "x": x,
        "positions": positions,
        "norm_mix": gain(ks[1], (DEPTH, D_MODEL)),
        "norm_ffn": gain(ks[2], (DEPTH, D_MODEL)),
        "w_in_even": nrm(ks[3], (N_EVEN, D_MODEL, IN_EVEN), D_MODEL ** -0.5),
        "w_out_even": nrm(ks[4], (N_EVEN, OUT_EVEN, D_MODEL), OUT_EVEN ** -0.5),
        "sgu_norm": gain(ks[5], (N_EVEN, SGU_WIDTH)),
        "sgu_w": nrm(ks[6], (N_EVEN, SGU_GROUPS, SGU_CHUNK, SGU_CHUNK), SGU_CHUNK ** -0.5),
        "sgu_b": 1.0 + 0.1 * jax.random.normal(ks[7], (N_EVEN, SGU_GROUPS, SGU_CHUNK), f32),
        "qn_dil": gain(ks[8], (N_EVEN, HEAD_DIM)),
        "kn_dil": gain(ks[9], (N_EVEN, HEAD_DIM)),
        "w_in_odd": nrm(ks[10], (N_ODD, D_MODEL, IN_ODD), D_MODEL ** -0.5),
        "w_out_odd": nrm(ks[11], (N_ODD, OUT_ODD, D_MODEL), OUT_ODD ** -0.5),
        "qn_swa": gain(ks[12], (N_ODD, HEAD_DIM)),
        "kn_swa": gain(ks[13], (N_ODD, HEAD_DIM)),
        "sinks": nrm(ks[14], (N_ODD, SWA_Q_HEADS), 0.5),
        "w_router_g": nrm(ks[15], (DEPTH, D_MODEL, N_GROUPS), D_MODEL ** -0.5),
        "b_router_g": nrm(ks[16], (DEPTH, N_GROUPS), 0.01),
        "w_router_e": nrm(ks[17], (DEPTH, N_GROUPS, D_MODEL, EXPERTS_PER_GROUP), D_MODEL ** -0.5),
        "b_router_e": nrm(ks[18], (DEPTH, N_GROUPS, EXPERTS_PER_GROUP), 0.01),
        "w_gate": nrm(ks[19], (DEPTH, N_EXPERTS, D_MODEL, EXPERT_FF), D_MODEL ** -0.5),
        "w_up": nrm(ks[20], (DEPTH, N_EXPERTS, D_MODEL, EXPERT_FF), D_MODEL ** -0.5),
        "w_down": nrm(ks[21], (DEPTH, N_EXPERTS, EXPERT_FF, D_MODEL), EXPERT_FF ** -0.5),
    }


def reference(x, positions, norm_mix, norm_ffn, w_in_even, w_out_even, sgu_norm, sgu_w, sgu_b,
              qn_dil, kn_dil, w_in_odd, w_out_odd, qn_swa, kn_swa, sinks,
              w_router_g, b_router_g, w_router_e, b_router_e, w_gate, w_up, w_down):
    cos, sin = rope_tables(positions)
    h = x
    for layer in range(DEPTH):
        i = layer // 2
        hn = rms_norm(h, norm_mix[layer])
        if layer % 2 == 0:
            h = h + even_mixer(hn, cos, sin, w_in_even[i], w_out_even[i], sgu_norm[i],
                               sgu_w[i], sgu_b[i], qn_dil[i], kn_dil[i])
        else:
            h = h + odd_mixer(hn, cos, sin, w_in_odd[i], w_out_odd[i], qn_swa[i], kn_swa[i],
                              sinks[i])
        h = h + hier_moe(rms_norm(h, norm_ffn[layer]), w_router_g[layer], b_router_g[layer],
                         w_router_e[layer], b_router_e[layer], w_gate[layer], w_up[layer],
                         w_down[layer])
    return h
```

```cpp
#include <hip/hip_runtime.h>
#include <stdint.h>
#include <math.h>

typedef unsigned short bf16;
__device__ __forceinline__ float bf2f(bf16 v) { return __uint_as_float((unsigned)v << 16); }
__device__ __forceinline__ bf16 f2bf(float f) { unsigned u = __float_as_uint(f); return (bf16)((u + 0x7fffu + ((u >> 16) & 1u)) >> 16); }

constexpr int T = 16384, SEQ = 8192, D = 1024;
constexpr int IN0 = 3328, OUT0K = 768, IN1 = 1280;
constexpr int NE = 32, FF = 256;
constexpr float EPS = 1e-6f;
constexpr float QSCALE = 0.125f * 1.4426950408889634f;
constexpr int SLOT_CAP = 40960;

constexpr size_t MiB = 1u << 20;
constexpr size_t WS_CTL = 0;
constexpr size_t WS_RSTD = 1 * MiB;
constexpr size_t WS_VSS = WS_RSTD + 65536;
constexpr size_t WS_CS = 2 * MiB;
constexpr size_t WS_EID = 3 * MiB;
constexpr size_t WS_GW = WS_EID + 131072;
constexpr size_t WS_ELIST = 4 * MiB;
constexpr size_t WS_HB = 70 * MiB;
constexpr size_t WS_Y = 102 * MiB;
constexpr size_t WS_YP = 102 * MiB;
constexpr size_t WS_HID = 166 * MiB;
constexpr size_t WS_Y1 = 166 * MiB;
constexpr size_t WS_A2 = 206 * MiB;

__global__ void k_rowprep(const float* __restrict__ src, bf16* __restrict__ hb, float* __restrict__ rstd) {
    const int gw = (blockIdx.x * blockDim.x + threadIdx.x) >> 6, lane = threadIdx.x & 63, nw = (gridDim.x * blockDim.x) >> 6;
    for (int r = gw; r < T; r += nw) {
        const float* p = src + (size_t)r * D; float s = 0.f;
        for (int c = lane; c < D; c += 64) { float v = p[c]; s += v * v; hb[(size_t)r * D + c] = f2bf(v); }
        for (int o = 1; o < 64; o <<= 1) s += __shfl_xor(s, o);
        if (lane == 0) rstd[r] = 1.0f / sqrtf(s * (1.0f / D) + EPS);
    }
}
__global__ void k_rope_tab(const int* __restrict__ pos, float* __restrict__ cs, float* __restrict__ sn) {
    const int i = blockIdx.x * blockDim.x + threadIdx.x; if (i >= T * 8) return;
    const int t = i >> 3, f = i & 7;
    const float inv = powf(500000.0f, -(float)f / 8.0f);
    const float ang = (float)pos[t] * inv;
    const double rev = (double)ang * 0.15915494309189535;
    const float fr = (float)(rev - floor(rev));
    cs[i] = __builtin_amdgcn_cosf(fr); sn[i] = __builtin_amdgcn_sinf(fr);
}
__global__ void __launch_bounds__(256) k_gemm_naive(const bf16* __restrict__ A, int lda, const float* __restrict__ W, int N, int K, const float* __restrict__ gain,
                                                    const float* __restrict__ rowscale, const float* __restrict__ resid, bf16* __restrict__ outb, int ldo, float* __restrict__ outf) {
    __shared__ float sA[16][65], sB[16][65];
    const int tx = threadIdx.x & 15, ty = threadIdx.x >> 4, m0 = blockIdx.y * 64, n0 = blockIdx.x * 64;
    float acc[4][4] = {};
    for (int k0 = 0; k0 < K; k0 += 16) {
        for (int e = threadIdx.x; e < 1024; e += 256) { const int r = e >> 4, c = e & 15; sA[c][r] = bf2f(A[(size_t)(m0 + r) * lda + k0 + c]); }
        for (int e = threadIdx.x; e < 1024; e += 256) { const int r = e >> 6, c = e & 63; sB[r][c] = W[(size_t)(k0 + r) * N + n0 + c] * (gain ? gain[k0 + r] : 1.0f); }
        __syncthreads();
#pragma unroll
        for (int k = 0; k < 16; ++k) {
            float a[4], b[4];
#pragma unroll
            for (int i = 0; i < 4; ++i) { a[i] = sA[k][ty * 4 + i]; b[i] = sB[k][tx * 4 + i]; }
#pragma unroll
            for (int i = 0; i < 4; ++i)
#pragma unroll
                for (int j = 0; j < 4; ++j) acc[i][j] += a[i] * b[j];
        }
        __syncthreads();
    }
    for (int i = 0; i < 4; ++i) for (int j = 0; j < 4; ++j) {
        const int m = m0 + ty * 4 + i, n = n0 + tx * 4 + j; float v = acc[i][j];
        if (rowscale) v *= rowscale[m];
        if (resid) v += resid[(size_t)m * N + n];
        if (outb) outb[(size_t)m * ldo + n] = f2bf(v);
        if (outf) outf[(size_t)m * N + n] = v;
    }
}
__device__ __forceinline__ float gelu_tanh(float x) { const float u = 0.7978845608028654f * (x + 0.044715f * x * x * x); return 0.5f * x * (1.0f + tanhf(u)); }
__global__ void __launch_bounds__(256) k_post0(bf16* __restrict__ Y, float* __restrict__ vss, const float* __restrict__ cs, const float* __restrict__ sn,
                                               const float* __restrict__ qn, const float* __restrict__ kn) {
    __shared__ float red[256]; __shared__ float hv[1536];
    const int t = blockIdx.x, tid = threadIdx.x; bf16* y = Y + (size_t)t * IN0;
    float ss = 0.f;
    for (int c = tid; c < 1024; c += 256) { float g = gelu_tanh(bf2f(y[c])); bf16 gb = f2bf(g); y[c] = gb; if (c >= 512) { float gr = bf2f(gb); ss += gr * gr; } }
    red[tid] = ss; __syncthreads();
    for (int o = 128; o > 0; o >>= 1) { if (tid < o) red[tid] += red[tid + o]; __syncthreads(); }
    if (tid < 8) vss[(size_t)t * 8 + tid] = (tid == 0) ? red[0] : 0.f;
    __syncthreads();
    for (int c = tid; c < 1536; c += 256) hv[c] = bf2f(y[1024 + c]);
    __syncthreads();
    for (int c = tid; c < 1536; c += 256) {
        const int h = c >> 6, d = c & 63; const bool isq = h < 12; const float* gn = isq ? qn : kn;
        float s = 0.f; for (int j = 0; j < 64; ++j) { float v = hv[h * 64 + j]; s += v * v; }
        const float rs = 1.0f / sqrtf(s * (1.0f / 64.0f) + EPS);
        float o = hv[c] * rs * gn[d];
        if (d < 16) { const int f = d & 7; const float co = cs[t * 8 + f], si = sn[t * 8 + f];
            const float x1 = hv[h * 64 + f] * rs * gn[f], x2 = hv[h * 64 + 8 + f] * rs * gn[8 + f];
            o = (d < 8) ? (x1 * co - x2 * si) : (x2 * co + x1 * si); }
        if (isq) o *= QSCALE;
        y[1024 + c] = f2bf(o);
    }
}
__global__ void __launch_bounds__(256) k_post1(bf16* __restrict__ Y, const float* __restrict__ cs, const float* __restrict__ sn, const float* __restrict__ qn, const float* __restrict__ kn) {
    __shared__ float hv[1152];
    const int t = blockIdx.x, tid = threadIdx.x; bf16* y = Y + (size_t)t * IN1;
    for (int c = tid; c < 1152; c += 256) hv[c] = bf2f(y[c]);
    __syncthreads();
    for (int c = tid; c < 1152; c += 256) {
        const int h = c >> 6, d = c & 63; const bool isq = h < 16; const float* gn = isq ? qn : kn;
        float s = 0.f; for (int j = 0; j < 64; ++j) { float v = hv[h * 64 + j]; s += v * v; }
        const float rs = 1.0f / sqrtf(s * (1.0f / 64.0f) + EPS);
        float o = hv[c] * rs * gn[d];
        if (d < 16) { const int f = d & 7; const float co = cs[t * 8 + f], si = sn[t * 8 + f];
            const float x1 = hv[h * 64 + f] * rs * gn[f], x2 = hv[h * 64 + 8 + f] * rs * gn[8 + f];
            o = (d < 8) ? (x1 * co - x2 * si) : (x2 * co + x1 * si); }
        if (isq) o *= QSCALE;
        y[c] = f2bf(o);
    }
}
__global__ void k_sgu_naive(const bf16* __restrict__ Y, const float* __restrict__ vss, const float* __restrict__ gn, const float* __restrict__ w, const float* __restrict__ bs, bf16* __restrict__ A2) {
    const int i = blockIdx.x * blockDim.x + threadIdx.x; if (i >= T * 512) return;
    const int row = i >> 9, ch = i & 511, g = ch >> 6, tt = row & 127, r0 = row - tt;
    float acc = 0.f;
    for (int s = 0; s <= tt; ++s) {
        const int rs_ = r0 + s; float sum = 0.f; for (int j = 0; j < 8; ++j) sum += vss[(size_t)rs_ * 8 + j];
        const float rstd = 1.0f / sqrtf(sum * (1.0f / 512.0f) + EPS);
        const float v = bf2f(f2bf(bf2f(Y[(size_t)rs_ * IN0 + 512 + ch]) * rstd * gn[ch]));
        acc += bf2f(f2bf(w[(g * 128 + tt) * 128 + s])) * v;
    }
    acc += bs[g * 128 + tt];
    A2[(size_t)row * OUT0K + ch] = f2bf(bf2f(Y[(size_t)row * IN0 + ch]) * acc);
}
__global__ void k_dil_naive(const bf16* __restrict__ Y, bf16* __restrict__ A2) {
    const int i = (blockIdx.x * blockDim.x + threadIdx.x) >> 6, d = threadIdx.x & 63; if (i >= T * 4) return;
    const int row = i >> 2, j = i & 3, b = row / SEQ, t = row % SEQ;
    float m = -INFINITY, l = 0.f, o = 0.f;
    for (int g = 0; g < 3; ++g) {
        const int dil = (g == 0) ? 1 : (g == 1 ? 4 : 16), h = g * 4 + j;
        const float q = bf2f(Y[(size_t)row * IN0 + 1024 + h * 64 + d]);
        for (int n = 0; n <= 128; ++n) {
            const int tk = t - n * dil; if (tk < 0) break;
            const size_t kr = (size_t)(b * SEQ + tk) * IN0;
            float s = q * bf2f(Y[kr + 1792 + h * 64 + d]);
            for (int x = 1; x < 64; x <<= 1) s += __shfl_xor(s, x);
            const float mn = fmaxf(m, s), a = exp2f(m - mn), p = exp2f(s - mn);
            l = l * a + p; o = o * a + p * bf2f(Y[kr + 2560 + h * 64 + d]);
            m = mn;
        }
    }
    A2[(size_t)row * OUT0K + 512 + j * 64 + d] = f2bf(o / l);
}
__global__ void k_swa_naive(const bf16* __restrict__ Y, const float* __restrict__ sinks, bf16* __restrict__ O) {
    const int i = (blockIdx.x * blockDim.x + threadIdx.x) >> 6, d = threadIdx.x & 63; if (i >= T * 16) return;
    const int row = i >> 4, h = i & 15, kvh = h >> 3, b = row / SEQ, t = row % SEQ;
    const float q = bf2f(Y[(size_t)row * IN1 + h * 64 + d]);
    float m = sinks[h] * 1.4426950408889634f, l = 1.0f, o = 0.f;
    for (int n = 0; n < 128; ++n) {
        const int tk = t - n; if (tk < 0) break;
        const size_t kr = (size_t)(b * SEQ + tk) * IN1;
        float s = q * bf2f(Y[kr + 1024 + kvh * 64 + d]);
        for (int x = 1; x < 64; x <<= 1) s += __shfl_xor(s, x);
        const float mn = fmaxf(m, s), a = exp2f(m - mn), p = exp2f(s - mn);
        l = l * a + p; o = o * a + p * bf2f(Y[kr + 1152 + kvh * 64 + d]);
        m = mn;
    }
    O[(size_t)row * D + h * 64 + d] = f2bf(o / l);
}
__global__ void k_router(const float* __restrict__ h, const float* __restrict__ gf, const float* __restrict__ wrg, const float* __restrict__ brg, const float* __restrict__ wre, const float* __restrict__ bre,
                         bf16* __restrict__ hb, float* __restrict__ rstd, int* __restrict__ eid, float* __restrict__ gw, int* __restrict__ counts, int* __restrict__ elist) {
    const int gwv = (blockIdx.x * blockDim.x + threadIdx.x) >> 6, lane = threadIdx.x & 63, nw = (gridDim.x * blockDim.x) >> 6;
    for (int r = gwv; r < T; r += nw) {
        const float* p = h + (size_t)r * D; float s = 0.f;
        for (int c = lane; c < D; c += 64) { float v = p[c]; s += v * v; hb[(size_t)r * D + c] = f2bf(v); }
        for (int o = 1; o < 64; o <<= 1) s += __shfl_xor(s, o);
        const float rs = 1.0f / sqrtf(s * (1.0f / D) + EPS);
        float lg[4] = {0.f, 0.f, 0.f, 0.f};
        for (int c = lane; c < D; c += 64) { const float xn = p[c] * rs * gf[c]; for (int g = 0; g < 4; ++g) lg[g] += xn * wrg[c * 4 + g]; }
        for (int g = 0; g < 4; ++g) { for (int o = 1; o < 64; o <<= 1) lg[g] += __shfl_xor(lg[g], o); lg[g] += brg[g]; }
        int gi = 0; for (int g = 1; g < 4; ++g) if (lg[g] > lg[gi]) gi = g;
        float zs = 0.f; for (int g = 0; g < 4; ++g) zs += expf(lg[g] - lg[gi]);
        const float ptop = 1.0f / zs;
        float le[8] = {0.f, 0.f, 0.f, 0.f, 0.f, 0.f, 0.f, 0.f};
        for (int c = lane; c < D; c += 64) { const float xn = p[c] * rs * gf[c]; for (int e = 0; e < 8; ++e) le[e] += xn * wre[((size_t)gi * D + c) * 8 + e]; }
        for (int e = 0; e < 8; ++e) { for (int o = 1; o < 64; o <<= 1) le[e] += __shfl_xor(le[e], o); le[e] += bre[gi * 8 + e]; }
        int i0 = 0; for (int e = 1; e < 8; ++e) if (le[e] > le[i0]) i0 = e;
        int i1 = (i0 == 0) ? 1 : 0; for (int e = 0; e < 8; ++e) if (e != i0 && le[e] > le[i1]) i1 = e;
        const float r1 = expf(le[i1] - le[i0]); const float g0 = ptop / (1.0f + r1), g1 = ptop * r1 / (1.0f + r1);
        if (lane == 0) {
            rstd[r] = rs; const int e0 = gi * 8 + i0, e1 = gi * 8 + i1;
            eid[r * 2] = e0; eid[r * 2 + 1] = e1; gw[r * 2] = g0; gw[r * 2 + 1] = g1;
            const int p0 = atomicAdd(&counts[e0], 1); elist[e0 * T + p0] = r * 2;
            const int p1 = atomicAdd(&counts[e1], 1); elist[e1 * T + p1] = r * 2 + 1;
        }
    }
}
__device__ __forceinline__ bool slot_lookup(const int* counts, int slot, int& e, int& pos) {
    int base = 0;
    for (int x = 0; x < NE; ++x) { const int c = counts[x], pc = (c + 255) & ~255; if (slot < base + pc) { e = x; pos = slot - base; return pos < c; } base += pc; }
    e = -1; pos = 0; return false;
}
__global__ void __launch_bounds__(256) k_gateup_naive(const bf16* __restrict__ hb, const float* __restrict__ rstd, const float* __restrict__ gf, const float* __restrict__ wg, const float* __restrict__ wu,
                                                      const int* __restrict__ counts, const int* __restrict__ elist, bf16* __restrict__ hid) {
    __shared__ float xs[1024];
    int e, pos; if (!slot_lookup(counts, blockIdx.x, e, pos)) return;
    const int pair = elist[e * T + pos], t = pair >> 1, j = threadIdx.x;
    for (int c = j; c < D; c += 256) xs[c] = bf2f(hb[(size_t)t * D + c]);
    __syncthreads();
    float g = 0.f, u = 0.f; const float* pg = wg + (size_t)e * D * FF + j; const float* pu = wu + (size_t)e * D * FF + j;
    for (int k = 0; k < D; ++k) { const float gk = gf[k]; g += xs[k] * bf2f(f2bf(pg[(size_t)k * FF] * gk)); u += xs[k] * bf2f(f2bf(pu[(size_t)k * FF] * gk)); }
    const float rs = rstd[t]; g *= rs; u *= rs;
    hid[(size_t)blockIdx.x * FF + j] = f2bf(g / (1.0f + expf(-g)) * u);
}
__global__ void __launch_bounds__(256) k_down_naive(const bf16* __restrict__ hid, const float* __restrict__ wd, const float* __restrict__ gw, const int* __restrict__ counts, const int* __restrict__ elist, bf16* __restrict__ yp) {
    __shared__ float hs[256];
    int e, pos; if (!slot_lookup(counts, blockIdx.x, e, pos)) return;
    const int pair = elist[e * T + pos];
    hs[threadIdx.x] = bf2f(hid[(size_t)blockIdx.x * FF + threadIdx.x]);
    __syncthreads();
    const float gwt = gw[pair];
    for (int n = threadIdx.x; n < D; n += 256) {
        float a = 0.f; const float* p = wd + (size_t)e * FF * D + n;
        for (int k = 0; k < FF; ++k) a += hs[k] * bf2f(f2bf(p[(size_t)k * D]));
        yp[(size_t)pair * D + n] = f2bf(a * gwt);
    }
}
__global__ void k_combine(float* __restrict__ h, const bf16* __restrict__ yp, bf16* __restrict__ hb, float* __restrict__ rstd) {
    const int gwv = (blockIdx.x * blockDim.x + threadIdx.x) >> 6, lane = threadIdx.x & 63, nw = (gridDim.x * blockDim.x) >> 6;
    for (int r = gwv; r < T; r += nw) {
        float s = 0.f;
        for (int c = lane; c < D; c += 64) { const float v = h[(size_t)r * D + c] + bf2f(yp[(size_t)(2 * r) * D + c]) + bf2f(yp[(size_t)(2 * r + 1) * D + c]);
            h[(size_t)r * D + c] = v; s += v * v; if (hb) hb[(size_t)r * D + c] = f2bf(v); }
        for (int o = 1; o < 64; o <<= 1) s += __shfl_xor(s, o);
        if (rstd && lane == 0) rstd[r] = 1.0f / sqrtf(s * (1.0f / D) + EPS);
    }
}

extern "C" void kernel_launch(void* const* d_in, const int* in_sizes, int n_in, void* d_out, int out_size, void* d_ws, size_t ws_size, hipStream_t stream) {
    const float* x = (const float*)d_in[0]; const int* positions = (const int*)d_in[1];
    const float* norm_mix = (const float*)d_in[2]; const float* norm_ffn = (const float*)d_in[3];
    const float* w_in_even = (const float*)d_in[4]; const float* w_out_even = (const float*)d_in[5];
    const float* sgu_norm = (const float*)d_in[6]; const float* sgu_w = (const float*)d_in[7]; const float* sgu_b = (const float*)d_in[8];
    const float* qn_dil = (const float*)d_in[9]; const float* kn_dil = (const float*)d_in[10];
    const float* w_in_odd = (const float*)d_in[11]; const float* w_out_odd = (const float*)d_in[12];
    const float* qn_swa = (const float*)d_in[13]; const float* kn_swa = (const float*)d_in[14]; const float* sinks = (const float*)d_in[15];
    const float* w_rg = (const float*)d_in[16]; const float* b_rg = (const float*)d_in[17]; const float* w_re = (const float*)d_in[18]; const float* b_re = (const float*)d_in[19];
    const float* w_gate = (const float*)d_in[20]; const float* w_up = (const float*)d_in[21]; const float* w_down = (const float*)d_in[22];
    float* out = (float*)d_out; unsigned char* ws = (unsigned char*)d_ws;
    int* counts = (int*)(ws + WS_CTL); float* rstd = (float*)(ws + WS_RSTD); float* vss = (float*)(ws + WS_VSS);
    float* cs = (float*)(ws + WS_CS); float* sn = cs + T * 8;
    int* eid = (int*)(ws + WS_EID); float* gw = (float*)(ws + WS_GW); int* elist = (int*)(ws + WS_ELIST);
    bf16* HB = (bf16*)(ws + WS_HB); bf16* Y = (bf16*)(ws + WS_Y); bf16* YP = (bf16*)(ws + WS_YP); bf16* HID = (bf16*)(ws + WS_HID); bf16* Y1 = (bf16*)(ws + WS_Y1); bf16* A2 = (bf16*)(ws + WS_A2);

    hipMemsetAsync(ws + WS_CTL, 0, MiB, stream);
    k_rope_tab<<<T * 8 / 256, 256, 0, stream>>>(positions, cs, sn);
    k_rowprep<<<2048, 256, 0, stream>>>(x, HB, rstd);
    k_gemm_naive<<<dim3(IN0 / 64, T / 64), 256, 0, stream>>>(HB, D, w_in_even, IN0, D, norm_mix, rstd, nullptr, Y, IN0, nullptr);
    k_post0<<<T, 256, 0, stream>>>(Y, vss, cs, sn, qn_dil, kn_dil);
    k_sgu_naive<<<T * 512 / 256, 256, 0, stream>>>(Y, vss, sgu_norm, sgu_w, sgu_b, A2);
    k_dil_naive<<<T * 4 / 4, 256, 0, stream>>>(Y, A2);
    k_gemm_naive<<<dim3(D / 64, T / 64), 256, 0, stream>>>(A2, OUT0K, w_out_even, D, OUT0K, nullptr, nullptr, x, nullptr, 0, out);
    k_router<<<2048, 256, 0, stream>>>(out, norm_ffn, w_rg, b_rg, w_re, b_re, HB, rstd, eid, gw, counts, elist);
    k_gateup_naive<<<SLOT_CAP, 256, 0, stream>>>(HB, rstd, norm_ffn, w_gate, w_up, counts, elist, HID);
    k_down_naive<<<SLOT_CAP, 256, 0, stream>>>(HID, w_down, gw, counts, elist, YP);
    k_combine<<<2048, 256, 0, stream>>>(out, YP, HB, rstd);
    k_gemm_naive<<<dim3(IN1 / 64, T / 64), 256, 0, stream>>>(HB, D, w_in_odd, IN1, D, norm_mix + D, rstd, nullptr, Y1, IN1, nullptr);
    k_post1<<<T, 256, 0, stream>>>(Y1, cs, sn, qn_swa, kn_swa);
    k_swa_naive<<<T * 16 / 4, 256, 0, stream>>>(Y1, sinks, A2);
    k_gemm_naive<<<dim3(D / 64, T / 64), 256, 0, stream>>>(A2, D, w_out_odd, D, D, nullptr, nullptr, out, nullptr, 0, out);
    hipMemsetAsync(ws + WS_CTL, 0, 4096, stream);
    k_router<<<2048, 256, 0, stream>>>(out, norm_ffn + D, w_rg + D * 4, b_rg + 4, w_re + (size_t)4 * D * 8, b_re + 32, HB, rstd, eid, gw, counts, elist);
    const size_t EW = (size_t)NE * D * FF;
    k_gateup_naive<<<SLOT_CAP, 256, 0, stream>>>(HB, rstd, norm_ffn + D, w_gate + EW, w_up + EW, counts, elist, HID);
    k_down_naive<<<SLOT_CAP, 256, 0, stream>>>(HID, w_down + EW, gw, counts, elist, YP);
    k_combine<<<2048, 256, 0, stream>>>(out, YP, nullptr, nullptr);
}
```

```cpp
#include <hip/hip_runtime.h>
#include <stdint.h>
#include <math.h>
#include <cstdio>

typedef unsigned short bf16;
__device__ __forceinline__ float bf2f(bf16 v) { return __uint_as_float((unsigned)v << 16); }
__device__ __forceinline__ bf16 f2bf(float f) { unsigned u = __float_as_uint(f); return (bf16)((u + 0x7fffu + ((u >> 16) & 1u)) >> 16); }

constexpr int T = 16384, SEQ = 8192, D = 1024;
constexpr int IN0 = 3328, OUT0K = 768, IN1 = 1280;
constexpr int NE = 32, FF = 256;
constexpr float EPS = 1e-6f;
constexpr float QSCALE = 0.125f * 1.4426950408889634f;
constexpr int SLOT_CAP = 40960;

constexpr size_t MiB = 1u << 20;
constexpr size_t WS_CTL = 0;
constexpr size_t WS_RSTD = 1 * MiB;
constexpr size_t WS_VSS = WS_RSTD + 65536;
constexpr size_t WS_CS = 2 * MiB;
constexpr size_t WS_EID = 3 * MiB;
constexpr size_t WS_GW = WS_EID + 131072;
constexpr size_t WS_ELIST = 4 * MiB;
constexpr size_t WS_HB = 70 * MiB;
constexpr size_t WS_Y = 102 * MiB;
constexpr size_t WS_YP = 102 * MiB;
constexpr size_t WS_HID = 166 * MiB;
constexpr size_t WS_Y1 = 166 * MiB;
constexpr size_t WS_A2 = 206 * MiB;


#define LAS __attribute__((address_space(3)))
constexpr int NTHR = 512, NWAVES = 8;
constexpr int LDS_BYTES = 147456;
constexpr int LDS_MISC = 131072;
constexpr int CW_BAR = 4096;

#define XB_TMO      128
#define XB_XCNT(j)  (256  + 64 * (j))
#define XB_XSUB(j)  (1280 + 64 * (j))
#define XB_XGEN(j)  (2304 + 64 * (j))
#define XB_TOP      3328
#define XB_TOPGEN   3392
#define XCD_BAR_WORDS 3456
#define XB_SPIN_CAP (1u << 20)
__device__ __forceinline__ unsigned xb_ld(unsigned* p)              { return __hip_atomic_load(p, __ATOMIC_RELAXED, __HIP_MEMORY_SCOPE_AGENT); }
__device__ __forceinline__ unsigned xb_add(unsigned* p, unsigned v) { return __hip_atomic_fetch_add(p, v, __ATOMIC_RELAXED, __HIP_MEMORY_SCOPE_AGENT); }
__device__ __forceinline__ unsigned xb_xcc_id() { return (unsigned)__builtin_amdgcn_s_getreg((3 << 11) | 20) & 0xFu; }
#define XB_SPIN(cond, bar) do { unsigned _sp = 0; while (cond) { __builtin_amdgcn_s_sleep(1); \
    if ((++_sp & 255u) == 0u) { if (xb_ld(&(bar)[XB_TMO])) break; if (_sp > XB_SPIN_CAP) { atomicAdd(&(bar)[XB_TMO], 1u); break; } } } } while (0)
struct XcdBarrier { unsigned* bar; unsigned x; volatile LAS unsigned* st; };
__device__ __forceinline__ XcdBarrier xcd_barrier_post(unsigned* bar, volatile LAS unsigned* st) {
    XcdBarrier b; b.bar = bar; b.x = xb_xcc_id(); b.st = st;
    if (threadIdx.x == 0) (void)xb_add(&bar[XB_XCNT(b.x)], 1u);
    return b;
}
__device__ __forceinline__ void xcd_barrier_complete(unsigned* bar, unsigned x, unsigned& nloc, unsigned& nx) {
    const unsigned G = gridDim.x * gridDim.y * gridDim.z;
    unsigned sum, cnt, mine, sp = 0u;
    for (;;) {
        sum = 0u; cnt = 0u; mine = 0u;
#pragma unroll
        for (unsigned j = 0; j < 16; ++j) { const unsigned c = xb_ld(&bar[XB_XCNT(j)]); sum += c; cnt += (c > 0u) ? 1u : 0u; mine = (j == x) ? c : mine; }
        if (sum == G) break;
        __builtin_amdgcn_s_sleep(1);
        if ((++sp & 255u) == 0u) { if (xb_ld(&bar[XB_TMO])) break; if (sp > XB_SPIN_CAP) { atomicAdd(&bar[XB_TMO], 1u); break; } }
    }
    nloc = mine > 0u ? mine : 1u; nx = cnt > 0u ? cnt : 1u;
}
__device__ __forceinline__ void xcd_barrier(const XcdBarrier& b) {
    asm volatile("s_waitcnt vmcnt(0)" ::: "memory");
    __syncthreads();
    if (threadIdx.x == 0) {
        unsigned* bar = b.bar;
        __builtin_amdgcn_s_waitcnt(0);
        unsigned nloc = b.st[0], nx = b.st[1];
        if (nloc == 0u) { xcd_barrier_complete(bar, b.x, nloc, nx); b.st[0] = nloc; b.st[1] = nx; }
        const unsigned old = xb_add(&bar[XB_XSUB(b.x)], 1u);
        const unsigned gen = old / nloc;
        if (old + 1u == (gen + 1u) * nloc) {
            __builtin_amdgcn_fence(__ATOMIC_RELEASE, "agent");
            asm volatile("s_waitcnt vmcnt(0)" ::: "memory");
            const unsigned og = xb_add(&bar[XB_TOP], 1u);
            const unsigned tg = og / nx;
            if (og + 1u == (tg + 1u) * nx) xb_add(&bar[XB_TOPGEN], 1u);
            else XB_SPIN(xb_ld(&bar[XB_TOPGEN]) == tg, bar);
            __builtin_amdgcn_fence(__ATOMIC_ACQUIRE, "agent");
            xb_add(&bar[XB_XGEN(b.x)], 1u);
            asm volatile("s_waitcnt vmcnt(0)" ::: "memory");
        } else {
            XB_SPIN(xb_ld(&bar[XB_XGEN(b.x)]) == gen, bar);
            __builtin_amdgcn_fence(__ATOMIC_ACQUIRE, "agent");
            asm volatile("s_waitcnt vmcnt(0)" ::: "memory");
        }
    }
    __syncthreads();
}

struct Args {
    const float *x; const int* positions; const float *norm_mix, *norm_ffn, *w_in_even, *w_out_even, *sgu_norm, *sgu_w, *sgu_b, *qn_dil, *kn_dil,
        *w_in_odd, *w_out_odd, *qn_swa, *kn_swa, *sinks, *w_rg, *b_rg, *w_re, *b_re, *w_gate, *w_up, *w_down;
    float* out; unsigned char* ws;
};

__device__ __forceinline__ float gelu_tanh(float x) { const float u = 0.7978845608028654f * (x + 0.044715f * x * x * x); return 0.5f * x * (1.0f + tanhf(u)); }
__device__ void n_rowprep(const float* __restrict__ src, bf16* __restrict__ hb, float* __restrict__ rstd) {
    const int gw = blockIdx.x * NWAVES + (threadIdx.x >> 6), lane = threadIdx.x & 63, nw = gridDim.x * NWAVES;
    for (int r = gw; r < T; r += nw) {
        const float* p = src + (size_t)r * D; float s = 0.f;
        for (int c = lane; c < D; c += 64) { float v = p[c]; s += v * v; hb[(size_t)r * D + c] = f2bf(v); }
        for (int o = 1; o < 64; o <<= 1) s += __shfl_xor(s, o);
        if (lane == 0) rstd[r] = 1.0f / sqrtf(s * (1.0f / D) + EPS);
    }
}
__device__ void n_rope_tab(const int* __restrict__ pos, float* __restrict__ cs, float* __restrict__ sn) {
    for (int i = blockIdx.x * NTHR + threadIdx.x; i < T * 8; i += gridDim.x * NTHR) {
        const int t = i >> 3, f = i & 7;
        const float inv = powf(500000.0f, -(float)f / 8.0f);
        const float ang = (float)pos[t] * inv;
        const double rev = (double)ang * 0.15915494309189535;
        const float fr = (float)(rev - floor(rev));
        cs[i] = __builtin_amdgcn_cosf(fr); sn[i] = __builtin_amdgcn_sinf(fr);
    }
}
__device__ void n_gemm(LAS unsigned char* lds, const bf16* __restrict__ A, int lda, const float* __restrict__ W, int M, int N, int K, const float* __restrict__ gain,
                       const float* __restrict__ rowscale, const float* resid, bf16* __restrict__ outb, int ldo, float* outf) {
    const int half = threadIdx.x >> 8, tid = threadIdx.x & 255;
    LAS float* sA = (LAS float*)(lds + half * 16384); LAS float* sB = sA + 16 * 65;
    const int tx = tid & 15, ty = tid >> 4, ntn = N / 64, nvb = ntn * (M / 64);
    for (int it = 0; (it * (int)gridDim.x) * 2 < nvb; ++it) {
        const int vb = (it * gridDim.x + blockIdx.x) * 2 + half; const bool ok = vb < nvb;
        const int m0 = ok ? (vb / ntn) * 64 : 0, n0 = ok ? (vb % ntn) * 64 : 0;
        float acc[4][4] = {};
        for (int k0 = 0; k0 < K; k0 += 16) {
            for (int e = tid; e < 1024; e += 256) { const int r = e >> 4, c = e & 15; sA[c * 65 + r] = bf2f(A[(size_t)(m0 + r) * lda + k0 + c]); }
            for (int e = tid; e < 1024; e += 256) { const int r = e >> 6, c = e & 63; sB[r * 65 + c] = W[(size_t)(k0 + r) * N + n0 + c] * (gain ? gain[k0 + r] : 1.0f); }
            __syncthreads();
#pragma unroll
            for (int k = 0; k < 16; ++k) {
                float a[4], b[4];
#pragma unroll
                for (int i = 0; i < 4; ++i) { a[i] = sA[k * 65 + ty * 4 + i]; b[i] = sB[k * 65 + tx * 4 + i]; }
#pragma unroll
                for (int i = 0; i < 4; ++i)
#pragma unroll
                    for (int j = 0; j < 4; ++j) acc[i][j] += a[i] * b[j];
            }
            __syncthreads();
        }
        if (ok)
#pragma unroll
        for (int i = 0; i < 4; ++i)
#pragma unroll
            for (int j = 0; j < 4; ++j) {
            const int m = m0 + ty * 4 + i, n = n0 + tx * 4 + j; float v = acc[i][j];
            if (rowscale) v *= rowscale[m];
            if (resid) v += resid[(size_t)m * N + n];
            if (outb) outb[(size_t)m * ldo + n] = f2bf(v);
            if (outf) outf[(size_t)m * N + n] = v;
        }
    }
}
__device__ void n_post(LAS unsigned char* lds, bf16* __restrict__ Y, int ld, int ngelu, int nq, int nk, float* __restrict__ vss, const float* __restrict__ cs, const float* __restrict__ sn,
                       const float* __restrict__ qn, const float* __restrict__ kn) {
    const int half = threadIdx.x >> 8, tid = threadIdx.x & 255;
    LAS float* red = (LAS float*)(lds + half * 16384); LAS float* hv = red + 256;
    const int nqk = (nq + nk) * 64;
    for (int it = 0; it * (int)gridDim.x * 2 < T; ++it) {
        const int t = (it * gridDim.x + blockIdx.x) * 2 + half; bf16* y = Y + (size_t)t * ld;
        if (ngelu) {
            float ss = 0.f;
            for (int c = tid; c < ngelu; c += 256) { float g = gelu_tanh(bf2f(y[c])); bf16 gb = f2bf(g); y[c] = gb; if (c >= ngelu / 2) { float gr = bf2f(gb); ss += gr * gr; } }
            red[tid] = ss; __syncthreads();
            for (int o = 128; o > 0; o >>= 1) { if (tid < o) red[tid] += red[tid + o]; __syncthreads(); }
            if (tid < 8) vss[(size_t)t * 8 + tid] = (tid == 0) ? red[0] : 0.f;
        }
        __syncthreads();
        for (int c = tid; c < nqk; c += 256) hv[c] = bf2f(y[ngelu + c]);
        __syncthreads();
        for (int c = tid; c < nqk; c += 256) {
            const int h = c >> 6, d = c & 63; const bool isq = h < nq; const float* gn = isq ? qn : kn;
            float s = 0.f; for (int j = 0; j < 64; ++j) { float v = hv[h * 64 + j]; s += v * v; }
            const float rs = 1.0f / sqrtf(s * (1.0f / 64.0f) + EPS);
            float o = hv[c] * rs * gn[d];
            if (d < 16) { const int f = d & 7; const float co = cs[t * 8 + f], si = sn[t * 8 + f];
                const float x1 = hv[h * 64 + f] * rs * gn[f], x2 = hv[h * 64 + 8 + f] * rs * gn[8 + f];
                o = (d < 8) ? (x1 * co - x2 * si) : (x2 * co + x1 * si); }
            if (isq) o *= QSCALE;
            y[ngelu + c] = f2bf(o);
        }
        __syncthreads();
    }
}
__device__ void n_sgu(const bf16* __restrict__ Y, const float* __restrict__ vss, const float* __restrict__ gn, const float* __restrict__ w, const float* __restrict__ bs, bf16* __restrict__ A2) {
    for (int i = blockIdx.x * NTHR + threadIdx.x; i < T * 512; i += gridDim.x * NTHR) {
        const int row = i >> 9, ch = i & 511, g = ch >> 6, tt = row & 127, r0 = row - tt;
        float acc = 0.f;
        for (int s = 0; s <= tt; ++s) {
            const int rs_ = r0 + s; float sum = 0.f; for (int j = 0; j < 8; ++j) sum += vss[(size_t)rs_ * 8 + j];
            const float rstd = 1.0f / sqrtf(sum * (1.0f / 512.0f) + EPS);
            const float v = bf2f(f2bf(bf2f(Y[(size_t)rs_ * IN0 + 512 + ch]) * rstd * gn[ch]));
            acc += bf2f(f2bf(w[(g * 128 + tt) * 128 + s])) * v;
        }
        acc += bs[g * 128 + tt];
        A2[(size_t)row * OUT0K + ch] = f2bf(bf2f(Y[(size_t)row * IN0 + ch]) * acc);
    }
}
__device__ void n_dil(const bf16* __restrict__ Y, bf16* __restrict__ A2) {
    const int d = threadIdx.x & 63;
    for (int i = blockIdx.x * NWAVES + (threadIdx.x >> 6); i < T * 4; i += gridDim.x * NWAVES) {
        const int row = i >> 2, j = i & 3, b = row / SEQ, t = row % SEQ;
        float m = -INFINITY, l = 0.f, o = 0.f;
        for (int g = 0; g < 3; ++g) {
            const int dil = (g == 0) ? 1 : (g == 1 ? 4 : 16), h = g * 4 + j;
            const float q = bf2f(Y[(size_t)row * IN0 + 1024 + h * 64 + d]);
            for (int n = 0; n <= 128; ++n) {
                const int tk = t - n * dil; if (tk < 0) break;
                const size_t kr = (size_t)(b * SEQ + tk) * IN0;
                float s = q * bf2f(Y[kr + 1792 + h * 64 + d]);
                for (int x = 1; x < 64; x <<= 1) s += __shfl_xor(s, x);
                const float mn = fmaxf(m, s), a = exp2f(m - mn), p = exp2f(s - mn);
                l = l * a + p; o = o * a + p * bf2f(Y[kr + 2560 + h * 64 + d]);
                m = mn;
            }
        }
        A2[(size_t)row * OUT0K + 512 + j * 64 + d] = f2bf(o / l);
    }
}
__device__ void n_swa(const bf16* __restrict__ Y, const float* __restrict__ sinks, bf16* __restrict__ O) {
    const int d = threadIdx.x & 63;
    for (int i = blockIdx.x * NWAVES + (threadIdx.x >> 6); i < T * 16; i += gridDim.x * NWAVES) {
        const int row = i >> 4, h = i & 15, kvh = h >> 3, b = row / SEQ, t = row % SEQ;
        const float q = bf2f(Y[(size_t)row * IN1 + h * 64 + d]);
        float m = sinks[h] * 1.4426950408889634f, l = 1.0f, o = 0.f;
        for (int n = 0; n < 128; ++n) {
            const int tk = t - n; if (tk < 0) break;
            const size_t kr = (size_t)(b * SEQ + tk) * IN1;
            float s = q * bf2f(Y[kr + 1024 + kvh * 64 + d]);
            for (int x = 1; x < 64; x <<= 1) s += __shfl_xor(s, x);
            const float mn = fmaxf(m, s), a = exp2f(m - mn), p = exp2f(s - mn);
            l = l * a + p; o = o * a + p * bf2f(Y[kr + 1152 + kvh * 64 + d]);
            m = mn;
        }
        O[(size_t)row * D + h * 64 + d] = f2bf(o / l);
    }
}
__device__ void n_router(const float* h, const float* __restrict__ gf, const float* __restrict__ wrg, const float* __restrict__ brg, const float* __restrict__ wre, const float* __restrict__ bre,
                         bf16* __restrict__ hb, float* __restrict__ rstd, int* __restrict__ eid, float* __restrict__ gw, int* counts, int* __restrict__ elist) {
    const int gwv = blockIdx.x * NWAVES + (threadIdx.x >> 6), lane = threadIdx.x & 63, nw = gridDim.x * NWAVES;
    for (int r = gwv; r < T; r += nw) {
        const float* p = h + (size_t)r * D; float s = 0.f;
        for (int c = lane; c < D; c += 64) { float v = p[c]; s += v * v; hb[(size_t)r * D + c] = f2bf(v); }
        for (int o = 1; o < 64; o <<= 1) s += __shfl_xor(s, o);
        const float rs = 1.0f / sqrtf(s * (1.0f / D) + EPS);
        float lg[4] = {0.f, 0.f, 0.f, 0.f};
        for (int c = lane; c < D; c += 64) { const float xn = p[c] * rs * gf[c];
#pragma unroll
            for (int g = 0; g < 4; ++g) lg[g] += xn * wrg[c * 4 + g]; }
#pragma unroll
        for (int g = 0; g < 4; ++g) { for (int o = 1; o < 64; o <<= 1) lg[g] += __shfl_xor(lg[g], o); lg[g] += brg[g]; }
        int gi = 0; float lmax = lg[0];
#pragma unroll
        for (int g = 1; g < 4; ++g) if (lg[g] > lmax) { lmax = lg[g]; gi = g; }
        float zs = 0.f;
#pragma unroll
        for (int g = 0; g < 4; ++g) zs += expf(lg[g] - lmax);
        const float ptop = 1.0f / zs;
        float le[8] = {0.f, 0.f, 0.f, 0.f, 0.f, 0.f, 0.f, 0.f};
        for (int c = lane; c < D; c += 64) { const float xn = p[c] * rs * gf[c];
#pragma unroll
            for (int e = 0; e < 8; ++e) le[e] += xn * wre[((size_t)gi * D + c) * 8 + e]; }
#pragma unroll
        for (int e = 0; e < 8; ++e) { for (int o = 1; o < 64; o <<= 1) le[e] += __shfl_xor(le[e], o); le[e] += bre[gi * 8 + e]; }
        int i0 = 0; float l0 = le[0];
#pragma unroll
        for (int e = 1; e < 8; ++e) if (le[e] > l0) { l0 = le[e]; i0 = e; }
        int i1 = -1; float l1 = -INFINITY;
#pragma unroll
        for (int e = 0; e < 8; ++e) if (e != i0 && le[e] > l1) { l1 = le[e]; i1 = e; }
        const float r1 = expf(l1 - l0); const float g0 = ptop / (1.0f + r1), g1 = ptop * r1 / (1.0f + r1);
        if (lane == 0) {
            rstd[r] = rs; const int e0 = gi * 8 + i0, e1 = gi * 8 + i1;
            eid[r * 2] = e0; eid[r * 2 + 1] = e1; gw[r * 2] = g0; gw[r * 2 + 1] = g1;
            const int p0 = atomicAdd(&counts[e0], 1); elist[e0 * T + p0] = r * 2;
            const int p1 = atomicAdd(&counts[e1], 1); elist[e1 * T + p1] = r * 2 + 1;
        }
    }
}
__device__ __forceinline__ bool slot_lookup(const int* counts, int slot, int& e, int& pos) {
    int base = 0; e = -1; pos = 0; bool ok = false;
    for (int x = 0; x < NE; ++x) { const int c = counts[x], pc = (c + 255) & ~255; if (e < 0 && slot < base + pc) { e = x; pos = slot - base; ok = pos < c; } base += pc; }
    if (e < 0) e = 0;
    return ok;
}
__device__ void n_gateup(LAS unsigned char* lds, const bf16* __restrict__ hb, const float* __restrict__ rstd, const float* __restrict__ gf, const float* __restrict__ wg, const float* __restrict__ wu,
                         const int* counts, const int* elist, bf16* __restrict__ hid) {
    const int half = threadIdx.x >> 8, j = threadIdx.x & 255; LAS float* xs = (LAS float*)(lds + half * 16384);
    for (int it = 0; it * (int)gridDim.x * 2 < SLOT_CAP; ++it) {
        const int slot = (it * gridDim.x + blockIdx.x) * 2 + half; int e, pos; const bool ok = slot_lookup(counts, slot, e, pos);
        const int pair = ok ? elist[e * T + pos] : 0, t = pair >> 1;
        for (int c = j; c < D; c += 256) xs[c] = bf2f(hb[(size_t)t * D + c]);
        __syncthreads();
        if (ok) {
            float g = 0.f, u = 0.f; const float* pg = wg + (size_t)e * D * FF + j; const float* pu = wu + (size_t)e * D * FF + j;
            for (int k = 0; k < D; ++k) { const float gk = gf[k]; g += xs[k] * bf2f(f2bf(pg[(size_t)k * FF] * gk)); u += xs[k] * bf2f(f2bf(pu[(size_t)k * FF] * gk)); }
            const float rs = rstd[t]; g *= rs; u *= rs;
            hid[(size_t)slot * FF + j] = f2bf(g / (1.0f + expf(-g)) * u);
        }
        __syncthreads();
    }
}
__device__ void n_down(LAS unsigned char* lds, const bf16* __restrict__ hid, const float* __restrict__ wd, const float* __restrict__ gw, const int* counts, const int* elist, bf16* __restrict__ yp) {
    const int half = threadIdx.x >> 8, tid = threadIdx.x & 255; LAS float* hs = (LAS float*)(lds + half * 16384);
    for (int it = 0; it * (int)gridDim.x * 2 < SLOT_CAP; ++it) {
        const int slot = (it * gridDim.x + blockIdx.x) * 2 + half; int e, pos; const bool ok = slot_lookup(counts, slot, e, pos);
        const int pair = ok ? elist[e * T + pos] : 0;
        hs[tid] = ok ? bf2f(hid[(size_t)slot * FF + tid]) : 0.f;
        __syncthreads();
        if (ok) {
            const float gwt = gw[pair];
            for (int n = tid; n < D; n += 256) {
                float a = 0.f; const float* p = wd + (size_t)e * FF * D + n;
                for (int k = 0; k < FF; ++k) a += hs[k] * bf2f(f2bf(p[(size_t)k * D]));
                yp[(size_t)pair * D + n] = f2bf(a * gwt);
            }
        }
        __syncthreads();
    }
}
__device__ void n_combine(float* h, const bf16* __restrict__ yp, bf16* __restrict__ hb, float* __restrict__ rstd) {
    const int gwv = blockIdx.x * NWAVES + (threadIdx.x >> 6), lane = threadIdx.x & 63, nw = gridDim.x * NWAVES;
    for (int r = gwv; r < T; r += nw) {
        float s = 0.f;
        for (int c = lane; c < D; c += 64) { const float v = h[(size_t)r * D + c] + bf2f(yp[(size_t)(2 * r) * D + c]) + bf2f(yp[(size_t)(2 * r + 1) * D + c]);
            h[(size_t)r * D + c] = v; s += v * v; if (hb) hb[(size_t)r * D + c] = f2bf(v); }
        for (int o = 1; o < 64; o <<= 1) s += __shfl_xor(s, o);
        if (rstd && lane == 0) rstd[r] = 1.0f / sqrtf(s * (1.0f / D) + EPS);
    }
}

__global__ void __launch_bounds__(NTHR, 2) mega_fwd(Args a) {
    extern __shared__ __attribute__((aligned(16))) unsigned char lds_raw[];
    LAS unsigned char* lds = (LAS unsigned char*)lds_raw;
    volatile LAS unsigned* MISC = (volatile LAS unsigned*)(lds + LDS_MISC);
    if (threadIdx.x < 64) MISC[threadIdx.x] = 0u;
    __syncthreads();
    unsigned char* ws = a.ws;
    unsigned* ctl = (unsigned*)(ws + WS_CTL);
    XcdBarrier bar = xcd_barrier_post(ctl + CW_BAR, MISC + 8);
    int* counts0 = (int*)ctl; int* counts1 = counts0 + 64;
    float* rstd = (float*)(ws + WS_RSTD); float* vss = (float*)(ws + WS_VSS);
    float* cs = (float*)(ws + WS_CS); float* sn = cs + T * 8;
    int* eid = (int*)(ws + WS_EID); float* gw = (float*)(ws + WS_GW); int* elist = (int*)(ws + WS_ELIST);
    bf16* HB = (bf16*)(ws + WS_HB); bf16* Y = (bf16*)(ws + WS_Y); bf16* YP = (bf16*)(ws + WS_YP); bf16* HID = (bf16*)(ws + WS_HID); bf16* Y1 = (bf16*)(ws + WS_Y1); bf16* A2 = (bf16*)(ws + WS_A2);
    float* out = a.out;
#define GRID_BAR() xcd_barrier(bar)
    n_rope_tab(a.positions, cs, sn);
    n_rowprep(a.x, HB, rstd);
    GRID_BAR();
    n_gemm(lds, HB, D, a.w_in_even, T, IN0, D, a.norm_mix, rstd, nullptr, Y, IN0, nullptr);
    GRID_BAR();
    n_post(lds, Y, IN0, 1024, 12, 12, vss, cs, sn, a.qn_dil, a.kn_dil);
    GRID_BAR();
    n_sgu(Y, vss, a.sgu_norm, a.sgu_w, a.sgu_b, A2);
    n_dil(Y, A2);
    GRID_BAR();
    n_gemm(lds, A2, OUT0K, a.w_out_even, T, D, OUT0K, nullptr, nullptr, a.x, nullptr, 0, out);
    GRID_BAR();
    n_router(out, a.norm_ffn, a.w_rg, a.b_rg, a.w_re, a.b_re, HB, rstd, eid, gw, counts0, elist);
    GRID_BAR();
    n_gateup(lds, HB, rstd, a.norm_ffn, a.w_gate, a.w_up, counts0, elist, HID);
    GRID_BAR();
    n_down(lds, HID, a.w_down, gw, counts0, elist, YP);
    GRID_BAR();
    n_combine(out, YP, HB, rstd);
    GRID_BAR();
    n_gemm(lds, HB, D, a.w_in_odd, T, IN1, D, a.norm_mix + D, rstd, nullptr, Y1, IN1, nullptr);
    GRID_BAR();
    n_post(lds, Y1, IN1, 0, 16, 2, nullptr, cs, sn, a.qn_swa, a.kn_swa);
    GRID_BAR();
    n_swa(Y1, a.sinks, A2);
    GRID_BAR();
    n_gemm(lds, A2, D, a.w_out_odd, T, D, D, nullptr, nullptr, out, nullptr, 0, out);
    GRID_BAR();
    n_router(out, a.norm_ffn + D, a.w_rg + D * 4, a.b_rg + 4, a.w_re + (size_t)4 * D * 8, a.b_re + 32, HB, rstd, eid, gw, counts1, elist);
    GRID_BAR();
    const size_t EW = (size_t)NE * D * FF;
    n_gateup(lds, HB, rstd, a.norm_ffn + D, a.w_gate + EW, a.w_up + EW, counts1, elist, HID);
    GRID_BAR();
    n_down(lds, HID, a.w_down + EW, gw, counts1, elist, YP);
    GRID_BAR();
    n_combine(out, YP, nullptr, nullptr);
}

extern "C" void kernel_launch(void* const* d_in, const int* in_sizes, int n_in, void* d_out, int out_size, void* d_ws, size_t ws_size, hipStream_t stream) {
    static int grid = 0;
    if (grid == 0) {
        int dev = 0, cus = 0, per_cu = 0;
        if (hipGetDevice(&dev) != hipSuccess || hipDeviceGetAttribute(&cus, hipDeviceAttributeMultiprocessorCount, dev) != hipSuccess) { fprintf(stderr, "kernel_launch: device query failed\n"); grid = -1; return; }
        if (hipFuncSetAttribute((const void*)mega_fwd, hipFuncAttributeMaxDynamicSharedMemorySize, LDS_BYTES) != hipSuccess) { fprintf(stderr, "kernel_launch: hipFuncSetAttribute failed\n"); grid = -1; return; }
        if (hipOccupancyMaxActiveBlocksPerMultiprocessor(&per_cu, (const void*)mega_fwd, NTHR, LDS_BYTES) != hipSuccess || per_cu < 1) { fprintf(stderr, "kernel_launch: occupancy query says %d blocks/CU\n", per_cu); grid = -1; (void)hipGetLastError(); return; }
        grid = cus;
    }
    if (grid < 0) return;
    if (hipMemsetAsync((char*)d_ws + WS_CTL, 0, MiB, stream) != hipSuccess) return;
    Args a{};
    a.x = (const float*)d_in[0]; a.positions = (const int*)d_in[1]; a.norm_mix = (const float*)d_in[2]; a.norm_ffn = (const float*)d_in[3];
    a.w_in_even = (const float*)d_in[4]; a.w_out_even = (const float*)d_in[5]; a.sgu_norm = (const float*)d_in[6]; a.sgu_w = (const float*)d_in[7]; a.sgu_b = (const float*)d_in[8];
    a.qn_dil = (const float*)d_in[9]; a.kn_dil = (const float*)d_in[10]; a.w_in_odd = (const float*)d_in[11]; a.w_out_odd = (const float*)d_in[12];
    a.qn_swa = (const float*)d_in[13]; a.kn_swa = (const float*)d_in[14]; a.sinks = (const float*)d_in[15];
    a.w_rg = (const float*)d_in[16]; a.b_rg = (const float*)d_in[17]; a.w_re = (const float*)d_in[18]; a.b_re = (const float*)d_in[19];
    a.w_gate = (const float*)d_in[20]; a.w_up = (const float*)d_in[21]; a.w_down = (const float*)d_in[22];
    a.out = (float*)d_out; a.ws = (unsigned char*)d_ws;
    hipLaunchKernelGGL(mega_fwd, dim3(grid), dim3(NTHR), LDS_BYTES, stream, a);
}
```

```cpp
#include <hip/hip_runtime.h>
#include <stdint.h>
#include <math.h>
#include <cstdio>

typedef unsigned short bf16;
__device__ __forceinline__ float bf2f(bf16 v) { return __uint_as_float((unsigned)v << 16); }
__device__ __forceinline__ bf16 f2bf(float f) { unsigned u = __float_as_uint(f); return (bf16)((u + 0x7fffu + ((u >> 16) & 1u)) >> 16); }

constexpr int T = 16384, SEQ = 8192, D = 1024;
constexpr int IN0 = 3328, OUT0K = 768, IN1 = 1280;
constexpr int NE = 32, FF = 256;
constexpr float EPS = 1e-6f;
constexpr float QSCALE = 0.125f * 1.4426950408889634f;
constexpr int SLOT_CAP = 40960;

constexpr size_t MiB = 1u << 20;
constexpr size_t WS_CTL = 0;
constexpr size_t WS_RSTD = 1 * MiB;
constexpr size_t WS_VSS = WS_RSTD + 65536;
constexpr size_t WS_CS = 2 * MiB;
constexpr size_t WS_EID = 3 * MiB;
constexpr size_t WS_GW = WS_EID + 131072;
constexpr size_t WS_ELIST = 4 * MiB;
constexpr size_t WS_WIN0 = 8 * MiB;
constexpr size_t WS_WOUT0 = 15 * MiB;
constexpr size_t WS_WIN1 = 17 * MiB;
constexpr size_t WS_WOUT1 = 20 * MiB;
constexpr size_t WS_WGU = 22 * MiB;
constexpr size_t WS_WD = 54 * MiB;
constexpr size_t WS_HB = 70 * MiB;
constexpr size_t WS_Y = 102 * MiB;
constexpr size_t WS_YP = 102 * MiB;
constexpr size_t WS_HID = 166 * MiB;
constexpr size_t WS_Y1 = 166 * MiB;
constexpr size_t WS_A2 = 206 * MiB;


#define LAS __attribute__((address_space(3)))
constexpr int NTHR = 512, NWAVES = 8;
constexpr int LDS_BYTES = 147456;
constexpr int LDS_MISC = 145408;
constexpr int CW_BAR = 4096;

#define XB_TMO      128
#define XB_XCNT(j)  (256  + 64 * (j))
#define XB_XSUB(j)  (1280 + 64 * (j))
#define XB_XGEN(j)  (2304 + 64 * (j))
#define XB_TOP      3328
#define XB_TOPGEN   3392
#define XCD_BAR_WORDS 3456
#define XB_SPIN_CAP (1u << 20)
__device__ __forceinline__ unsigned xb_ld(unsigned* p)              { return __hip_atomic_load(p, __ATOMIC_RELAXED, __HIP_MEMORY_SCOPE_AGENT); }
__device__ __forceinline__ unsigned xb_add(unsigned* p, unsigned v) { return __hip_atomic_fetch_add(p, v, __ATOMIC_RELAXED, __HIP_MEMORY_SCOPE_AGENT); }
__device__ __forceinline__ unsigned xb_xcc_id() { return (unsigned)__builtin_amdgcn_s_getreg((3 << 11) | 20) & 0xFu; }
#define XB_SPIN(cond, bar) do { unsigned _sp = 0; while (cond) { __builtin_amdgcn_s_sleep(1); \
    if ((++_sp & 255u) == 0u) { if (xb_ld(&(bar)[XB_TMO])) break; if (_sp > XB_SPIN_CAP) { atomicAdd(&(bar)[XB_TMO], 1u); break; } } } } while (0)
struct XcdBarrier { unsigned* bar; unsigned x; volatile LAS unsigned* st; };
__device__ __forceinline__ XcdBarrier xcd_barrier_post(unsigned* bar, volatile LAS unsigned* st) {
    XcdBarrier b; b.bar = bar; b.x = xb_xcc_id(); b.st = st;
    if (threadIdx.x == 0) (void)xb_add(&bar[XB_XCNT(b.x)], 1u);
    return b;
}
__device__ __forceinline__ void xcd_barrier_complete(unsigned* bar, unsigned x, unsigned& nloc, unsigned& nx) {
    const unsigned G = gridDim.x * gridDim.y * gridDim.z;
    unsigned sum, cnt, mine, sp = 0u;
    for (;;) {
        sum = 0u; cnt = 0u; mine = 0u;
#pragma unroll
        for (unsigned j = 0; j < 16; ++j) { const unsigned c = xb_ld(&bar[XB_XCNT(j)]); sum += c; cnt += (c > 0u) ? 1u : 0u; mine = (j == x) ? c : mine; }
        if (sum == G) break;
        __builtin_amdgcn_s_sleep(1);
        if ((++sp & 255u) == 0u) { if (xb_ld(&bar[XB_TMO])) break; if (sp > XB_SPIN_CAP) { atomicAdd(&bar[XB_TMO], 1u); break; } }
    }
    nloc = mine > 0u ? mine : 1u; nx = cnt > 0u ? cnt : 1u;
}
__device__ __forceinline__ void xcd_barrier(const XcdBarrier& b) {
    asm volatile("s_waitcnt vmcnt(0)" ::: "memory");
    __syncthreads();
    if (threadIdx.x == 0) {
        unsigned* bar = b.bar;
        __builtin_amdgcn_s_waitcnt(0);
        unsigned nloc = b.st[0], nx = b.st[1];
        if (nloc == 0u) { xcd_barrier_complete(bar, b.x, nloc, nx); b.st[0] = nloc; b.st[1] = nx; }
        const unsigned old = xb_add(&bar[XB_XSUB(b.x)], 1u);
        const unsigned gen = old / nloc;
        if (old + 1u == (gen + 1u) * nloc) {
            __builtin_amdgcn_fence(__ATOMIC_RELEASE, "agent");
            asm volatile("s_waitcnt vmcnt(0)" ::: "memory");
            const unsigned og = xb_add(&bar[XB_TOP], 1u);
            const unsigned tg = og / nx;
            if (og + 1u == (tg + 1u) * nx) xb_add(&bar[XB_TOPGEN], 1u);
            else XB_SPIN(xb_ld(&bar[XB_TOPGEN]) == tg, bar);
            __builtin_amdgcn_fence(__ATOMIC_ACQUIRE, "agent");
            xb_add(&bar[XB_XGEN(b.x)], 1u);
            asm volatile("s_waitcnt vmcnt(0)" ::: "memory");
        } else {
            XB_SPIN(xb_ld(&bar[XB_XGEN(b.x)]) == gen, bar);
            __builtin_amdgcn_fence(__ATOMIC_ACQUIRE, "agent");
            asm volatile("s_waitcnt vmcnt(0)" ::: "memory");
        }
    }
    __syncthreads();
}


typedef short bf16x8 __attribute__((ext_vector_type(8)));
typedef float f32x4 __attribute__((ext_vector_type(4)));
typedef float f32x2 __attribute__((ext_vector_type(2)));
typedef unsigned u32x4 __attribute__((ext_vector_type(4)));
typedef unsigned u32x2 __attribute__((ext_vector_type(2)));
typedef __bf16 bf16x2_t __attribute__((ext_vector_type(2)));
__device__ __forceinline__ unsigned pk2(float lo, float hi) { f32x2 v = {lo, hi}; bf16x2_t b = __builtin_convertvector(v, bf16x2_t); return __builtin_bit_cast(unsigned, b); }
__device__ __forceinline__ float gelu_fast(float x) { const float u = x * (0.7978845608028654f + 0.0356774081363001f * x * x);
    return x * __builtin_amdgcn_rcpf(1.0f + __builtin_amdgcn_exp2f(-2.885390081777927f * u)); }

__device__ __forceinline__ void cvt_item(const float* __restrict__ W, int N, int k0, int n0, const float* __restrict__ gain, bf16* __restrict__ WT, int K, int drow0, LAS float* scr, int lane) {
#pragma unroll
    for (int i = 0; i < 8; ++i) {
        const int kk = i * 8 + (lane >> 3);
        f32x4 v = *(const f32x4*)(W + (size_t)(k0 + kk) * N + n0 + 4 * (lane & 7));
        if (gain) v = v * gain[k0 + kk];
        *(LAS f32x4*)(scr + kk * 36 + 4 * (lane & 7)) = v;
    }
    const int n = lane & 31;
#pragma unroll
    for (int cc = 0; cc < 4; ++cc) {
        const int c = (lane >> 5) * 4 + cc; const LAS float* q = scr + (8 * c) * 36 + n;
        u32x4 o; o.x = pk2(q[0], q[36]); o.y = pk2(q[72], q[108]); o.z = pk2(q[144], q[180]); o.w = pk2(q[216], q[252]);
        *(u32x4*)(WT + (size_t)(drow0 + n) * K + k0 + 8 * c) = o;
    }
}
__device__ __forceinline__ int inproj_pos(int n0) { return (n0 & ~255) | (((n0 >> 5) & 1) << 7) | (((n0 >> 6) & 3) << 5); }
__device__ __forceinline__ void cvt_matrix_items(const float* W, int K, int N, const float* gain, bf16* WT, int mode, int item, LAS float* scr, int lane) {
    const int nblk = N / 32, kb = item / nblk, nb = item % nblk, n0 = nb * 32;
    int d0 = n0;
    if (mode == 1) d0 = inproj_pos(n0);
    else if (mode == 2) d0 = 256 * (n0 >> 7) + (n0 & 127);
    else if (mode == 3) d0 = 256 * (n0 >> 7) + 128 + (n0 & 127);
    cvt_item(W, N, kb * 64, n0, gain, WT, K, d0, scr, lane);
}
struct CvtFam { const float* src; bf16* dst; const float* gain; int K, N, nmat, mode; int dstride_rows; };
__device__ __forceinline__ int cvt_fam_items(const CvtFam& f) { return f.nmat * (f.K / 64) * (f.N / 32); }
__device__ __forceinline__ void cvt_fam_run(const CvtFam& f, int item, LAS float* scr, int lane) {
    const int per = (f.K / 64) * (f.N / 32), e = item / per, it = item % per;
    cvt_matrix_items(f.src + (size_t)e * f.K * f.N, f.K, f.N, f.gain, f.dst + (size_t)e * f.dstride_rows * f.K, f.mode, it, scr, lane);
}

__device__ __forceinline__ float wave_sum(float v) {
#pragma unroll
    for (int o = 1; o < 64; o <<= 1) v += __shfl_xor(v, o);
    return v;
}
__device__ __forceinline__ void f_rowprep(const float* __restrict__ src, bf16* __restrict__ hb, float* __restrict__ rstd) {
    const int gw = blockIdx.x * NWAVES + (threadIdx.x >> 6), lane = threadIdx.x & 63, nw = gridDim.x * NWAVES;
    for (int r = gw; r < T; r += nw) {
        const f32x4* xr = (const f32x4*)(src + (size_t)r * D) + lane; f32x4 v[4]; float s = 0.f;
#pragma unroll
        for (int j = 0; j < 4; ++j) { v[j] = xr[64 * j]; s += (v[j].x * v[j].x + v[j].y * v[j].y) + (v[j].z * v[j].z + v[j].w * v[j].w); }
        s = wave_sum(s);
        u32x2* o = (u32x2*)(hb + (size_t)r * D) + lane;
#pragma unroll
        for (int j = 0; j < 4; ++j) { u32x2 w; w.x = pk2(v[j].x, v[j].y); w.y = pk2(v[j].z, v[j].w); o[64 * j] = w; }
        if (lane == 0) rstd[r] = 1.0f / sqrtf(s * (1.0f / D) + EPS);
    }
}

namespace pg8 {
constexpr int BM = 256, BK = 64, HALF = 128, HTB = HALF * BK * 2, STAGE_BYTES = 8 * HTB, NXCD = 8, WGM = 8;
__device__ __forceinline__ int lds_byte(int r, int c) { const int st = (r >> 4) * 2 + (c >> 5), rr = r & 15, cc = c & 31, ob = rr * 64 + cc * 2; return st * 1024 + (ob ^ (((ob >> 9) & 1) << 5)); }
__device__ __forceinline__ void stage_rc(int b, int& R, int& C) { const int st = b / 1024, sb = b % 1024, swz = sb ^ (((sb >> 9) & 1) << 5); R = (st >> 1) * 16 + swz / 64; C = (st & 1) * 32 + (swz % 64) / 2; }
__device__ __forceinline__ int perm32(int rho) { const int n = rho >> 4, i = rho & 15; return 8 * (i >> 2) + 4 * n + (i & 3); }
struct Unit { int pm, pn, e, aux; };
struct DenseOrder {
    int nM, nN, nwg, G, c, K; const bf16* Bt;
    __device__ void init(int M, int N, int K_, const bf16* Bt_, int G_, int c_) { nM = M / BM; nN = N / BM; nwg = nM * nN; G = G_; c = c_; K = K_; Bt = Bt_; }
    __device__ __forceinline__ bool next(int i, Unit& u) const {
        const long L = (long)i * G + c; if (L >= nwg) return false;
        int wgid = (int)L; { const int q = nwg / NXCD, r = nwg % NXCD, xcd = wgid % NXCD, off = wgid / NXCD; wgid = (xcd < r ? xcd * (q + 1) : r * (q + 1) + (xcd - r) * q) + off; }
        const int nig = WGM * nN, gid = wgid / nig, fm = gid * WGM, gsz = (nM - fm) < WGM ? (nM - fm) : WGM;
        u.pm = fm + ((wgid % nig) % gsz); u.pn = (wgid % nig) / gsz; u.e = 0; u.aux = 0; return true;
    }
    __device__ __forceinline__ unsigned a_rowoff(const Unit& u, int r) const { return (unsigned)(u.pm * BM + r) * (unsigned)(K * 2); }
    __device__ __forceinline__ const char* b_base(const Unit& u) const { return (const char*)Bt + (size_t)u.pn * BM * K * 2; }
};

template <class Epi, class Sched, bool ALIGN_EPI>
__device__ __forceinline__ void gemm_phase(LAS unsigned char* lds, const bf16* Abase, const int K, const Sched& S, const Epi& E) {
    int tid_ = threadIdx.x; asm volatile("" : "+v"(tid_));
    const int tid = tid_, wid = __builtin_amdgcn_readfirstlane(tid >> 6), lane = tid & 63, wr = wid >> 2, wc = wid & 3, fr = lane & 15, fq = lane >> 4;
    const int nt = K / BK;
    unsigned voffB[2];
#pragma unroll
    for (int i = 0; i < 2; ++i) { int R, C; stage_rc(tid * 16 + i * 8192, R, C); const int Rb = Epi::PERM ? ((R & ~31) + perm32(R & 31)) : R;
        voffB[i] = (unsigned)(Rb * K + C) * 2u; }
    const size_t kstep = (size_t)(BK * 2);
    const size_t hstep = (size_t)HALF * K * 2;
    const unsigned ldsw = (unsigned)wid * 1024u;
    const int aoff = lds_byte(wr * 64 + fr, fq * 8), boff = lds_byte(wc * 32 + fr, fq * 8);
#define PG8_SA(b, h) (((b) * 2 + (h)) * HTB)
#define PG8_SB(b, h) ((4 + (b) * 2 + (h)) * HTB)
#define PG8_STAGE_B(bufoff, gbase) do { _Pragma("unroll") for (int _i = 0; _i < 2; ++_i) \
        __builtin_amdgcn_global_load_lds((const unsigned*)((const char*)(gbase) + voffB[_i]), (LAS unsigned*)(lds + (bufoff) + ldsw + _i * 8192), 16, 0, 0); } while (0)
#define PG8_STAGE_A(bufoff, offs, kb) do { _Pragma("unroll") for (int _i = 0; _i < 2; ++_i) \
        __builtin_amdgcn_global_load_lds((const unsigned*)((const char*)Abase + (size_t)(offs)[_i] + (size_t)(kb)), (LAS unsigned*)(lds + (bufoff) + ldsw + _i * 8192), 16, 0, 0); } while (0)
#define PG8_LDA(dst, b, h) do { _Pragma("unroll") for (int m = 0; m < 4; ++m) _Pragma("unroll") for (int k = 0; k < 2; ++k) dst[m][k] = *(const LAS bf16x8*)(lds + PG8_SA(b, h) + aoff + m * 2048 + k * 1024); } while (0)
#define PG8_LDB(dst, b, h) do { _Pragma("unroll") for (int n = 0; n < 2; ++n) _Pragma("unroll") for (int k = 0; k < 2; ++k) dst[n][k] = *(const LAS bf16x8*)(lds + PG8_SB(b, h) + boff + n * 2048 + k * 1024); } while (0)
#define PG8_MMA(ai, bj, At, Bt) do { __builtin_amdgcn_s_setprio(1); _Pragma("unroll") for (int m = 0; m < 4; ++m) _Pragma("unroll") for (int n = 0; n < 2; ++n) _Pragma("unroll") for (int k = 0; k < 2; ++k) \
        acc[ai][bj][m][n] = __builtin_amdgcn_mfma_f32_16x16x32_bf16(Bt[n][k], At[m][k], acc[ai][bj][m][n], 0, 0, 0); __builtin_amdgcn_s_setprio(0); } while (0)
#define PG8_WAIT_V(n) asm volatile("s_waitcnt vmcnt(" #n ")" ::: "memory")
#define PG8_WAIT_L(n) asm volatile("s_waitcnt lgkmcnt(" #n ")" ::: "memory")
#define PG8_BAR __builtin_amdgcn_s_barrier()
#define PG8_SCHED __builtin_amdgcn_sched_barrier(0)
#define PG8_AOFF(dst, u) do { int _t = tid; asm volatile("" : "+v"(_t)); _Pragma("unroll") for (int _i = 0; _i < 2; ++_i) { int _R, _C; stage_rc(_t * 16 + _i * 8192, _R, _C); \
        _Pragma("unroll") for (int _h = 0; _h < 2; ++_h) dst[_h][_i] = S.a_rowoff(u, _h * HALF + _R) + (unsigned)(_C * 2); } } while (0)
    Unit cur, nxt; int ui = 0;
    if (!S.next(0, cur)) return;
    f32x4 acc[2][2][4][2];
#pragma unroll
    for (int a = 0; a < 2; ++a)
#pragma unroll
        for (int b = 0; b < 2; ++b)
#pragma unroll
            for (int m = 0; m < 4; ++m)
#pragma unroll
                for (int n = 0; n < 2; ++n) acc[a][b][m][n] = (f32x4){0.f, 0.f, 0.f, 0.f};
    bf16x8 At[4][2], B0[2][2], B1[2][2];
    unsigned cA[2][2];
    PG8_AOFF(cA, cur);
    const char* cB = S.b_base(cur);
    PG8_STAGE_B(PG8_SB(0, 0), cB); PG8_STAGE_B(PG8_SB(0, 1), cB + hstep); PG8_STAGE_A(PG8_SA(0, 0), cA[0], 0); PG8_STAGE_A(PG8_SA(0, 1), cA[1], 0);
    if (wr == 1) PG8_BAR;
    PG8_WAIT_V(2); PG8_BAR;
    PG8_STAGE_B(PG8_SB(1, 0), cB + kstep); PG8_STAGE_A(PG8_SA(1, 0), cA[0], kstep); PG8_STAGE_B(PG8_SB(1, 1), cB + hstep + kstep);
    PG8_WAIT_V(6); PG8_BAR;
    for (;;) {
        const bool has_next = S.next(ui + 1, nxt);
        const char* nB = has_next ? S.b_base(nxt) : cB;
#pragma unroll 1
        for (int t = 0; t < nt; t += 2) {
            const bool last = (t == nt - 2);
            const size_t k1 = (size_t)(t + 1) * kstep;
            const size_t k2 = last ? (size_t)0 : (size_t)(t + 2) * kstep, k3 = k2 + kstep;
            const char* b2 = last ? nB : cB + (size_t)(t + 2) * kstep; const char* b3 = b2 + kstep;
            PG8_LDB(B0, 0, 0); PG8_LDB(B1, 0, 1); PG8_SCHED; PG8_LDA(At, 0, 0); PG8_STAGE_A(PG8_SA(1, 1), cA[1], k1);
            if (last && has_next) { PG8_AOFF(cA, nxt); }
            PG8_WAIT_V(8); PG8_WAIT_L(0); PG8_BAR; PG8_MMA(0, 0, At, B0); PG8_MMA(0, 1, At, B1); PG8_BAR; PG8_SCHED;
            PG8_LDA(At, 0, 1); PG8_STAGE_B(PG8_SB(0, 0), b2); PG8_STAGE_B(PG8_SB(0, 1), b2 + hstep); PG8_STAGE_A(PG8_SA(0, 0), cA[0], k2);
            PG8_WAIT_V(8); PG8_WAIT_L(0); PG8_BAR; PG8_MMA(1, 0, At, B0); PG8_MMA(1, 1, At, B1); PG8_BAR; PG8_SCHED;
            PG8_LDB(B0, 1, 0); PG8_LDB(B1, 1, 1); PG8_SCHED; PG8_LDA(At, 1, 0); PG8_STAGE_A(PG8_SA(0, 1), cA[1], k2);
            PG8_WAIT_V(8); PG8_WAIT_L(0); PG8_BAR; PG8_MMA(0, 0, At, B0); PG8_MMA(0, 1, At, B1); PG8_BAR; PG8_SCHED;
            PG8_LDA(At, 1, 1); PG8_STAGE_B(PG8_SB(1, 0), b3); PG8_STAGE_B(PG8_SB(1, 1), b3 + hstep); PG8_STAGE_A(PG8_SA(1, 0), cA[0], k3);
            PG8_WAIT_V(8); PG8_WAIT_L(0); PG8_BAR; PG8_MMA(1, 0, At, B0); PG8_MMA(1, 1, At, B1); PG8_BAR; PG8_SCHED;
        }
        if constexpr (ALIGN_EPI) { if (wr == 0) PG8_BAR; }
        E(acc, cur, wr, wc, fr, fq);
        if (!has_next) break;
#pragma unroll
        for (int a = 0; a < 2; ++a)
#pragma unroll
            for (int b = 0; b < 2; ++b)
#pragma unroll
                for (int m = 0; m < 4; ++m)
#pragma unroll
                    for (int n = 0; n < 2; ++n) acc[a][b][m][n] = (f32x4){0.f, 0.f, 0.f, 0.f};
        cur = nxt; cB = nB; ++ui;
        if constexpr (ALIGN_EPI) { if (wr == 1) PG8_BAR; }
    }
    PG8_WAIT_V(0);
    if constexpr (!ALIGN_EPI) { if (wr == 0) PG8_BAR; }
    PG8_BAR;
#undef PG8_SA
#undef PG8_SB
#undef PG8_STAGE_A
#undef PG8_STAGE_B
#undef PG8_LDA
#undef PG8_LDB
#undef PG8_MMA
#undef PG8_WAIT_V
#undef PG8_WAIT_L
#undef PG8_BAR
#undef PG8_SCHED
#undef PG8_AOFF
}

template <int LAYER> struct EpiIn {
    static constexpr bool PERM = true;
    bf16* Y; const float* rstd; float* vss; const float* cs; const float* sn; const float* qn; const float* kn;
    __device__ __forceinline__ void operator()(const f32x4 (&acc)[2][2][4][2], const Unit& u, int wr, int wc, int fr, int fq) const {
        constexpr int LD = LAYER == 0 ? IN0 : IN1;
        int type; bool isq;
        if (LAYER == 0) { type = u.pn < 2 ? 0 : (u.pn < 4 ? 1 : (u.pn < 10 ? 2 : 3)); isq = u.pn < 7; }
        else { type = (u.pn < 4 || wc < 2) ? 2 : 3; isq = u.pn < 4; }
        f32x4 g[2][2];
        if (type == 2) { const float* gn = isq ? qn : kn;
#pragma unroll
            for (int bj = 0; bj < 2; ++bj)
#pragma unroll
                for (int n = 0; n < 2; ++n) { g[bj][n] = *(const f32x4*)(gn + 32 * bj + 8 * fq + 4 * n); if (isq) g[bj][n] = g[bj][n] * QSCALE; } }
        const int colb = u.pn * BM + 64 * wc + 8 * fq;
#pragma unroll
        for (int ai = 0; ai < 2; ++ai)
#pragma unroll
            for (int m = 0; m < 4; ++m) {
                const int row = u.pm * BM + ai * HALF + wr * 64 + m * 16 + fr;
                const float rs = rstd[row];
                f32x4 v[2][2];
#pragma unroll
                for (int bj = 0; bj < 2; ++bj)
#pragma unroll
                    for (int n = 0; n < 2; ++n) v[bj][n] = acc[ai][bj][m][n] * rs;
                if (type <= 1) {
#pragma unroll
                    for (int bj = 0; bj < 2; ++bj)
#pragma unroll
                        for (int n = 0; n < 2; ++n) { v[bj][n].x = gelu_fast(v[bj][n].x); v[bj][n].y = gelu_fast(v[bj][n].y); v[bj][n].z = gelu_fast(v[bj][n].z); v[bj][n].w = gelu_fast(v[bj][n].w); }
                } else if (type == 2) {
                    float ss = 0.f;
#pragma unroll
                    for (int bj = 0; bj < 2; ++bj)
#pragma unroll
                        for (int n = 0; n < 2; ++n) ss += (v[bj][n].x * v[bj][n].x + v[bj][n].y * v[bj][n].y) + (v[bj][n].z * v[bj][n].z + v[bj][n].w * v[bj][n].w);
                    ss += __shfl_xor(ss, 16); ss += __shfl_xor(ss, 32);
                    const float hr = 1.0f / sqrtf(ss * (1.0f / 64.0f) + EPS);
#pragma unroll
                    for (int bj = 0; bj < 2; ++bj)
#pragma unroll
                        for (int n = 0; n < 2; ++n) v[bj][n] = v[bj][n] * g[bj][n] * hr;
                    f32x4 o[2];
#pragma unroll
                    for (int n = 0; n < 2; ++n) { o[n].x = __shfl_xor(v[0][n].x, 16); o[n].y = __shfl_xor(v[0][n].y, 16); o[n].z = __shfl_xor(v[0][n].z, 16); o[n].w = __shfl_xor(v[0][n].w, 16); }
                    if (fq < 2) {
                        const f32x4 c0 = *(const f32x4*)(cs + (size_t)row * 8), c1 = *(const f32x4*)(cs + (size_t)row * 8 + 4);
                        f32x4 s0 = *(const f32x4*)(sn + (size_t)row * 8), s1 = *(const f32x4*)(sn + (size_t)row * 8 + 4);
                        if (fq == 0) { s0 = -s0; s1 = -s1; }
                        v[0][0] = v[0][0] * c0 + o[0] * s0; v[0][1] = v[0][1] * c1 + o[1] * s1;
                    }
                }
                bf16* rowp = Y + (size_t)row * LD + colb;
                float vsum = 0.f;
#pragma unroll
                for (int bj = 0; bj < 2; ++bj) {
                    u32x4 w; w.x = pk2(v[bj][0].x, v[bj][0].y); w.y = pk2(v[bj][0].z, v[bj][0].w); w.z = pk2(v[bj][1].x, v[bj][1].y); w.w = pk2(v[bj][1].z, v[bj][1].w);
                    *(u32x4*)(rowp + 32 * bj) = w;
                    if (LAYER == 0 && type == 1) {
#pragma unroll
                        for (int q = 0; q < 4; ++q) { const float lo = __uint_as_float(w[q] << 16), hi = __uint_as_float(w[q] & 0xffff0000u); vsum += lo * lo + hi * hi; }
                    }
                }
                if (LAYER == 0 && type == 1) { vsum += __shfl_xor(vsum, 16); vsum += __shfl_xor(vsum, 32); if (fq == 0) vss[(size_t)row * 8 + (u.pn - 2) * 4 + wc] = vsum; }
            }
    }
};
struct EpiRes {
    static constexpr bool PERM = false;
    const float* resid; float* out;
    __device__ __forceinline__ void operator()(const f32x4 (&acc)[2][2][4][2], const Unit& u, int wr, int wc, int fr, int fq) const {
        const int row0 = u.pm * BM + wr * 64 + fr, col0 = u.pn * BM + wc * 32 + 4 * fq;
#pragma unroll
        for (int ai = 0; ai < 2; ++ai)
#pragma unroll
            for (int m = 0; m < 4; ++m) { const size_t off = (size_t)(row0 + ai * HALF + m * 16) * D + col0;
#pragma unroll
                for (int bj = 0; bj < 2; ++bj)
#pragma unroll
                    for (int n = 0; n < 2; ++n) { const f32x4 r = *(const f32x4*)(resid + off + bj * HALF + n * 16); *(f32x4*)(out + off + bj * HALF + n * 16) = r + acc[ai][bj][m][n]; } }
    }
};
__device__ __forceinline__ void moe_setup(volatile LAS int* tb, const int* counts) {
    if (threadIdx.x == 0) { int sacc = 0; for (int e = 0; e < NE; ++e) { tb[e] = sacc; sacc += (counts[e] + 255) >> 8; } tb[NE] = sacc; }
    __syncthreads();
}
template <int NPN, bool GATHER> struct MoeOrder {
    const volatile LAS int* tb; const int* counts; const int* elist; int G, c, K, brows; const bf16* Bt;
    __device__ __forceinline__ bool next(int i, Unit& u) const {
        const int L = i * G + c, ntile = __builtin_amdgcn_readfirstlane(tb[NE]); if (L >= ntile * NPN) return false;
        const int tile = L / NPN; int e = 0, te = 0;
#pragma unroll 1
        for (int x = 1; x < NE; ++x) { const int v = __builtin_amdgcn_readfirstlane(tb[x]); if (v <= tile) { e = x; te = v; } }
        u.e = e; u.pm = tile - te; u.pn = L % NPN; u.aux = tile; return true;
    }
    __device__ __forceinline__ unsigned a_rowoff(const Unit& u, int r) const {
        if (GATHER) { const int pos = u.pm * BM + r; const int tok = pos < counts[u.e] ? (elist[u.e * T + pos] >> 1) : 0; return (unsigned)tok * (unsigned)(K * 2); }
        return (unsigned)(u.aux * BM + r) * (unsigned)(K * 2);
    }
    __device__ __forceinline__ const char* b_base(const Unit& u) const { return (const char*)Bt + ((size_t)u.e * brows + (size_t)u.pn * BM) * K * 2; }
};
struct EpiGU {
    static constexpr bool PERM = true;
    bf16* hid; const float* rstd; const int* counts; const int* elist;
    __device__ __forceinline__ void operator()(const f32x4 (&acc)[2][2][4][2], const Unit& u, int wr, int wc, int fr, int fq) const {
        const int cnt = counts[u.e];
#pragma unroll
        for (int ai = 0; ai < 2; ++ai)
#pragma unroll
            for (int m = 0; m < 4; ++m) {
                const int r = ai * HALF + wr * 64 + m * 16 + fr, pos = u.pm * BM + r;
                if (pos < cnt) {
                    const int tok = elist[u.e * T + pos] >> 1; const float rs = rstd[tok];
                    u32x4 w;
#pragma unroll
                    for (int n = 0; n < 2; ++n) {
                        const f32x4 g = acc[ai][0][m][n] * rs, up = acc[ai][1][m][n] * rs; f32x4 h;
                        h.x = g.x * __builtin_amdgcn_rcpf(1.0f + __builtin_amdgcn_exp2f(-1.4426950408889634f * g.x)) * up.x;
                        h.y = g.y * __builtin_amdgcn_rcpf(1.0f + __builtin_amdgcn_exp2f(-1.4426950408889634f * g.y)) * up.y;
                        h.z = g.z * __builtin_amdgcn_rcpf(1.0f + __builtin_amdgcn_exp2f(-1.4426950408889634f * g.z)) * up.z;
                        h.w = g.w * __builtin_amdgcn_rcpf(1.0f + __builtin_amdgcn_exp2f(-1.4426950408889634f * g.w)) * up.w;
                        if (n == 0) { w.x = pk2(h.x, h.y); w.y = pk2(h.z, h.w); } else { w.z = pk2(h.x, h.y); w.w = pk2(h.z, h.w); }
                    }
                    *(u32x4*)(hid + (size_t)(u.aux * BM + r) * FF + u.pn * HALF + wc * 32 + 8 * fq) = w;
                }
            }
    }
};
struct EpiDown {
    static constexpr bool PERM = true;
    bf16* yp; const float* gw; const int* counts; const int* elist;
    __device__ __forceinline__ void operator()(const f32x4 (&acc)[2][2][4][2], const Unit& u, int wr, int wc, int fr, int fq) const {
        const int cnt = counts[u.e];
#pragma unroll
        for (int ai = 0; ai < 2; ++ai)
#pragma unroll
            for (int m = 0; m < 4; ++m) {
                const int r = ai * HALF + wr * 64 + m * 16 + fr, pos = u.pm * BM + r;
                if (pos < cnt) {
                    const int pair = elist[u.e * T + pos]; const float gv = gw[pair];
                    bf16* rowp = yp + (size_t)pair * D + u.pn * BM + wc * 32 + 8 * fq;
#pragma unroll
                    for (int bj = 0; bj < 2; ++bj) { const f32x4 v0 = acc[ai][bj][m][0] * gv, v1 = acc[ai][bj][m][1] * gv;
                        u32x4 w; w.x = pk2(v0.x, v0.y); w.y = pk2(v0.z, v0.w); w.z = pk2(v1.x, v1.y); w.w = pk2(v1.z, v1.w);
                        *(u32x4*)(rowp + bj * HALF) = w; }
                }
            }
    }
};
}


__device__ __forceinline__ int opaque_tid() { int t = threadIdx.x; asm volatile("" : "+v"(t)); return t; }
typedef float f32x16 __attribute__((ext_vector_type(16)));
typedef short s16x4 __attribute__((ext_vector_type(4)));
__device__ __forceinline__ int crow(int r, int hi) { return (r & 3) + 8 * (r >> 2) + 4 * hi; }
__device__ __forceinline__ s16x4 lds_tr(LAS unsigned char* p) { return __builtin_bit_cast(s16x4, __builtin_amdgcn_ds_read_tr16_b64_v4i16((LAS s16x4*)p)); }
constexpr int VST_PITCH = 144, VST_BYTES = 32 * VST_PITCH;
template <int W> __device__ __forceinline__ void attn_tile(const bf16* __restrict__ Qp, size_t qstride, const bf16* __restrict__ Kp, const bf16* __restrict__ Vp, size_t kvstride, int q0,
                                                          LAS unsigned char* vst, float sinkv, f32x16 (&o)[2], float& m_out, float& l_out, const int lane) {
    const int r32 = lane & 31, hi = lane >> 5;
    bf16x8 qf[4];
#pragma unroll
    for (int d0 = 0; d0 < 4; ++d0) qf[d0] = *(const bf16x8*)(Qp + (size_t)r32 * qstride + d0 * 16 + hi * 8);
    f32x16 sc[5];
#pragma unroll
    for (int c = 0; c < 5; ++c) {
        int ki = q0 - 128 + 32 * c + r32; ki = ki < 0 ? 0 : ki;
        const bf16* kp = Kp + (size_t)ki * kvstride + hi * 8;
        f32x16 acc = {};
#pragma unroll
        for (int d0 = 0; d0 < 4; ++d0) { const bf16x8 kf = *(const bf16x8*)(kp + d0 * 16); acc = __builtin_amdgcn_mfma_f32_32x32x16_bf16(kf, qf[d0], acc, 0, 0, 0); }
        sc[c] = acc;
    }
    float m = sinkv;
#pragma unroll
    for (int c = 0; c < 5; ++c)
#pragma unroll
        for (int r = 0; r < 16; ++r) {
            const int kk = 32 * c + crow(r, hi), rel = 128 + r32 - kk;
            const bool ok = (rel >= 0) && (rel <= W) && (q0 - 128 + kk >= 0);
            const float v = ok ? sc[c][r] : -INFINITY; sc[c][r] = v; m = fmaxf(m, v);
        }
    m = fmaxf(m, __shfl_xor(m, 32));
    float l = 0.f;
#pragma unroll
    for (int c = 0; c < 5; ++c)
#pragma unroll
        for (int r = 0; r < 16; ++r) { const float pv = __builtin_amdgcn_exp2f(sc[c][r] - m); sc[c][r] = pv; l += pv; }
    l += __shfl_xor(l, 32);
    l += __builtin_amdgcn_exp2f(sinkv - m);
    o[0] = (f32x16){}; o[1] = (f32x16){};
    const int vr = lane >> 1, vcb = (lane & 1) * 64;
    const int g16 = lane >> 4, q4 = (lane & 15) >> 2, p4 = lane & 3;
    LAS unsigned char* trbase = vst + (4 * (g16 >> 1) + q4) * VST_PITCH + (16 * (g16 & 1) + 4 * p4) * 2;
#pragma unroll
    for (int c = 0; c < 5; ++c) {
        LAS unsigned char* buf = vst + (c & 1) * VST_BYTES;
        int ki = q0 - 128 + 32 * c + vr; ki = ki < 0 ? 0 : ki;
        const u32x4* vp = (const u32x4*)((const unsigned char*)(Vp + (size_t)ki * kvstride) + vcb);
        u32x4 t0 = vp[0], t1 = vp[1], t2 = vp[2], t3 = vp[3];
        LAS u32x4* wp = (LAS u32x4*)(buf + vr * VST_PITCH + vcb);
        wp[0] = t0; wp[1] = t1; wp[2] = t2; wp[3] = t3;
#pragma unroll
        for (int ks = 0; ks < 2; ++ks) {
            bf16x8 pb;
#pragma unroll
            for (int j = 0; j < 4; ++j) { const unsigned w = pk2(sc[c][8 * ks + 2 * j], sc[c][8 * ks + 2 * j + 1]); pb[2 * j] = (short)(w & 0xffffu); pb[2 * j + 1] = (short)(w >> 16); }
#pragma unroll
            for (int db = 0; db < 2; ++db) {
                LAS unsigned char* tp = trbase + (c & 1) * VST_BYTES + (16 * ks) * VST_PITCH + db * 64;
                const s16x4 lo = lds_tr(tp), hi4 = lds_tr(tp + 8 * VST_PITCH);
                const bf16x8 vf = {lo[0], lo[1], lo[2], lo[3], hi4[0], hi4[1], hi4[2], hi4[3]};
                o[db] = __builtin_amdgcn_mfma_f32_32x32x16_bf16(vf, pb, o[db], 0, 0, 0);
            }
        }
    }
    m_out = m; l_out = l;
}
__device__ __forceinline__ void f_swa(LAS unsigned char* lds, const bf16* __restrict__ Y1, const float* __restrict__ sinks, bf16* __restrict__ O) {
    const int tid = opaque_tid(), lane = tid & 63, wave = __builtin_amdgcn_readfirstlane(tid >> 6), r32 = lane & 31, hi = lane >> 5;
    LAS unsigned char* vst = lds + wave * (2 * VST_BYTES);
    for (int it = blockIdx.x; it < 1024; it += gridDim.x) {
        const int kvh = it & 1, qt = (it >> 1) & 255, b = it >> 9, hq = kvh * 8 + wave, q0 = qt * 32;
        const bf16* rowb = Y1 + (size_t)b * SEQ * IN1;
        f32x16 o[2]; float m, l;
        attn_tile<127>(rowb + (size_t)q0 * IN1 + hq * 64, IN1, rowb + 1024 + kvh * 64, rowb + 1152 + kvh * 64, IN1, q0, vst, sinks[hq] * 1.4426950408889634f, o, m, l, lane);
        const float inv = 1.0f / l;
        bf16* op = O + (size_t)(b * SEQ + q0 + r32) * D + hq * 64 + 4 * hi;
#pragma unroll
        for (int db = 0; db < 2; ++db)
#pragma unroll
            for (int g4 = 0; g4 < 4; ++g4) { u32x2 w; w.x = pk2(o[db][4 * g4] * inv, o[db][4 * g4 + 1] * inv); w.y = pk2(o[db][4 * g4 + 2] * inv, o[db][4 * g4 + 3] * inv);
                *(u32x2*)(op + 32 * db + 8 * g4) = w; }
    }
}


constexpr int OB_OFF = 73728, OB_PITCH = 136, LSE_OFF = 143360;
__device__ __forceinline__ void dil_item(LAS unsigned char* lds, const bf16* __restrict__ Y, bf16* __restrict__ A2, int item) {
    const int tid = opaque_tid(), lane = tid & 63, wave = __builtin_amdgcn_readfirstlane(tid >> 6), r32 = lane & 31, hi = lane >> 5;
    const int blk = item & 15, j = (item >> 4) & 3, b = item >> 6;
    LAS unsigned char* vst = lds + wave * (2 * VST_BYTES);
    LAS unsigned char* OB = lds + OB_OFF; LAS float* LSE = (LAS float*)(lds + LSE_OFF);
    const bf16* rowb = Y + (size_t)b * SEQ * IN0;
#pragma unroll 1
    for (int pass = 0; pass < 3; ++pass) {
        const int g = 2 - pass, dil = 1 << (2 * g), tpc = 16 >> (2 * g), h = g * 4 + j;
#pragma unroll 1
        for (int tt = 0; tt < 2; ++tt) {
            const int tile = wave + 8 * tt, r = tile / tpc, ti = tile % tpc;
            const int q0 = (blk * 512) / dil + 32 * ti;
            const bf16* base = rowb + (size_t)r * IN0;
            f32x16 o[2]; float m, l;
            attn_tile<128>(base + (size_t)q0 * dil * IN0 + 1024 + h * 64, (size_t)dil * IN0, base + 1792 + h * 64, base + 2560 + h * 64, (size_t)dil * IN0, q0, vst, -INFINITY, o, m, l, lane);
            const int tok = r + dil * (32 * ti + r32);
            float lse = m + __builtin_amdgcn_logf(l);
            float wb = 1.0f / l, wa = 0.f;
            if (pass > 0) {
                const float lp = LSE[tok], M = fmaxf(lp, lse);
                const float ea = __builtin_amdgcn_exp2f(lp - M), eb = __builtin_amdgcn_exp2f(lse - M), inv = 1.0f / (ea + eb);
                wa = ea * inv; wb = eb * inv / l; lse = M + __builtin_amdgcn_logf(ea + eb);
            }
            LAS unsigned char* ob = OB + tok * OB_PITCH + 8 * hi;
            bf16* gp = A2 + (size_t)(b * SEQ + blk * 512 + tok) * OUT0K + 512 + j * 64 + 4 * hi;
#pragma unroll
            for (int db = 0; db < 2; ++db)
#pragma unroll
                for (int g4 = 0; g4 < 4; ++g4) {
                    float v0 = o[db][4 * g4] * wb, v1 = o[db][4 * g4 + 1] * wb, v2 = o[db][4 * g4 + 2] * wb, v3 = o[db][4 * g4 + 3] * wb;
                    LAS u32x2* q = (LAS u32x2*)(ob + 64 * db + 16 * g4);
                    if (pass > 0) { const u32x2 pw = *q;
                        v0 += wa * __uint_as_float(pw.x << 16); v1 += wa * __uint_as_float(pw.x & 0xffff0000u); v2 += wa * __uint_as_float(pw.y << 16); v3 += wa * __uint_as_float(pw.y & 0xffff0000u); }
                    u32x2 w; w.x = pk2(v0, v1); w.y = pk2(v2, v3);
                    if (pass < 2) *q = w; else *(u32x2*)(gp + 32 * db + 8 * g4) = w;
                }
            if (pass < 2) LSE[tok] = lse;
        }
        __syncthreads();
    }
}
__device__ __forceinline__ void sgu_item(LAS unsigned char* lds, const bf16* __restrict__ Y, const float* __restrict__ vss, const float* __restrict__ gn, const float* __restrict__ w, const float* __restrict__ bs,
                                         bf16* __restrict__ A2, int cidx) {
    const int tid = opaque_tid(), lane = tid & 63, g = __builtin_amdgcn_readfirstlane(tid >> 6), r32 = lane & 31, hi = lane >> 5;
    LAS unsigned char* vst = lds + g * (2 * VST_BYTES);
    const int r0 = cidx * 128;
    f32x16 acc[4][2];
#pragma unroll
    for (int a = 0; a < 4; ++a) { acc[a][0] = (f32x16){}; acc[a][1] = (f32x16){}; }
    const int vr = lane >> 1, vhalf = lane & 1;
    const int g16 = lane >> 4, q4 = (lane & 15) >> 2, p4 = lane & 3;
    LAS unsigned char* trbase = vst + (4 * (g16 >> 1) + q4) * VST_PITCH + (16 * (g16 & 1) + 4 * p4) * 2;
#pragma unroll
    for (int sc = 0; sc < 4; ++sc) {
        LAS unsigned char* buf = vst + (sc & 1) * VST_BYTES;
        {
            const int row = r0 + 32 * sc + vr;
            const f32x4 p0 = *(const f32x4*)(vss + (size_t)row * 8), p1 = *(const f32x4*)(vss + (size_t)row * 8 + 4);
            const float rs = 1.0f / sqrtf(((p0.x + p0.y) + (p0.z + p0.w) + (p1.x + p1.y) + (p1.z + p1.w)) * (1.0f / 512.0f) + EPS);
            const u32x4* vp = (const u32x4*)(Y + (size_t)row * IN0 + 512 + g * 64 + 32 * vhalf);
            const float* gp = gn + g * 64 + 32 * vhalf;
            LAS u32x4* wp = (LAS u32x4*)(buf + vr * VST_PITCH + 64 * vhalf);
#pragma unroll
            for (int i = 0; i < 4; ++i) { const u32x4 t = vp[i]; const f32x4 ga = *(const f32x4*)(gp + 8 * i), gb = *(const f32x4*)(gp + 8 * i + 4); u32x4 o;
                o.x = pk2(__uint_as_float(t.x << 16) * rs * ga.x, __uint_as_float(t.x & 0xffff0000u) * rs * ga.y);
                o.y = pk2(__uint_as_float(t.y << 16) * rs * ga.z, __uint_as_float(t.y & 0xffff0000u) * rs * ga.w);
                o.z = pk2(__uint_as_float(t.z << 16) * rs * gb.x, __uint_as_float(t.z & 0xffff0000u) * rs * gb.y);
                o.w = pk2(__uint_as_float(t.w << 16) * rs * gb.z, __uint_as_float(t.w & 0xffff0000u) * rs * gb.w);
                wp[i] = o; }
        }
#pragma unroll
        for (int ks = 0; ks < 2; ++ks) {
            bf16x8 vf[2];
#pragma unroll
            for (int db = 0; db < 2; ++db) { LAS unsigned char* tp = trbase + (sc & 1) * VST_BYTES + (16 * ks) * VST_PITCH + db * 64;
                const s16x4 lo = lds_tr(tp), hi4 = lds_tr(tp + 8 * VST_PITCH); vf[db] = (bf16x8){lo[0], lo[1], lo[2], lo[3], hi4[0], hi4[1], hi4[2], hi4[3]}; }
#pragma unroll
            for (int tt = sc; tt < 4; ++tt) {
                const int t = 32 * tt + r32, s0 = 32 * sc + 16 * ks + 4 * hi;
                const float* wrow = w + ((size_t)(g * 128 + t) * 128 + s0);
                f32x4 w0 = *(const f32x4*)wrow, w1 = *(const f32x4*)(wrow + 8);
                if (tt == sc) {
                    w0.x = (s0 + 0 <= t) ? w0.x : 0.f; w0.y = (s0 + 1 <= t) ? w0.y : 0.f; w0.z = (s0 + 2 <= t) ? w0.z : 0.f; w0.w = (s0 + 3 <= t) ? w0.w : 0.f;
                    w1.x = (s0 + 8 <= t) ? w1.x : 0.f; w1.y = (s0 + 9 <= t) ? w1.y : 0.f; w1.z = (s0 + 10 <= t) ? w1.z : 0.f; w1.w = (s0 + 11 <= t) ? w1.w : 0.f;
                }
                const unsigned a0 = pk2(w0.x, w0.y), a1 = pk2(w0.z, w0.w), a2 = pk2(w1.x, w1.y), a3 = pk2(w1.z, w1.w);
                const bf16x8 wf = {(short)(a0 & 0xffffu), (short)(a0 >> 16), (short)(a1 & 0xffffu), (short)(a1 >> 16), (short)(a2 & 0xffffu), (short)(a2 >> 16), (short)(a3 & 0xffffu), (short)(a3 >> 16)};
#pragma unroll
                for (int db = 0; db < 2; ++db) acc[tt][db] = __builtin_amdgcn_mfma_f32_32x32x16_bf16(vf[db], wf, acc[tt][db], 0, 0, 0);
            }
        }
    }
#pragma unroll
    for (int tt = 0; tt < 4; ++tt) {
        const int t = 32 * tt + r32; const float bias = bs[g * 128 + t];
        const size_t row = (size_t)(r0 + t);
        const bf16* up = Y + row * IN0 + g * 64 + 4 * hi; bf16* op = A2 + row * OUT0K + g * 64 + 4 * hi;
#pragma unroll
        for (int db = 0; db < 2; ++db)
#pragma unroll
            for (int g4 = 0; g4 < 4; ++g4) { const u32x2 uu = *(const u32x2*)(up + 32 * db + 8 * g4); u32x2 o;
                o.x = pk2((acc[tt][db][4 * g4] + bias) * __uint_as_float(uu.x << 16), (acc[tt][db][4 * g4 + 1] + bias) * __uint_as_float(uu.x & 0xffff0000u));
                o.y = pk2((acc[tt][db][4 * g4 + 2] + bias) * __uint_as_float(uu.y << 16), (acc[tt][db][4 * g4 + 3] + bias) * __uint_as_float(uu.y & 0xffff0000u));
                *(u32x2*)(op + 32 * db + 8 * g4) = o; }
    }
}
__device__ __forceinline__ void f_mixers0(LAS unsigned char* lds, const bf16* Y, const float* vss, const float* gn, const float* w, const float* bs, bf16* A2) {
    for (int id = blockIdx.x; id < 256; id += gridDim.x) {
        if (id < 128) dil_item(lds, Y, A2, id);
        else sgu_item(lds, Y, vss, gn, w, bs, A2, id - 128);
    }
}

__device__ __forceinline__ float gelu_tanh(float x) { const float u = 0.7978845608028654f * (x + 0.044715f * x * x * x); return 0.5f * x * (1.0f + tanhf(u)); }
__device__ void n_rowprep(const float* __restrict__ src, bf16* __restrict__ hb, float* __restrict__ rstd) {
    const int gw = blockIdx.x * NWAVES + (threadIdx.x >> 6), lane = threadIdx.x & 63, nw = gridDim.x * NWAVES;
    for (int r = gw; r < T; r += nw) {
        const float* p = src + (size_t)r * D; float s = 0.f;
        for (int c = lane; c < D; c += 64) { float v = p[c]; s += v * v; hb[(size_t)r * D + c] = f2bf(v); }
        for (int o = 1; o < 64; o <<= 1) s += __shfl_xor(s, o);
        if (lane == 0) rstd[r] = 1.0f / sqrtf(s * (1.0f / D) + EPS);
    }
}
__device__ void n_rope_tab(const int* __restrict__ pos, float* __restrict__ cs, float* __restrict__ sn) {
    for (int i = blockIdx.x * NTHR + threadIdx.x; i < T * 8; i += gridDim.x * NTHR) {
        const int t = i >> 3, f = i & 7;
        const float inv = powf(500000.0f, -(float)f / 8.0f);
        const float ang = (float)pos[t] * inv;
        const double rev = (double)ang * 0.15915494309189535;
        const float fr = (float)(rev - floor(rev));
        cs[i] = __builtin_amdgcn_cosf(fr); sn[i] = __builtin_amdgcn_sinf(fr);
    }
}
__device__ void n_gemm(LAS unsigned char* lds, const bf16* __restrict__ A, int lda, const float* __restrict__ W, int M, int N, int K, const float* __restrict__ gain,
                       const float* __restrict__ rowscale, const float* resid, bf16* __restrict__ outb, int ldo, float* outf) {
    const int half = threadIdx.x >> 8, tid = threadIdx.x & 255;
    LAS float* sA = (LAS float*)(lds + half * 16384); LAS float* sB = sA + 16 * 65;
    const int tx = tid & 15, ty = tid >> 4, ntn = N / 64, nvb = ntn * (M / 64);
    for (int it = 0; (it * (int)gridDim.x) * 2 < nvb; ++it) {
        const int vb = (it * gridDim.x + blockIdx.x) * 2 + half; const bool ok = vb < nvb;
        const int m0 = ok ? (vb / ntn) * 64 : 0, n0 = ok ? (vb % ntn) * 64 : 0;
        float acc[4][4] = {};
        for (int k0 = 0; k0 < K; k0 += 16) {
            for (int e = tid; e < 1024; e += 256) { const int r = e >> 4, c = e & 15; sA[c * 65 + r] = bf2f(A[(size_t)(m0 + r) * lda + k0 + c]); }
            for (int e = tid; e < 1024; e += 256) { const int r = e >> 6, c = e & 63; sB[r * 65 + c] = W[(size_t)(k0 + r) * N + n0 + c] * (gain ? gain[k0 + r] : 1.0f); }
            __syncthreads();
#pragma unroll
            for (int k = 0; k < 16; ++k) {
                float a[4], b[4];
#pragma unroll
                for (int i = 0; i < 4; ++i) { a[i] = sA[k * 65 + ty * 4 + i]; b[i] = sB[k * 65 + tx * 4 + i]; }
#pragma unroll
                for (int i = 0; i < 4; ++i)
#pragma unroll
                    for (int j = 0; j < 4; ++j) acc[i][j] += a[i] * b[j];
            }
            __syncthreads();
        }
        if (ok)
#pragma unroll
        for (int i = 0; i < 4; ++i)
#pragma unroll
            for (int j = 0; j < 4; ++j) {
            const int m = m0 + ty * 4 + i, n = n0 + tx * 4 + j; float v = acc[i][j];
            if (rowscale) v *= rowscale[m];
            if (resid) v += resid[(size_t)m * N + n];
            if (outb) outb[(size_t)m * ldo + n] = f2bf(v);
            if (outf) outf[(size_t)m * N + n] = v;
        }
    }
}
__device__ void n_post(LAS unsigned char* lds, bf16* __restrict__ Y, int ld, int ngelu, int nq, int nk, float* __restrict__ vss, const float* __restrict__ cs, const float* __restrict__ sn,
                       const float* __restrict__ qn, const float* __restrict__ kn) {
    const int half = threadIdx.x >> 8, tid = threadIdx.x & 255;
    LAS float* red = (LAS float*)(lds + half * 16384); LAS float* hv = red + 256;
    const int nqk = (nq + nk) * 64;
    for (int it = 0; it * (int)gridDim.x * 2 < T; ++it) {
        const int t = (it * gridDim.x + blockIdx.x) * 2 + half; bf16* y = Y + (size_t)t * ld;
        if (ngelu) {
            float ss = 0.f;
            for (int c = tid; c < ngelu; c += 256) { float g = gelu_tanh(bf2f(y[c])); bf16 gb = f2bf(g); y[c] = gb; if (c >= ngelu / 2) { float gr = bf2f(gb); ss += gr * gr; } }
            red[tid] = ss; __syncthreads();
            for (int o = 128; o > 0; o >>= 1) { if (tid < o) red[tid] += red[tid + o]; __syncthreads(); }
            if (tid < 8) vss[(size_t)t * 8 + tid] = (tid == 0) ? red[0] : 0.f;
        }
        __syncthreads();
        for (int c = tid; c < nqk; c += 256) hv[c] = bf2f(y[ngelu + c]);
        __syncthreads();
        for (int c = tid; c < nqk; c += 256) {
            const int h = c >> 6, d = c & 63; const bool isq = h < nq; const float* gn = isq ? qn : kn;
            float s = 0.f; for (int j = 0; j < 64; ++j) { float v = hv[h * 64 + j]; s += v * v; }
            const float rs = 1.0f / sqrtf(s * (1.0f / 64.0f) + EPS);
            float o = hv[c] * rs * gn[d];
            if (d < 16) { const int f = d & 7; const float co = cs[t * 8 + f], si = sn[t * 8 + f];
                const float x1 = hv[h * 64 + f] * rs * gn[f], x2 = hv[h * 64 + 8 + f] * rs * gn[8 + f];
                o = (d < 8) ? (x1 * co - x2 * si) : (x2 * co + x1 * si); }
            if (isq) o *= QSCALE;
            y[ngelu + c] = f2bf(o);
        }
        __syncthreads();
    }
}
__device__ void n_sgu(const bf16* __restrict__ Y, const float* __restrict__ vss, const float* __restrict__ gn, const float* __restrict__ w, const float* __restrict__ bs, bf16* __restrict__ A2) {
    for (int i = blockIdx.x * NTHR + threadIdx.x; i < T * 512; i += gridDim.x * NTHR) {
        const int row = i >> 9, ch = i & 511, g = ch >> 6, tt = row & 127, r0 = row - tt;
        float acc = 0.f;
        for (int s = 0; s <= tt; ++s) {
            const int rs_ = r0 + s; float sum = 0.f; for (int j = 0; j < 8; ++j) sum += vss[(size_t)rs_ * 8 + j];
            const float rstd = 1.0f / sqrtf(sum * (1.0f / 512.0f) + EPS);
            const float v = bf2f(f2bf(bf2f(Y[(size_t)rs_ * IN0 + 512 + ch]) * rstd * gn[ch]));
            acc += bf2f(f2bf(w[(g * 128 + tt) * 128 + s])) * v;
        }
        acc += bs[g * 128 + tt];
        A2[(size_t)row * OUT0K + ch] = f2bf(bf2f(Y[(size_t)row * IN0 + ch]) * acc);
    }
}
__device__ void n_dil(const bf16* __restrict__ Y, bf16* __restrict__ A2) {
    const int d = threadIdx.x & 63;
    for (int i = blockIdx.x * NWAVES + (threadIdx.x >> 6); i < T * 4; i += gridDim.x * NWAVES) {
        const int row = i >> 2, j = i & 3, b = row / SEQ, t = row % SEQ;
        float m = -INFINITY, l = 0.f, o = 0.f;
        for (int g = 0; g < 3; ++g) {
            const int dil = (g == 0) ? 1 : (g == 1 ? 4 : 16), h = g * 4 + j;
            const float q = bf2f(Y[(size_t)row * IN0 + 1024 + h * 64 + d]);
            for (int n = 0; n <= 128; ++n) {
                const int tk = t - n * dil; if (tk < 0) break;
                const size_t kr = (size_t)(b * SEQ + tk) * IN0;
                float s = q * bf2f(Y[kr + 1792 + h * 64 + d]);
                for (int x = 1; x < 64; x <<= 1) s += __shfl_xor(s, x);
                const float mn = fmaxf(m, s), a = exp2f(m - mn), p = exp2f(s - mn);
                l = l * a + p; o = o * a + p * bf2f(Y[kr + 2560 + h * 64 + d]);
                m = mn;
            }
        }
        A2[(size_t)row * OUT0K + 512 + j * 64 + d] = f2bf(o / l);
    }
}
__device__ void n_swa(const bf16* __restrict__ Y, const float* __restrict__ sinks, bf16* __restrict__ O) {
    const int d = threadIdx.x & 63;
    for (int i = blockIdx.x * NWAVES + (threadIdx.x >> 6); i < T * 16; i += gridDim.x * NWAVES) {
        const int row = i >> 4, h = i & 15, kvh = h >> 3, b = row / SEQ, t = row % SEQ;
        const float q = bf2f(Y[(size_t)row * IN1 + h * 64 + d]);
        float m = sinks[h] * 1.4426950408889634f, l = 1.0f, o = 0.f;
        for (int n = 0; n < 128; ++n) {
            const int tk = t - n; if (tk < 0) break;
            const size_t kr = (size_t)(b * SEQ + tk) * IN1;
            float s = q * bf2f(Y[kr + 1024 + kvh * 64 + d]);
            for (int x = 1; x < 64; x <<= 1) s += __shfl_xor(s, x);
            const float mn = fmaxf(m, s), a = exp2f(m - mn), p = exp2f(s - mn);
            l = l * a + p; o = o * a + p * bf2f(Y[kr + 1152 + kvh * 64 + d]);
            m = mn;
        }
        O[(size_t)row * D + h * 64 + d] = f2bf(o / l);
    }
}
__device__ void n_router(const float* h, const float* __restrict__ gf, const float* __restrict__ wrg, const float* __restrict__ brg, const float* __restrict__ wre, const float* __restrict__ bre,
                         bf16* __restrict__ hb, float* __restrict__ rstd, int* __restrict__ eid, float* __restrict__ gw, int* counts, int* __restrict__ elist) {
    const int gwv = blockIdx.x * NWAVES + (threadIdx.x >> 6), lane = threadIdx.x & 63, nw = gridDim.x * NWAVES;
    for (int r = gwv; r < T; r += nw) {
        const float* p = h + (size_t)r * D; float s = 0.f;
        for (int c = lane; c < D; c += 64) { float v = p[c]; s += v * v; hb[(size_t)r * D + c] = f2bf(v); }
        for (int o = 1; o < 64; o <<= 1) s += __shfl_xor(s, o);
        const float rs = 1.0f / sqrtf(s * (1.0f / D) + EPS);
        float lg[4] = {0.f, 0.f, 0.f, 0.f};
        for (int c = lane; c < D; c += 64) { const float xn = p[c] * rs * gf[c];
#pragma unroll
            for (int g = 0; g < 4; ++g) lg[g] += xn * wrg[c * 4 + g]; }
#pragma unroll
        for (int g = 0; g < 4; ++g) { for (int o = 1; o < 64; o <<= 1) lg[g] += __shfl_xor(lg[g], o); lg[g] += brg[g]; }
        int gi = 0; float lmax = lg[0];
#pragma unroll
        for (int g = 1; g < 4; ++g) if (lg[g] > lmax) { lmax = lg[g]; gi = g; }
        float zs = 0.f;
#pragma unroll
        for (int g = 0; g < 4; ++g) zs += expf(lg[g] - lmax);
        const float ptop = 1.0f / zs;
        float le[8] = {0.f, 0.f, 0.f, 0.f, 0.f, 0.f, 0.f, 0.f};
        for (int c = lane; c < D; c += 64) { const float xn = p[c] * rs * gf[c];
#pragma unroll
            for (int e = 0; e < 8; ++e) le[e] += xn * wre[((size_t)gi * D + c) * 8 + e]; }
#pragma unroll
        for (int e = 0; e < 8; ++e) { for (int o = 1; o < 64; o <<= 1) le[e] += __shfl_xor(le[e], o); le[e] += bre[gi * 8 + e]; }
        int i0 = 0; float l0 = le[0];
#pragma unroll
        for (int e = 1; e < 8; ++e) if (le[e] > l0) { l0 = le[e]; i0 = e; }
        int i1 = -1; float l1 = -INFINITY;
#pragma unroll
        for (int e = 0; e < 8; ++e) if (e != i0 && le[e] > l1) { l1 = le[e]; i1 = e; }
        const float r1 = expf(l1 - l0); const float g0 = ptop / (1.0f + r1), g1 = ptop * r1 / (1.0f + r1);
        if (lane == 0) {
            rstd[r] = rs; const int e0 = gi * 8 + i0, e1 = gi * 8 + i1;
            eid[r * 2] = e0; eid[r * 2 + 1] = e1; gw[r * 2] = g0; gw[r * 2 + 1] = g1;
            const int p0 = atomicAdd(&counts[e0], 1); elist[e0 * T + p0] = r * 2;
            const int p1 = atomicAdd(&counts[e1], 1); elist[e1 * T + p1] = r * 2 + 1;
        }
    }
}
__device__ __forceinline__ bool slot_lookup(const int* counts, int slot, int& e, int& pos) {
    int base = 0; e = -1; pos = 0; bool ok = false;
    for (int x = 0; x < NE; ++x) { const int c = counts[x], pc = (c + 255) & ~255; if (e < 0 && slot < base + pc) { e = x; pos = slot - base; ok = pos < c; } base += pc; }
    if (e < 0) e = 0;
    return ok;
}
__device__ void n_gateup(LAS unsigned char* lds, const bf16* __restrict__ hb, const float* __restrict__ rstd, const float* __restrict__ gf, const float* __restrict__ wg, const float* __restrict__ wu,
                         const int* counts, const int* elist, bf16* __restrict__ hid) {
    const int half = threadIdx.x >> 8, j = threadIdx.x & 255; LAS float* xs = (LAS float*)(lds + half * 16384);
    for (int it = 0; it * (int)gridDim.x * 2 < SLOT_CAP; ++it) {
        const int slot = (it * gridDim.x + blockIdx.x) * 2 + half; int e, pos; const bool ok = slot_lookup(counts, slot, e, pos);
        const int pair = ok ? elist[e * T + pos] : 0, t = pair >> 1;
        for (int c = j; c < D; c += 256) xs[c] = bf2f(hb[(size_t)t * D + c]);
        __syncthreads();
        if (ok) {
            float g = 0.f, u = 0.f; const float* pg = wg + (size_t)e * D * FF + j; const float* pu = wu + (size_t)e * D * FF + j;
            for (int k = 0; k < D; ++k) { const float gk = gf[k]; g += xs[k] * bf2f(f2bf(pg[(size_t)k * FF] * gk)); u += xs[k] * bf2f(f2bf(pu[(size_t)k * FF] * gk)); }
            const float rs = rstd[t]; g *= rs; u *= rs;
            hid[(size_t)slot * FF + j] = f2bf(g / (1.0f + expf(-g)) * u);
        }
        __syncthreads();
    }
}
__device__ void n_down(LAS unsigned char* lds, const bf16* __restrict__ hid, const float* __restrict__ wd, const float* __restrict__ gw, const int* counts, const int* elist, bf16* __restrict__ yp) {
    const int half = threadIdx.x >> 8, tid = threadIdx.x & 255; LAS float* hs = (LAS float*)(lds + half * 16384);
    for (int it = 0; it * (int)gridDim.x * 2 < SLOT_CAP; ++it) {
        const int slot = (it * gridDim.x + blockIdx.x) * 2 + half; int e, pos; const bool ok = slot_lookup(counts, slot, e, pos);
        const int pair = ok ? elist[e * T + pos] : 0;
        hs[tid] = ok ? bf2f(hid[(size_t)slot * FF + tid]) : 0.f;
        __syncthreads();
        if (ok) {
            const float gwt = gw[pair];
            for (int n = tid; n < D; n += 256) {
                float a = 0.f; const float* p = wd + (size_t)e * FF * D + n;
                for (int k = 0; k < FF; ++k) a += hs[k] * bf2f(f2bf(p[(size_t)k * D]));
                yp[(size_t)pair * D + n] = f2bf(a * gwt);
            }
        }
        __syncthreads();
    }
}
__device__ void n_combine(float* h, const bf16* __restrict__ yp, bf16* __restrict__ hb, float* __restrict__ rstd) {
    const int gwv = blockIdx.x * NWAVES + (threadIdx.x >> 6), lane = threadIdx.x & 63, nw = gridDim.x * NWAVES;
    for (int r = gwv; r < T; r += nw) {
        float s = 0.f;
        for (int c = lane; c < D; c += 64) { const float v = h[(size_t)r * D + c] + bf2f(yp[(size_t)(2 * r) * D + c]) + bf2f(yp[(size_t)(2 * r + 1) * D + c]);
            h[(size_t)r * D + c] = v; s += v * v; if (hb) hb[(size_t)r * D + c] = f2bf(v); }
        for (int o = 1; o < 64; o <<= 1) s += __shfl_xor(s, o);
        if (rstd && lane == 0) rstd[r] = 1.0f / sqrtf(s * (1.0f / D) + EPS);
    }
}


__device__ __forceinline__ void cvt_experts(const float* wg, const float* wu, const float* wd, const float* gain, bf16* WGU, bf16* WDT, LAS unsigned char* lds) {
    const int lane = threadIdx.x & 63, wave = threadIdx.x >> 6;
    LAS float* scr = (LAS float*)(lds + wave * 9216);
    const int gwv = blockIdx.x * NWAVES + wave, NGW = gridDim.x * NWAVES;
    const CvtFam g0{wg, WGU, gain, D, FF, NE, 2, 512};
    const CvtFam g1{wu, WGU, gain, D, FF, NE, 3, 512};
    const CvtFam g2{wd, WDT, nullptr, FF, D, NE, 0, 1024};
    const int n0 = cvt_fam_items(g0), n1 = n0 + cvt_fam_items(g1), n2 = n1 + cvt_fam_items(g2);
    for (int it = gwv; it < n2; it += NGW) {
        if (it < n0) cvt_fam_run(g0, it, scr, lane);
        else if (it < n1) cvt_fam_run(g1, it - n0, scr, lane);
        else cvt_fam_run(g2, it - n1, scr, lane);
    }
}

enum { A_X, A_POS, A_NMIX, A_NFFN, A_WINE, A_WOUTE, A_SGUN, A_SGUW, A_SGUB, A_QND, A_KND, A_WINO, A_WOUTO, A_QNS, A_KNS, A_SINK, A_WRG, A_BRG, A_WRE, A_BRE, A_WG, A_WU, A_WD, A_OUT, A_WS, A_N };
struct Args { const void* p[A_N]; };
constexpr int LDS_ARGS = LDS_MISC + 1024;
__device__ __forceinline__ const void* ldarg(int i) {
    volatile LAS unsigned* q = (volatile LAS unsigned*)((LAS unsigned char*)0 + LDS_ARGS) + 2 * i;
    const unsigned lo = __builtin_amdgcn_readfirstlane(q[0]), hi = __builtin_amdgcn_readfirstlane(q[1]);
    return (const void*)(((unsigned long long)hi << 32) | lo);
}
#define ARGF(i) ((const float*)ldarg(i))
#define WSP(T, off) ((T*)((unsigned char*)ldarg(A_WS) + (off)))
__device__ __forceinline__ void grid_bar() {
    XcdBarrier b; b.bar = WSP(unsigned, WS_CTL) + CW_BAR; b.x = xb_xcc_id(); b.st = (volatile LAS unsigned*)((LAS unsigned char*)0 + LDS_MISC) + 8;
    xcd_barrier(b);
}
__device__ __forceinline__ void moe_phases(LAS unsigned char* lds, int cofs) {
    volatile LAS int* tb = (volatile LAS int*)(lds + LDS_MISC + 256);
    pg8::moe_setup(tb, WSP(int, WS_CTL) + cofs);
    {
        pg8::MoeOrder<2, true> S{tb, WSP(int, WS_CTL) + cofs, WSP(int, WS_ELIST), (int)gridDim.x, (int)blockIdx.x, D, 512, WSP(bf16, WS_WGU)};
        pg8::EpiGU E{WSP(bf16, WS_HID), WSP(float, WS_RSTD), WSP(int, WS_CTL) + cofs, WSP(int, WS_ELIST)};
        pg8::gemm_phase<pg8::EpiGU, pg8::MoeOrder<2, true>, true>(lds, WSP(bf16, WS_HB), D, S, E);
    }
    grid_bar();
    {
        pg8::MoeOrder<4, false> S{tb, WSP(int, WS_CTL) + cofs, WSP(int, WS_ELIST), (int)gridDim.x, (int)blockIdx.x, FF, 1024, WSP(bf16, WS_WD)};
        pg8::EpiDown E{WSP(bf16, WS_YP), WSP(float, WS_GW), WSP(int, WS_CTL) + cofs, WSP(int, WS_ELIST)};
        pg8::gemm_phase<pg8::EpiDown, pg8::MoeOrder<4, false>, true>(lds, WSP(bf16, WS_HID), FF, S, E);
    }
}
__global__ void __launch_bounds__(NTHR, 2) mega_fwd(Args a) {
    extern __shared__ __attribute__((aligned(16))) unsigned char lds_raw[];
    LAS unsigned char* lds = (LAS unsigned char*)lds_raw;
    {
        volatile LAS unsigned* MISC = (volatile LAS unsigned*)(lds + LDS_MISC);
        if (threadIdx.x < 64) MISC[threadIdx.x] = 0u;
        if (threadIdx.x < 2 * A_N) ((volatile LAS unsigned*)(lds + LDS_ARGS))[threadIdx.x] = ((const unsigned*)&a)[threadIdx.x];
        __syncthreads();
        (void)xcd_barrier_post(WSP(unsigned, WS_CTL) + CW_BAR, MISC + 8);
    }
    constexpr size_t SN_OFF = WS_CS + (size_t)T * 8 * 4;
    constexpr size_t EW1 = (size_t)NE * D * FF;
    {
        const int lane = threadIdx.x & 63, wave = threadIdx.x >> 6;
        LAS float* scr = (LAS float*)(lds + wave * 9216);
        const int gwv = blockIdx.x * NWAVES + wave, NGW = gridDim.x * NWAVES;
        const CvtFam f0{ARGF(A_WINE), WSP(bf16, WS_WIN0), ARGF(A_NMIX), D, IN0, 1, 1, 0};
        const CvtFam f1{ARGF(A_WOUTE), WSP(bf16, WS_WOUT0), nullptr, OUT0K, D, 1, 0, 0};
        const CvtFam f2{ARGF(A_WINO), WSP(bf16, WS_WIN1), ARGF(A_NMIX) + D, D, IN1, 1, 1, 0};
        const CvtFam f3{ARGF(A_WOUTO), WSP(bf16, WS_WOUT1), nullptr, D, D, 1, 0, 0};
        const int n0 = cvt_fam_items(f0), n1 = n0 + cvt_fam_items(f1), n2 = n1 + cvt_fam_items(f2), n3 = n2 + cvt_fam_items(f3);
        for (int it = gwv; it < n3; it += NGW) {
            if (it < n0) cvt_fam_run(f0, it, scr, lane);
            else if (it < n1) cvt_fam_run(f1, it - n0, scr, lane);
            else if (it < n2) cvt_fam_run(f2, it - n1, scr, lane);
            else cvt_fam_run(f3, it - n2, scr, lane);
        }
    }
    cvt_experts(ARGF(A_WG), ARGF(A_WU), ARGF(A_WD), ARGF(A_NFFN), WSP(bf16, WS_WGU), WSP(bf16, WS_WD), lds);
    n_rope_tab((const int*)ldarg(A_POS), WSP(float, WS_CS), WSP(float, SN_OFF));
    f_rowprep(ARGF(A_X), WSP(bf16, WS_HB), WSP(float, WS_RSTD));
    grid_bar();
    {
        pg8::DenseOrder S; S.init(T, IN0, D, WSP(bf16, WS_WIN0), gridDim.x, blockIdx.x);
        pg8::EpiIn<0> E{WSP(bf16, WS_Y), WSP(float, WS_RSTD), WSP(float, WS_VSS), WSP(float, WS_CS), WSP(float, SN_OFF), ARGF(A_QND), ARGF(A_KND)};
        pg8::gemm_phase<pg8::EpiIn<0>, pg8::DenseOrder, true>(lds, WSP(bf16, WS_HB), D, S, E);
    }
    grid_bar();
    f_mixers0(lds, WSP(bf16, WS_Y), WSP(float, WS_VSS), ARGF(A_SGUN), ARGF(A_SGUW), ARGF(A_SGUB), WSP(bf16, WS_A2));
    grid_bar();
    {
        pg8::DenseOrder S; S.init(T, D, OUT0K, WSP(bf16, WS_WOUT0), gridDim.x, blockIdx.x);
        pg8::EpiRes E{ARGF(A_X), (float*)ldarg(A_OUT)};
        pg8::gemm_phase<pg8::EpiRes, pg8::DenseOrder, true>(lds, WSP(bf16, WS_A2), OUT0K, S, E);
    }
    grid_bar();
    n_router((float*)ldarg(A_OUT), ARGF(A_NFFN), ARGF(A_WRG), ARGF(A_BRG), ARGF(A_WRE), ARGF(A_BRE), WSP(bf16, WS_HB), WSP(float, WS_RSTD), WSP(int, WS_EID), WSP(float, WS_GW), WSP(int, WS_CTL), WSP(int, WS_ELIST));
    grid_bar();
    moe_phases(lds, 0);
    grid_bar();
    n_combine((float*)ldarg(A_OUT), WSP(bf16, WS_YP), WSP(bf16, WS_HB), WSP(float, WS_RSTD));
    cvt_experts(ARGF(A_WG) + EW1, ARGF(A_WU) + EW1, ARGF(A_WD) + EW1, ARGF(A_NFFN) + D, WSP(bf16, WS_WGU), WSP(bf16, WS_WD), lds);
    grid_bar();
    {
        pg8::DenseOrder S; S.init(T, IN1, D, WSP(bf16, WS_WIN1), gridDim.x, blockIdx.x);
        pg8::EpiIn<1> E{WSP(bf16, WS_Y1), WSP(float, WS_RSTD), nullptr, WSP(float, WS_CS), WSP(float, SN_OFF), ARGF(A_QNS), ARGF(A_KNS)};
        pg8::gemm_phase<pg8::EpiIn<1>, pg8::DenseOrder, true>(lds, WSP(bf16, WS_HB), D, S, E);
    }
    grid_bar();
    f_swa(lds, WSP(bf16, WS_Y1), ARGF(A_SINK), WSP(bf16, WS_A2));
    grid_bar();
    {
        pg8::DenseOrder S; S.init(T, D, D, WSP(bf16, WS_WOUT1), gridDim.x, blockIdx.x);
        pg8::EpiRes E{(const float*)ldarg(A_OUT), (float*)ldarg(A_OUT)};
        pg8::gemm_phase<pg8::EpiRes, pg8::DenseOrder, true>(lds, WSP(bf16, WS_A2), D, S, E);
    }
    grid_bar();
    n_router((float*)ldarg(A_OUT), ARGF(A_NFFN) + D, ARGF(A_WRG) + D * 4, ARGF(A_BRG) + 4, ARGF(A_WRE) + (size_t)4 * D * 8, ARGF(A_BRE) + 32, WSP(bf16, WS_HB), WSP(float, WS_RSTD), WSP(int, WS_EID), WSP(float, WS_GW), WSP(int, WS_CTL) + 64, WSP(int, WS_ELIST));
    grid_bar();
    moe_phases(lds, 64);
    grid_bar();
    n_combine((float*)ldarg(A_OUT), WSP(bf16, WS_YP), nullptr, nullptr);
}

extern "C" void kernel_launch(void* const* d_in, const int* in_sizes, int n_in, void* d_out, int out_size, void* d_ws, size_t ws_size, hipStream_t stream) {
    static int grid = 0;
    if (grid == 0) {
        int dev = 0, cus = 0, per_cu = 0;
        if (hipGetDevice(&dev) != hipSuccess || hipDeviceGetAttribute(&cus, hipDeviceAttributeMultiprocessorCount, dev) != hipSuccess) { fprintf(stderr, "kernel_launch: device query failed\n"); grid = -1; return; }
        if (hipFuncSetAttribute((const void*)mega_fwd, hipFuncAttributeMaxDynamicSharedMemorySize, LDS_BYTES) != hipSuccess) { fprintf(stderr, "kernel_launch: hipFuncSetAttribute failed\n"); grid = -1; return; }
        if (hipOccupancyMaxActiveBlocksPerMultiprocessor(&per_cu, (const void*)mega_fwd, NTHR, LDS_BYTES) != hipSuccess || per_cu < 1) { fprintf(stderr, "kernel_launch: occupancy query says %d blocks/CU\n", per_cu); grid = -1; (void)hipGetLastError(); return; }
        grid = cus;
    }
    if (grid < 0) return;
    if (hipMemsetAsync((char*)d_ws + WS_CTL, 0, MiB, stream) != hipSuccess) return;
    Args a{};
    for (int i = 0; i < 23; ++i) a.p[i] = d_in[i];
    a.p[A_OUT] = d_out; a.p[A_WS] = d_ws;
    hipLaunchKernelGGL(mega_fwd, dim3(grid), dim3(NTHR), LDS_BYTES, stream, a);
}
```

```cpp
#include <hip/hip_runtime.h>
#include <stdint.h>
#include <math.h>
#include <cstdio>

typedef unsigned short bf16;
__device__ __forceinline__ float bf2f(bf16 v) { return __uint_as_float((unsigned)v << 16); }
__device__ __forceinline__ bf16 f2bf(float f) { unsigned u = __float_as_uint(f); return (bf16)((u + 0x7fffu + ((u >> 16) & 1u)) >> 16); }

constexpr int T = 16384, SEQ = 8192, D = 1024;
constexpr int IN0 = 3328, OUT0K = 768, IN1 = 1280;
constexpr int NE = 32, FF = 256;
constexpr float EPS = 1e-6f;
constexpr float QSCALE = 0.125f * 1.4426950408889634f;
constexpr int SLOT_CAP = 40960;

constexpr size_t MiB = 1u << 20;
constexpr size_t WS_CTL = 0;
constexpr size_t WS_RSTD = 1 * MiB;
constexpr size_t WS_VSS = WS_RSTD + 65536;
constexpr size_t WS_CS = 2 * MiB;
constexpr size_t WS_EID = 3 * MiB;
constexpr size_t WS_GW = WS_EID + 131072;
constexpr size_t WS_ELIST = 4 * MiB;
constexpr size_t WS_RTAB = 6 * MiB;
constexpr size_t WS_WIN0 = 8 * MiB;
constexpr size_t WS_WOUT0 = 15 * MiB;
constexpr size_t WS_WIN1 = 17 * MiB;
constexpr size_t WS_WOUT1 = 20 * MiB;
constexpr size_t WS_WGU = 22 * MiB;
constexpr size_t WS_WD = 54 * MiB;
constexpr size_t WS_HB = 70 * MiB;
constexpr size_t WS_Y = 102 * MiB;
constexpr size_t WS_YP = 102 * MiB;
constexpr size_t WS_HID = 166 * MiB;
constexpr size_t WS_Y1 = 166 * MiB;
constexpr size_t WS_A2 = 206 * MiB;


#define REP_P0 1
#define REP_P1 1
#define REP_P2 1
#define REP_P3 1
#define REP_GU 1
#define REP_DN 1
#define REP_CVT1 1
#define REP_P5 1
#define REP_P6 1
#define PROBE_ROUTER 0
#define PROBE_COMBINE 0
#define PROBE_BARS 0
#define LAS __attribute__((address_space(3)))
constexpr int NTHR = 512, NWAVES = 8;
constexpr int LDS_BYTES = 147456;
constexpr int LDS_MISC = 145408;
constexpr int CW_BAR = 4096;

#define XB_TMO      128
#define XB_XCNT(j)  (256  + 64 * (j))
#define XB_XSUB(j)  (1280 + 64 * (j))
#define XB_XGEN(j)  (2304 + 64 * (j))
#define XB_TOP      3328
#define XB_TOPGEN   3392
#define XCD_BAR_WORDS 3456
#define XB_SPIN_CAP (1u << 20)
__device__ __forceinline__ unsigned xb_ld(unsigned* p)              { return __hip_atomic_load(p, __ATOMIC_RELAXED, __HIP_MEMORY_SCOPE_AGENT); }
__device__ __forceinline__ unsigned xb_add(unsigned* p, unsigned v) { return __hip_atomic_fetch_add(p, v, __ATOMIC_RELAXED, __HIP_MEMORY_SCOPE_AGENT); }
__device__ __forceinline__ unsigned xb_xcc_id() { return (unsigned)__builtin_amdgcn_s_getreg((3 << 11) | 20) & 0xFu; }
#define XB_SPIN(cond, bar) do { unsigned _sp = 0; while (cond) { __builtin_amdgcn_s_sleep(1); \
    if ((++_sp & 255u) == 0u) { if (xb_ld(&(bar)[XB_TMO])) break; if (_sp > XB_SPIN_CAP) { atomicAdd(&(bar)[XB_TMO], 1u); break; } } } } while (0)
struct XcdBarrier { unsigned* bar; unsigned x; volatile LAS unsigned* st; };
__device__ __forceinline__ XcdBarrier xcd_barrier_post(unsigned* bar, volatile LAS unsigned* st) {
    XcdBarrier b; b.bar = bar; b.x = xb_xcc_id(); b.st = st;
    if (threadIdx.x == 0) (void)xb_add(&bar[XB_XCNT(b.x)], 1u);
    return b;
}
__device__ __forceinline__ void xcd_barrier_complete(unsigned* bar, unsigned x, unsigned& nloc, unsigned& nx) {
    const unsigned G = gridDim.x * gridDim.y * gridDim.z;
    unsigned sum, cnt, mine, sp = 0u;
    for (;;) {
        sum = 0u; cnt = 0u; mine = 0u;
#pragma unroll
        for (unsigned j = 0; j < 16; ++j) { const unsigned c = xb_ld(&bar[XB_XCNT(j)]); sum += c; cnt += (c > 0u) ? 1u : 0u; mine = (j == x) ? c : mine; }
        if (sum == G) break;
        __builtin_amdgcn_s_sleep(1);
        if ((++sp & 255u) == 0u) { if (xb_ld(&bar[XB_TMO])) break; if (sp > XB_SPIN_CAP) { atomicAdd(&bar[XB_TMO], 1u); break; } }
    }
    nloc = mine > 0u ? mine : 1u; nx = cnt > 0u ? cnt : 1u;
}
__device__ __forceinline__ void xcd_barrier(const XcdBarrier& b) {
    asm volatile("s_waitcnt vmcnt(0)" ::: "memory");
    __syncthreads();
    if (threadIdx.x == 0) {
        unsigned* bar = b.bar;
        __builtin_amdgcn_s_waitcnt(0);
        unsigned nloc = b.st[0], nx = b.st[1];
        if (nloc == 0u) { xcd_barrier_complete(bar, b.x, nloc, nx); b.st[0] = nloc; b.st[1] = nx; }
        const unsigned old = xb_add(&bar[XB_XSUB(b.x)], 1u);
        const unsigned gen = old / nloc;
        if (old + 1u == (gen + 1u) * nloc) {
            __builtin_amdgcn_fence(__ATOMIC_RELEASE, "agent");
            asm volatile("s_waitcnt vmcnt(0)" ::: "memory");
            const unsigned og = xb_add(&bar[XB_TOP], 1u);
            const unsigned tg = og / nx;
            if (og + 1u == (tg + 1u) * nx) xb_add(&bar[XB_TOPGEN], 1u);
            else XB_SPIN(xb_ld(&bar[XB_TOPGEN]) == tg, bar);
            __builtin_amdgcn_fence(__ATOMIC_ACQUIRE, "agent");
            xb_add(&bar[XB_XGEN(b.x)], 1u);
            asm volatile("s_waitcnt vmcnt(0)" ::: "memory");
        } else {
            XB_SPIN(xb_ld(&bar[XB_XGEN(b.x)]) == gen, bar);
            __builtin_amdgcn_fence(__ATOMIC_ACQUIRE, "agent");
            asm volatile("s_waitcnt vmcnt(0)" ::: "memory");
        }
    }
    __syncthreads();
}


__device__ __forceinline__ int opaque_tid() { int t = threadIdx.x; asm volatile("" : "+v"(t)); return t; }
typedef short bf16x8 __attribute__((ext_vector_type(8)));
typedef float f32x4 __attribute__((ext_vector_type(4)));
typedef float f32x2 __attribute__((ext_vector_type(2)));
typedef unsigned u32x4 __attribute__((ext_vector_type(4)));
typedef unsigned u32x2 __attribute__((ext_vector_type(2)));
typedef __bf16 bf16x2_t __attribute__((ext_vector_type(2)));
__device__ __forceinline__ unsigned pk2(float lo, float hi) { f32x2 v = {lo, hi}; bf16x2_t b = __builtin_convertvector(v, bf16x2_t); return __builtin_bit_cast(unsigned, b); }
__device__ __forceinline__ float gelu_fast(float x) { const float u = x * (0.7978845608028654f + 0.0356774081363001f * x * x);
    return x * __builtin_amdgcn_rcpf(1.0f + __builtin_amdgcn_exp2f(-2.885390081777927f * u)); }

__device__ __forceinline__ void cvt_item(const float* __restrict__ W, int N, int k0, int n0, const float* __restrict__ gain, bf16* __restrict__ WT, int K, int drow0, LAS float* scr, int lane) {
#pragma unroll
    for (int i = 0; i < 8; ++i) {
        const int kk = i * 8 + (lane >> 3);
        f32x4 v = *(const f32x4*)(W + (size_t)(k0 + kk) * N + n0 + 4 * (lane & 7));
        if (gain) v = v * gain[k0 + kk];
        *(LAS f32x4*)(scr + kk * 36 + 4 * (lane & 7)) = v;
    }
    const int n = lane & 31;
#pragma unroll
    for (int cc = 0; cc < 4; ++cc) {
        const int c = (lane >> 5) * 4 + cc; const LAS float* q = scr + (8 * c) * 36 + n;
        u32x4 o; o.x = pk2(q[0], q[36]); o.y = pk2(q[72], q[108]); o.z = pk2(q[144], q[180]); o.w = pk2(q[216], q[252]);
        *(u32x4*)(WT + (size_t)(drow0 + n) * K + k0 + 8 * c) = o;
    }
}
__device__ __forceinline__ int inproj_pos(int n0) { return (n0 & ~255) | (((n0 >> 5) & 1) << 7) | (((n0 >> 6) & 3) << 5); }
__device__ __forceinline__ void cvt_matrix_items(const float* W, int K, int N, const float* gain, bf16* WT, int mode, int item, LAS float* scr, int lane) {
    const int nblk = N / 32, kb = item / nblk, nb = item % nblk, n0 = nb * 32;
    int d0 = n0;
    if (mode == 1) d0 = inproj_pos(n0);
    else if (mode == 2) d0 = 256 * (n0 >> 7) + (n0 & 127);
    else if (mode == 3) d0 = 256 * (n0 >> 7) + 128 + (n0 & 127);
    cvt_item(W, N, kb * 64, n0, gain, WT, K, d0, scr, lane);
}
struct CvtFam { const float* src; bf16* dst; const float* gain; int K, N, nmat, mode; int dstride_rows; };
__device__ __forceinline__ int cvt_fam_items(const CvtFam& f) { return f.nmat * (f.K / 64) * (f.N / 32); }
__device__ __forceinline__ void cvt_fam_run(const CvtFam& f, int item, LAS float* scr, int lane) {
    const int per = (f.K / 64) * (f.N / 32), e = item / per, it = item % per;
    cvt_matrix_items(f.src + (size_t)e * f.K * f.N, f.K, f.N, f.gain, f.dst + (size_t)e * f.dstride_rows * f.K, f.mode, it, scr, lane);
}

__device__ __forceinline__ float wave_sum(float v) {
#pragma unroll
    for (int o = 1; o < 64; o <<= 1) v += __shfl_xor(v, o);
    return v;
}
__device__ __forceinline__ void f_rowprep(const float* __restrict__ src, bf16* __restrict__ hb, float* __restrict__ rstd) {
    const int tid = opaque_tid(); const int gw = blockIdx.x * NWAVES + (tid >> 6), lane = tid & 63, nw = gridDim.x * NWAVES;
    for (int r = gw; r < T; r += nw) {
        const f32x4* xr = (const f32x4*)(src + (size_t)r * D) + lane; f32x4 v[4]; float s = 0.f;
#pragma unroll
        for (int j = 0; j < 4; ++j) { v[j] = xr[64 * j]; s += (v[j].x * v[j].x + v[j].y * v[j].y) + (v[j].z * v[j].z + v[j].w * v[j].w); }
        s = wave_sum(s);
        u32x2* o = (u32x2*)(hb + (size_t)r * D) + lane;
#pragma unroll
        for (int j = 0; j < 4; ++j) { u32x2 w; w.x = pk2(v[j].x, v[j].y); w.y = pk2(v[j].z, v[j].w); o[64 * j] = w; }
        if (lane == 0) rstd[r] = 1.0f / sqrtf(s * (1.0f / D) + EPS);
    }
}

namespace pg8 {
constexpr int BM = 256, BK = 64, HALF = 128, HTB = HALF * BK * 2, STAGE_BYTES = 8 * HTB, NXCD = 8, WGM = 8;
__device__ __forceinline__ int lds_byte(int r, int c) { const int st = (r >> 4) * 2 + (c >> 5), rr = r & 15, cc = c & 31, ob = rr * 64 + cc * 2; return st * 1024 + (ob ^ (((ob >> 9) & 1) << 5)); }
__device__ __forceinline__ void stage_rc(int b, int& R, int& C) { const int st = b / 1024, sb = b % 1024, swz = sb ^ (((sb >> 9) & 1) << 5); R = (st >> 1) * 16 + swz / 64; C = (st & 1) * 32 + (swz % 64) / 2; }
__device__ __forceinline__ int perm32(int rho) { const int n = rho >> 4, i = rho & 15; return 8 * (i >> 2) + 4 * n + (i & 3); }
struct Unit { int pm, pn, e, aux; };
struct DenseOrder {
    int nM, nN, nwg, G, c, K; const bf16* Bt;
    __device__ void init(int M, int N, int K_, const bf16* Bt_, int G_, int c_) { nM = M / BM; nN = N / BM; nwg = nM * nN; G = G_; c = c_; K = K_; Bt = Bt_; }
    __device__ __forceinline__ bool next(int i, Unit& u) const {
        const long L = (long)i * G + c; if (L >= nwg) return false;
        int wgid = (int)L; { const int q = nwg / NXCD, r = nwg % NXCD, xcd = wgid % NXCD, off = wgid / NXCD; wgid = (xcd < r ? xcd * (q + 1) : r * (q + 1) + (xcd - r) * q) + off; }
        const int nig = WGM * nN, gid = wgid / nig, fm = gid * WGM, gsz = (nM - fm) < WGM ? (nM - fm) : WGM;
        u.pm = fm + ((wgid % nig) % gsz); u.pn = (wgid % nig) / gsz; u.e = 0; u.aux = 0; return true;
    }
    __device__ __forceinline__ unsigned a_rowoff(const Unit& u, int r) const { return (unsigned)(u.pm * BM + r) * (unsigned)(K * 2); }
    __device__ __forceinline__ const char* b_base(const Unit& u) const { return (const char*)Bt + (size_t)u.pn * BM * K * 2; }
};

template <class Epi, class Sched, bool ALIGN_EPI>
__device__ __forceinline__ void gemm_phase(LAS unsigned char* lds, const bf16* Abase, const int K, const Sched& S, const Epi& E) {
    int tid_ = threadIdx.x; asm volatile("" : "+v"(tid_));
    const int tid = tid_, wid = __builtin_amdgcn_readfirstlane(tid >> 6), lane = tid & 63, wr = wid >> 2, wc = wid & 3, fr = lane & 15, fq = lane >> 4;
    const int nt = K / BK;
    unsigned voffB[2];
#pragma unroll
    for (int i = 0; i < 2; ++i) { int R, C; stage_rc(tid * 16 + i * 8192, R, C); const int Rb = Epi::PERM ? ((R & ~31) + perm32(R & 31)) : R;
        voffB[i] = (unsigned)(Rb * K + C) * 2u; }
    const size_t kstep = (size_t)(BK * 2);
    const size_t hstep = (size_t)HALF * K * 2;
    const unsigned ldsw = (unsigned)wid * 1024u;
    const int aoff = lds_byte(wr * 64 + fr, fq * 8), boff = lds_byte(wc * 32 + fr, fq * 8);
#define PG8_SA(b, h) (((b) * 2 + (h)) * HTB)
#define PG8_SB(b, h) ((4 + (b) * 2 + (h)) * HTB)
#define PG8_STAGE_B(bufoff, gbase) do { _Pragma("unroll") for (int _i = 0; _i < 2; ++_i) \
        __builtin_amdgcn_global_load_lds((const unsigned*)((const char*)(gbase) + voffB[_i]), (LAS unsigned*)(lds + (bufoff) + ldsw + _i * 8192), 16, 0, 0); } while (0)
#define PG8_STAGE_A(bufoff, offs, kb) do { _Pragma("unroll") for (int _i = 0; _i < 2; ++_i) \
        __builtin_amdgcn_global_load_lds((const unsigned*)((const char*)Abase + (size_t)(offs)[_i] + (size_t)(kb)), (LAS unsigned*)(lds + (bufoff) + ldsw + _i * 8192), 16, 0, 0); } while (0)
#define PG8_LDA(dst, b, h) do { _Pragma("unroll") for (int m = 0; m < 4; ++m) _Pragma("unroll") for (int k = 0; k < 2; ++k) dst[m][k] = *(const LAS bf16x8*)(lds + PG8_SA(b, h) + aoff + m * 2048 + k * 1024); } while (0)
#define PG8_LDB(dst, b, h) do { _Pragma("unroll") for (int n = 0; n < 2; ++n) _Pragma("unroll") for (int k = 0; k < 2; ++k) dst[n][k] = *(const LAS bf16x8*)(lds + PG8_SB(b, h) + boff + n * 2048 + k * 1024); } while (0)
#define PG8_MMA(ai, bj, At, Bt) do { __builtin_amdgcn_s_setprio(1); _Pragma("unroll") for (int m = 0; m < 4; ++m) _Pragma("unroll") for (int n = 0; n < 2; ++n) _Pragma("unroll") for (int k = 0; k < 2; ++k) \
        acc[ai][bj][m][n] = __builtin_amdgcn_mfma_f32_16x16x32_bf16(Bt[n][k], At[m][k], acc[ai][bj][m][n], 0, 0, 0); __builtin_amdgcn_s_setprio(0); } while (0)
#define PG8_WAIT_V(n) asm volatile("s_waitcnt vmcnt(" #n ")" ::: "memory")
#define PG8_WAIT_L(n) asm volatile("s_waitcnt lgkmcnt(" #n ")" ::: "memory")
#define PG8_BAR __builtin_amdgcn_s_barrier()
#define PG8_SCHED __builtin_amdgcn_sched_barrier(0)
#define PG8_AOFF(dst, u) do { int _t = tid; asm volatile("" : "+v"(_t)); _Pragma("unroll") for (int _i = 0; _i < 2; ++_i) { int _R, _C; stage_rc(_t * 16 + _i * 8192, _R, _C); \
        _Pragma("unroll") for (int _h = 0; _h < 2; ++_h) dst[_h][_i] = S.a_rowoff(u, _h * HALF + _R) + (unsigned)(_C * 2); } } while (0)
    Unit cur, nxt; int ui = 0;
    if (!S.next(0, cur)) return;
    f32x4 acc[2][2][4][2];
#pragma unroll
    for (int a = 0; a < 2; ++a)
#pragma unroll
        for (int b = 0; b < 2; ++b)
#pragma unroll
            for (int m = 0; m < 4; ++m)
#pragma unroll
                for (int n = 0; n < 2; ++n) acc[a][b][m][n] = (f32x4){0.f, 0.f, 0.f, 0.f};
    bf16x8 At[4][2], B0[2][2], B1[2][2];
    unsigned cA[2][2];
    PG8_AOFF(cA, cur);
    const char* cB = S.b_base(cur);
    PG8_STAGE_B(PG8_SB(0, 0), cB); PG8_STAGE_B(PG8_SB(0, 1), cB + hstep); PG8_STAGE_A(PG8_SA(0, 0), cA[0], 0); PG8_STAGE_A(PG8_SA(0, 1), cA[1], 0);
    if (wr == 1) PG8_BAR;
    PG8_WAIT_V(2); PG8_BAR;
    PG8_STAGE_B(PG8_SB(1, 0), cB + kstep); PG8_STAGE_A(PG8_SA(1, 0), cA[0], kstep); PG8_STAGE_B(PG8_SB(1, 1), cB + hstep + kstep);
    PG8_WAIT_V(6); PG8_BAR;
    for (;;) {
        const bool has_next = S.next(ui + 1, nxt);
        const char* nB = has_next ? S.b_base(nxt) : cB;
#pragma unroll 1
        for (int t = 0; t < nt; t += 2) {
            const bool last = (t == nt - 2);
            const size_t k1 = (size_t)(t + 1) * kstep;
            const size_t k2 = last ? (size_t)0 : (size_t)(t + 2) * kstep, k3 = k2 + kstep;
            const char* b2 = last ? nB : cB + (size_t)(t + 2) * kstep; const char* b3 = b2 + kstep;
            PG8_LDB(B0, 0, 0); PG8_LDB(B1, 0, 1); PG8_SCHED; PG8_LDA(At, 0, 0); PG8_STAGE_A(PG8_SA(1, 1), cA[1], k1);
            if (last && has_next) { PG8_AOFF(cA, nxt); }
            PG8_WAIT_V(8); PG8_WAIT_L(0); PG8_BAR; PG8_MMA(0, 0, At, B0); PG8_MMA(0, 1, At, B1); PG8_BAR; PG8_SCHED;
            PG8_LDA(At, 0, 1); PG8_STAGE_B(PG8_SB(0, 0), b2); PG8_STAGE_B(PG8_SB(0, 1), b2 + hstep); PG8_STAGE_A(PG8_SA(0, 0), cA[0], k2);
            PG8_WAIT_V(8); PG8_WAIT_L(0); PG8_BAR; PG8_MMA(1, 0, At, B0); PG8_MMA(1, 1, At, B1); PG8_BAR; PG8_SCHED;
            PG8_LDB(B0, 1, 0); PG8_LDB(B1, 1, 1); PG8_SCHED; PG8_LDA(At, 1, 0); PG8_STAGE_A(PG8_SA(0, 1), cA[1], k2);
            PG8_WAIT_V(8); PG8_WAIT_L(0); PG8_BAR; PG8_MMA(0, 0, At, B0); PG8_MMA(0, 1, At, B1); PG8_BAR; PG8_SCHED;
            PG8_LDA(At, 1, 1); PG8_STAGE_B(PG8_SB(1, 0), b3); PG8_STAGE_B(PG8_SB(1, 1), b3 + hstep); PG8_STAGE_A(PG8_SA(1, 0), cA[0], k3);
            PG8_WAIT_V(8); PG8_WAIT_L(0); PG8_BAR; PG8_MMA(1, 0, At, B0); PG8_MMA(1, 1, At, B1); PG8_BAR; PG8_SCHED;
        }
        if constexpr (ALIGN_EPI) { if (wr == 0) PG8_BAR; }
        E(acc, cur, wr, wc, fr, fq);
        if (!has_next) break;
#pragma unroll
        for (int a = 0; a < 2; ++a)
#pragma unroll
            for (int b = 0; b < 2; ++b)
#pragma unroll
                for (int m = 0; m < 4; ++m)
#pragma unroll
                    for (int n = 0; n < 2; ++n) acc[a][b][m][n] = (f32x4){0.f, 0.f, 0.f, 0.f};
        cur = nxt; cB = nB; ++ui;
        if constexpr (ALIGN_EPI) { if (wr == 1) PG8_BAR; }
    }
    PG8_WAIT_V(0);
    if constexpr (!ALIGN_EPI) { if (wr == 0) PG8_BAR; }
    PG8_BAR;
#undef PG8_SA
#undef PG8_SB
#undef PG8_STAGE_A
#undef PG8_STAGE_B
#undef PG8_LDA
#undef PG8_LDB
#undef PG8_MMA
#undef PG8_WAIT_V
#undef PG8_WAIT_L
#undef PG8_BAR
#undef PG8_SCHED
#undef PG8_AOFF
}

template <int LAYER> struct EpiIn {
    static constexpr bool PERM = true;
    bf16* Y; const float* rstd; float* vss; const float* cs; const float* sn; const float* qn; const float* kn;
    __device__ __forceinline__ void operator()(const f32x4 (&acc)[2][2][4][2], const Unit& u, int wr, int wc, int fr, int fq) const {
        constexpr int LD = LAYER == 0 ? IN0 : IN1;
        int type; bool isq;
        if (LAYER == 0) { type = u.pn < 2 ? 0 : (u.pn < 4 ? 1 : (u.pn < 10 ? 2 : 3)); isq = u.pn < 7; }
        else { type = (u.pn < 4 || wc < 2) ? 2 : 3; isq = u.pn < 4; }
        f32x4 g[2][2];
        if (type == 2) { const float* gn = isq ? qn : kn;
#pragma unroll
            for (int bj = 0; bj < 2; ++bj)
#pragma unroll
                for (int n = 0; n < 2; ++n) { g[bj][n] = *(const f32x4*)(gn + 32 * bj + 8 * fq + 4 * n); if (isq) g[bj][n] = g[bj][n] * QSCALE; } }
        const int colb = u.pn * BM + 64 * wc + 8 * fq;
#pragma unroll
        for (int ai = 0; ai < 2; ++ai)
#pragma unroll
            for (int m = 0; m < 4; ++m) {
                const int row = u.pm * BM + ai * HALF + wr * 64 + m * 16 + fr;
                const float rs = rstd[row];
                f32x4 v[2][2];
#pragma unroll
                for (int bj = 0; bj < 2; ++bj)
#pragma unroll
                    for (int n = 0; n < 2; ++n) v[bj][n] = acc[ai][bj][m][n] * rs;
                if (type <= 1) {
#pragma unroll
                    for (int bj = 0; bj < 2; ++bj)
#pragma unroll
                        for (int n = 0; n < 2; ++n) { v[bj][n].x = gelu_fast(v[bj][n].x); v[bj][n].y = gelu_fast(v[bj][n].y); v[bj][n].z = gelu_fast(v[bj][n].z); v[bj][n].w = gelu_fast(v[bj][n].w); }
                } else if (type == 2) {
                    float ss = 0.f;
#pragma unroll
                    for (int bj = 0; bj < 2; ++bj)
#pragma unroll
                        for (int n = 0; n < 2; ++n) ss += (v[bj][n].x * v[bj][n].x + v[bj][n].y * v[bj][n].y) + (v[bj][n].z * v[bj][n].z + v[bj][n].w * v[bj][n].w);
                    ss += __shfl_xor(ss, 16); ss += __shfl_xor(ss, 32);
                    const float hr = 1.0f / sqrtf(ss * (1.0f / 64.0f) + EPS);
#pragma unroll
                    for (int bj = 0; bj < 2; ++bj)
#pragma unroll
                        for (int n = 0; n < 2; ++n) v[bj][n] = v[bj][n] * g[bj][n] * hr;
                    f32x4 o[2];
#pragma unroll
                    for (int n = 0; n < 2; ++n) { o[n].x = __shfl_xor(v[0][n].x, 16); o[n].y = __shfl_xor(v[0][n].y, 16); o[n].z = __shfl_xor(v[0][n].z, 16); o[n].w = __shfl_xor(v[0][n].w, 16); }
                    if (fq < 2) {
                        const f32x4 c0 = *(const f32x4*)(cs + (size_t)row * 8), c1 = *(const f32x4*)(cs + (size_t)row * 8 + 4);
                        f32x4 s0 = *(const f32x4*)(sn + (size_t)row * 8), s1 = *(const f32x4*)(sn + (size_t)row * 8 + 4);
                        if (fq == 0) { s0 = -s0; s1 = -s1; }
                        v[0][0] = v[0][0] * c0 + o[0] * s0; v[0][1] = v[0][1] * c1 + o[1] * s1;
                    }
                }
                bf16* rowp = Y + (size_t)row * LD + colb;
                float vsum = 0.f;
#pragma unroll
                for (int bj = 0; bj < 2; ++bj) {
                    u32x4 w; w.x = pk2(v[bj][0].x, v[bj][0].y); w.y = pk2(v[bj][0].z, v[bj][0].w); w.z = pk2(v[bj][1].x, v[bj][1].y); w.w = pk2(v[bj][1].z, v[bj][1].w);
                    *(u32x4*)(rowp + 32 * bj) = w;
                    if (LAYER == 0 && type == 1) {
#pragma unroll
                        for (int q = 0; q < 4; ++q) { const float lo = __uint_as_float(w[q] << 16), hi = __uint_as_float(w[q] & 0xffff0000u); vsum += lo * lo + hi * hi; }
                    }
                }
                if (LAYER == 0 && type == 1) { vsum += __shfl_xor(vsum, 16); vsum += __shfl_xor(vsum, 32); if (fq == 0) vss[(size_t)row * 8 + (u.pn - 2) * 4 + wc] = vsum; }
            }
    }
};
struct EpiRes {
    static constexpr bool PERM = false;
    const float* resid; float* out;
    __device__ __forceinline__ void operator()(const f32x4 (&acc)[2][2][4][2], const Unit& u, int wr, int wc, int fr, int fq) const {
        const int row0 = u.pm * BM + wr * 64 + fr, col0 = u.pn * BM + wc * 32 + 4 * fq;
#pragma unroll
        for (int ai = 0; ai < 2; ++ai)
#pragma unroll
            for (int m = 0; m < 4; ++m) { const size_t off = (size_t)(row0 + ai * HALF + m * 16) * D + col0;
#pragma unroll
                for (int bj = 0; bj < 2; ++bj)
#pragma unroll
                    for (int n = 0; n < 2; ++n) { const f32x4 r = *(const f32x4*)(resid + off + bj * HALF + n * 16); *(f32x4*)(out + off + bj * HALF + n * 16) = r + acc[ai][bj][m][n]; } }
    }
};
__device__ __forceinline__ void moe_setup(volatile LAS int* tb, const int* counts) {
    if (threadIdx.x == 0) { int sacc = 0; for (int e = 0; e < NE; ++e) { tb[e] = sacc; sacc += (counts[e] + 255) >> 8; } tb[NE] = sacc; }
    __syncthreads();
}
template <int NPN, bool GATHER> struct MoeOrder {
    const volatile LAS int* tb; const int* counts; const int* elist; int G, c, K, brows; const bf16* Bt;
    __device__ __forceinline__ bool next(int i, Unit& u) const {
        const int L = i * G + c, ntile = __builtin_amdgcn_readfirstlane(tb[NE]); if (L >= ntile * NPN) return false;
        const int tile = L / NPN; int e = 0, te = 0;
#pragma unroll 1
        for (int x = 1; x < NE; ++x) { const int v = __builtin_amdgcn_readfirstlane(tb[x]); if (v <= tile) { e = x; te = v; } }
        u.e = e; u.pm = tile - te; u.pn = L % NPN; u.aux = tile; return true;
    }
    __device__ __forceinline__ unsigned a_rowoff(const Unit& u, int r) const {
        if (GATHER) { const int pos = u.pm * BM + r; const int tok = pos < counts[u.e] ? (elist[u.e * T + pos] >> 1) : 0; return (unsigned)tok * (unsigned)(K * 2); }
        return (unsigned)(u.aux * BM + r) * (unsigned)(K * 2);
    }
    __device__ __forceinline__ const char* b_base(const Unit& u) const { return (const char*)Bt + ((size_t)u.e * brows + (size_t)u.pn * BM) * K * 2; }
};
struct EpiGU {
    static constexpr bool PERM = true;
    bf16* hid; const float* rstd; const int* counts; const int* elist;
    __device__ __forceinline__ void operator()(const f32x4 (&acc)[2][2][4][2], const Unit& u, int wr, int wc, int fr, int fq) const {
        const int cnt = counts[u.e];
#pragma unroll
        for (int ai = 0; ai < 2; ++ai)
#pragma unroll
            for (int m = 0; m < 4; ++m) {
                const int r = ai * HALF + wr * 64 + m * 16 + fr, pos = u.pm * BM + r;
                if (pos < cnt) {
                    const int tok = elist[u.e * T + pos] >> 1; const float rs = rstd[tok];
                    u32x4 w;
#pragma unroll
                    for (int n = 0; n < 2; ++n) {
                        const f32x4 g = acc[ai][0][m][n] * rs, up = acc[ai][1][m][n] * rs; f32x4 h;
                        h.x = g.x * __builtin_amdgcn_rcpf(1.0f + __builtin_amdgcn_exp2f(-1.4426950408889634f * g.x)) * up.x;
                        h.y = g.y * __builtin_amdgcn_rcpf(1.0f + __builtin_amdgcn_exp2f(-1.4426950408889634f * g.y)) * up.y;
                        h.z = g.z * __builtin_amdgcn_rcpf(1.0f + __builtin_amdgcn_exp2f(-1.4426950408889634f * g.z)) * up.z;
                        h.w = g.w * __builtin_amdgcn_rcpf(1.0f + __builtin_amdgcn_exp2f(-1.4426950408889634f * g.w)) * up.w;
                        if (n == 0) { w.x = pk2(h.x, h.y); w.y = pk2(h.z, h.w); } else { w.z = pk2(h.x, h.y); w.w = pk2(h.z, h.w); }
                    }
                    *(u32x4*)(hid + (size_t)(u.aux * BM + r) * FF + u.pn * HALF + wc * 32 + 8 * fq) = w;
                }
            }
    }
};
struct EpiDown {
    static constexpr bool PERM = true;
    bf16* yp; const float* gw; const int* counts; const int* elist;
    __device__ __forceinline__ void operator()(const f32x4 (&acc)[2][2][4][2], const Unit& u, int wr, int wc, int fr, int fq) const {
        const int cnt = counts[u.e];
#pragma unroll
        for (int ai = 0; ai < 2; ++ai)
#pragma unroll
            for (int m = 0; m < 4; ++m) {
                const int r = ai * HALF + wr * 64 + m * 16 + fr, pos = u.pm * BM + r;
                if (pos < cnt) {
                    const int pair = elist[u.e * T + pos]; const float gv = gw[pair];
                    bf16* rowp = yp + (size_t)pair * D + u.pn * BM + wc * 32 + 8 * fq;
#pragma unroll
                    for (int bj = 0; bj < 2; ++bj) { const f32x4 v0 = acc[ai][bj][m][0] * gv, v1 = acc[ai][bj][m][1] * gv;
                        u32x4 w; w.x = pk2(v0.x, v0.y); w.y = pk2(v0.z, v0.w); w.z = pk2(v1.x, v1.y); w.w = pk2(v1.z, v1.w);
                        *(u32x4*)(rowp + bj * HALF) = w; }
                }
            }
    }
};
}


typedef float f32x16 __attribute__((ext_vector_type(16)));
typedef short s16x4 __attribute__((ext_vector_type(4)));
__device__ __forceinline__ int crow(int r, int hi) { return (r & 3) + 8 * (r >> 2) + 4 * hi; }
__device__ __forceinline__ s16x4 lds_tr(LAS unsigned char* p) { return __builtin_bit_cast(s16x4, __builtin_amdgcn_ds_read_tr16_b64_v4i16((LAS s16x4*)p)); }
constexpr int VST_PITCH = 144, VST_BYTES = 32 * VST_PITCH;
template <int W> __device__ __forceinline__ void attn_tile(const bf16* __restrict__ Qp, size_t qstride, const bf16* __restrict__ Kp, const bf16* __restrict__ Vp, size_t kvstride, int q0,
                                                          LAS unsigned char* vst, float sinkv, f32x16 (&o)[2], float& m_out, float& l_out, const int lane) {
    const int r32 = lane & 31, hi = lane >> 5;
    bf16x8 qf[4];
#pragma unroll
    for (int d0 = 0; d0 < 4; ++d0) qf[d0] = *(const bf16x8*)(Qp + (size_t)r32 * qstride + d0 * 16 + hi * 8);
    f32x16 sc[5];
#pragma unroll
    for (int c = 0; c < 5; ++c) {
        int ki = q0 - 128 + 32 * c + r32; ki = ki < 0 ? 0 : ki;
        const bf16* kp = Kp + (size_t)ki * kvstride + hi * 8;
        f32x16 acc = {};
#pragma unroll
        for (int d0 = 0; d0 < 4; ++d0) { const bf16x8 kf = *(const bf16x8*)(kp + d0 * 16); acc = __builtin_amdgcn_mfma_f32_32x32x16_bf16(kf, qf[d0], acc, 0, 0, 0); }
        sc[c] = acc;
    }
    float m = sinkv;
#pragma unroll
    for (int c = 0; c < 5; ++c)
#pragma unroll
        for (int r = 0; r < 16; ++r) {
            const int kk = 32 * c + crow(r, hi), rel = 128 + r32 - kk;
            const bool ok = (rel >= 0) && (rel <= W) && (q0 - 128 + kk >= 0);
            const float v = ok ? sc[c][r] : -INFINITY; sc[c][r] = v; m = fmaxf(m, v);
        }
    m = fmaxf(m, __shfl_xor(m, 32));
    float l = 0.f;
#pragma unroll
    for (int c = 0; c < 5; ++c)
#pragma unroll
        for (int r = 0; r < 16; ++r) { const float pv = __builtin_amdgcn_exp2f(sc[c][r] - m); sc[c][r] = pv; l += pv; }
    l += __shfl_xor(l, 32);
    l += __builtin_amdgcn_exp2f(sinkv - m);
    o[0] = (f32x16){}; o[1] = (f32x16){};
    const int vr = lane >> 1, vcb = (lane & 1) * 64;
    const int g16 = lane >> 4, q4 = (lane & 15) >> 2, p4 = lane & 3;
    LAS unsigned char* trbase = vst + (4 * (g16 >> 1) + q4) * VST_PITCH + (16 * (g16 & 1) + 4 * p4) * 2;
#pragma unroll
    for (int c = 0; c < 5; ++c) {
        LAS unsigned char* buf = vst + (c & 1) * VST_BYTES;
        int ki = q0 - 128 + 32 * c + vr; ki = ki < 0 ? 0 : ki;
        const u32x4* vp = (const u32x4*)((const unsigned char*)(Vp + (size_t)ki * kvstride) + vcb);
        u32x4 t0 = vp[0], t1 = vp[1], t2 = vp[2], t3 = vp[3];
        LAS u32x4* wp = (LAS u32x4*)(buf + vr * VST_PITCH + vcb);
        wp[0] = t0; wp[1] = t1; wp[2] = t2; wp[3] = t3;
#pragma unroll
        for (int ks = 0; ks < 2; ++ks) {
            bf16x8 pb;
#pragma unroll
            for (int j = 0; j < 4; ++j) { const unsigned w = pk2(sc[c][8 * ks + 2 * j], sc[c][8 * ks + 2 * j + 1]); pb[2 * j] = (short)(w & 0xffffu); pb[2 * j + 1] = (short)(w >> 16); }
#pragma unroll
            for (int db = 0; db < 2; ++db) {
                LAS unsigned char* tp = trbase + (c & 1) * VST_BYTES + (16 * ks) * VST_PITCH + db * 64;
                const s16x4 lo = lds_tr(tp), hi4 = lds_tr(tp + 8 * VST_PITCH);
                const bf16x8 vf = {lo[0], lo[1], lo[2], lo[3], hi4[0], hi4[1], hi4[2], hi4[3]};
                o[db] = __builtin_amdgcn_mfma_f32_32x32x16_bf16(vf, pb, o[db], 0, 0, 0);
            }
        }
    }
    m_out = m; l_out = l;
}
__device__ __forceinline__ void f_swa(LAS unsigned char* lds, const bf16* __restrict__ Y1, const float* __restrict__ sinks, bf16* __restrict__ O) {
    const int tid = opaque_tid(), lane = tid & 63, wave = __builtin_amdgcn_readfirstlane(tid >> 6), r32 = lane & 31, hi = lane >> 5;
    LAS unsigned char* vst = lds + wave * (2 * VST_BYTES);
    for (int it = blockIdx.x; it < 1024; it += gridDim.x) {
        const int kvh = it & 1, qt = (it >> 1) & 255, b = it >> 9, hq = kvh * 8 + wave, q0 = qt * 32;
        const bf16* rowb = Y1 + (size_t)b * SEQ * IN1;
        f32x16 o[2]; float m, l;
        attn_tile<127>(rowb + (size_t)q0 * IN1 + hq * 64, IN1, rowb + 1024 + kvh * 64, rowb + 1152 + kvh * 64, IN1, q0, vst, sinks[hq] * 1.4426950408889634f, o, m, l, lane);
        const float inv = 1.0f / l;
        bf16* op = O + (size_t)(b * SEQ + q0 + r32) * D + hq * 64 + 4 * hi;
#pragma unroll
        for (int db = 0; db < 2; ++db)
#pragma unroll
            for (int g4 = 0; g4 < 4; ++g4) { u32x2 w; w.x = pk2(o[db][4 * g4] * inv, o[db][4 * g4 + 1] * inv); w.y = pk2(o[db][4 * g4 + 2] * inv, o[db][4 * g4 + 3] * inv);
                *(u32x2*)(op + 32 * db + 8 * g4) = w; }
    }
}


constexpr int OB_OFF = 73728, OB_PITCH = 136, LSE_OFF = 143360;
__device__ __forceinline__ void dil_item(LAS unsigned char* lds, const bf16* __restrict__ Y, bf16* __restrict__ A2, int item) {
    const int tid = opaque_tid(), lane = tid & 63, wave = __builtin_amdgcn_readfirstlane(tid >> 6), r32 = lane & 31, hi = lane >> 5;
    const int blk = item & 15, j = (item >> 4) & 3, b = item >> 6;
    LAS unsigned char* vst = lds + wave * (2 * VST_BYTES);
    LAS unsigned char* OB = lds + OB_OFF; LAS float* LSE = (LAS float*)(lds + LSE_OFF);
    const bf16* rowb = Y + (size_t)b * SEQ * IN0;
#pragma unroll 1
    for (int pass = 0; pass < 3; ++pass) {
        const int g = 2 - pass, dil = 1 << (2 * g), tpc = 16 >> (2 * g), h = g * 4 + j;
#pragma unroll 1
        for (int tt = 0; tt < 2; ++tt) {
            const int tile = wave + 8 * tt, r = tile / tpc, ti = tile % tpc;
            const int q0 = (blk * 512) / dil + 32 * ti;
            const bf16* base = rowb + (size_t)r * IN0;
            f32x16 o[2]; float m, l;
            attn_tile<128>(base + (size_t)q0 * dil * IN0 + 1024 + h * 64, (size_t)dil * IN0, base + 1792 + h * 64, base + 2560 + h * 64, (size_t)dil * IN0, q0, vst, -INFINITY, o, m, l, lane);
            const int tok = r + dil * (32 * ti + r32);
            float lse = m + __builtin_amdgcn_logf(l);
            float wb = 1.0f / l, wa = 0.f;
            if (pass > 0) {
                const float lp = LSE[tok], M = fmaxf(lp, lse);
                const float ea = __builtin_amdgcn_exp2f(lp - M), eb = __builtin_amdgcn_exp2f(lse - M), inv = 1.0f / (ea + eb);
                wa = ea * inv; wb = eb * inv / l; lse = M + __builtin_amdgcn_logf(ea + eb);
            }
            LAS unsigned char* ob = OB + tok * OB_PITCH + 8 * hi;
            bf16* gp = A2 + (size_t)(b * SEQ + blk * 512 + tok) * OUT0K + 512 + j * 64 + 4 * hi;
#pragma unroll
            for (int db = 0; db < 2; ++db)
#pragma unroll
                for (int g4 = 0; g4 < 4; ++g4) {
                    float v0 = o[db][4 * g4] * wb, v1 = o[db][4 * g4 + 1] * wb, v2 = o[db][4 * g4 + 2] * wb, v3 = o[db][4 * g4 + 3] * wb;
                    LAS u32x2* q = (LAS u32x2*)(ob + 64 * db + 16 * g4);
                    if (pass > 0) { const u32x2 pw = *q;
                        v0 += wa * __uint_as_float(pw.x << 16); v1 += wa * __uint_as_float(pw.x & 0xffff0000u); v2 += wa * __uint_as_float(pw.y << 16); v3 += wa * __uint_as_float(pw.y & 0xffff0000u); }
                    u32x2 w; w.x = pk2(v0, v1); w.y = pk2(v2, v3);
                    if (pass < 2) *q = w; else *(u32x2*)(gp + 32 * db + 8 * g4) = w;
                }
            if (pass < 2) LSE[tok] = lse;
        }
        __syncthreads();
    }
}
__device__ __forceinline__ void sgu_item(LAS unsigned char* lds, const bf16* __restrict__ Y, const float* __restrict__ vss, const float* __restrict__ gn, const float* __restrict__ w, const float* __restrict__ bs,
                                         bf16* __restrict__ A2, int cidx) {
    const int tid = opaque_tid(), lane = tid & 63, g = __builtin_amdgcn_readfirstlane(tid >> 6), r32 = lane & 31, hi = lane >> 5;
    LAS unsigned char* vst = lds + g * (2 * VST_BYTES);
    const int r0 = cidx * 128;
    f32x16 acc[4][2];
#pragma unroll
    for (int a = 0; a < 4; ++a) { acc[a][0] = (f32x16){}; acc[a][1] = (f32x16){}; }
    const int vr = lane >> 1, vhalf = lane & 1;
    const int g16 = lane >> 4, q4 = (lane & 15) >> 2, p4 = lane & 3;
    LAS unsigned char* trbase = vst + (4 * (g16 >> 1) + q4) * VST_PITCH + (16 * (g16 & 1) + 4 * p4) * 2;
#pragma unroll
    for (int sc = 0; sc < 4; ++sc) {
        LAS unsigned char* buf = vst + (sc & 1) * VST_BYTES;
        {
            const int row = r0 + 32 * sc + vr;
            const f32x4 p0 = *(const f32x4*)(vss + (size_t)row * 8), p1 = *(const f32x4*)(vss + (size_t)row * 8 + 4);
            const float rs = 1.0f / sqrtf(((p0.x + p0.y) + (p0.z + p0.w) + (p1.x + p1.y) + (p1.z + p1.w)) * (1.0f / 512.0f) + EPS);
            const u32x4* vp = (const u32x4*)(Y + (size_t)row * IN0 + 512 + g * 64 + 32 * vhalf);
            const float* gp = gn + g * 64 + 32 * vhalf;
            LAS u32x4* wp = (LAS u32x4*)(buf + vr * VST_PITCH + 64 * vhalf);
#pragma unroll
            for (int i = 0; i < 4; ++i) { const u32x4 t = vp[i]; const f32x4 ga = *(const f32x4*)(gp + 8 * i), gb = *(const f32x4*)(gp + 8 * i + 4); u32x4 o;
                o.x = pk2(__uint_as_float(t.x << 16) * rs * ga.x, __uint_as_float(t.x & 0xffff0000u) * rs * ga.y);
                o.y = pk2(__uint_as_float(t.y << 16) * rs * ga.z, __uint_as_float(t.y & 0xffff0000u) * rs * ga.w);
                o.z = pk2(__uint_as_float(t.z << 16) * rs * gb.x, __uint_as_float(t.z & 0xffff0000u) * rs * gb.y);
                o.w = pk2(__uint_as_float(t.w << 16) * rs * gb.z, __uint_as_float(t.w & 0xffff0000u) * rs * gb.w);
                wp[i] = o; }
        }
#pragma unroll
        for (int ks = 0; ks < 2; ++ks) {
            bf16x8 vf[2];
#pragma unroll
            for (int db = 0; db < 2; ++db) { LAS unsigned char* tp = trbase + (sc & 1) * VST_BYTES + (16 * ks) * VST_PITCH + db * 64;
                const s16x4 lo = lds_tr(tp), hi4 = lds_tr(tp + 8 * VST_PITCH); vf[db] = (bf16x8){lo[0], lo[1], lo[2], lo[3], hi4[0], hi4[1], hi4[2], hi4[3]}; }
#pragma unroll
            for (int tt = sc; tt < 4; ++tt) {
                const int t = 32 * tt + r32, s0 = 32 * sc + 16 * ks + 4 * hi;
                const float* wrow = w + ((size_t)(g * 128 + t) * 128 + s0);
                f32x4 w0 = *(const f32x4*)wrow, w1 = *(const f32x4*)(wrow + 8);
                if (tt == sc) {
                    w0.x = (s0 + 0 <= t) ? w0.x : 0.f; w0.y = (s0 + 1 <= t) ? w0.y : 0.f; w0.z = (s0 + 2 <= t) ? w0.z : 0.f; w0.w = (s0 + 3 <= t) ? w0.w : 0.f;
                    w1.x = (s0 + 8 <= t) ? w1.x : 0.f; w1.y = (s0 + 9 <= t) ? w1.y : 0.f; w1.z = (s0 + 10 <= t) ? w1.z : 0.f; w1.w = (s0 + 11 <= t) ? w1.w : 0.f;
                }
                const unsigned a0 = pk2(w0.x, w0.y), a1 = pk2(w0.z, w0.w), a2 = pk2(w1.x, w1.y), a3 = pk2(w1.z, w1.w);
                const bf16x8 wf = {(short)(a0 & 0xffffu), (short)(a0 >> 16), (short)(a1 & 0xffffu), (short)(a1 >> 16), (short)(a2 & 0xffffu), (short)(a2 >> 16), (short)(a3 & 0xffffu), (short)(a3 >> 16)};
#pragma unroll
                for (int db = 0; db < 2; ++db) acc[tt][db] = __builtin_amdgcn_mfma_f32_32x32x16_bf16(vf[db], wf, acc[tt][db], 0, 0, 0);
            }
        }
    }
#pragma unroll
    for (int tt = 0; tt < 4; ++tt) {
        const int t = 32 * tt + r32; const float bias = bs[g * 128 + t];
        const size_t row = (size_t)(r0 + t);
        const bf16* up = Y + row * IN0 + g * 64 + 4 * hi; bf16* op = A2 + row * OUT0K + g * 64 + 4 * hi;
#pragma unroll
        for (int db = 0; db < 2; ++db)
#pragma unroll
            for (int g4 = 0; g4 < 4; ++g4) { const u32x2 uu = *(const u32x2*)(up + 32 * db + 8 * g4); u32x2 o;
                o.x = pk2((acc[tt][db][4 * g4] + bias) * __uint_as_float(uu.x << 16), (acc[tt][db][4 * g4 + 1] + bias) * __uint_as_float(uu.x & 0xffff0000u));
                o.y = pk2((acc[tt][db][4 * g4 + 2] + bias) * __uint_as_float(uu.y << 16), (acc[tt][db][4 * g4 + 3] + bias) * __uint_as_float(uu.y & 0xffff0000u));
                *(u32x2*)(op + 32 * db + 8 * g4) = o; }
    }
}
__device__ __forceinline__ void f_mixers0(LAS unsigned char* lds, const bf16* Y, const float* vss, const float* gn, const float* w, const float* bs, bf16* A2) {
    for (int id = blockIdx.x; id < 256; id += gridDim.x) {
        if (id < 128) dil_item(lds, Y, A2, id);
        else sgu_item(lds, Y, vss, gn, w, bs, A2, id - 128);
    }
}


__device__ __forceinline__ void build_router_tab(const float* __restrict__ gf, const float* __restrict__ wrg, const float* __restrict__ wre, bf16* __restrict__ RT) {
    for (int i = blockIdx.x * NTHR + opaque_tid(); i < 64 * D; i += gridDim.x * NTHR) {
        const int n = i >> 10, k = i & 1023; float v = 0.f;
        if (n < 36) v = ((n < 4) ? wrg[k * 4 + n] : wre[((size_t)((n - 4) >> 3) * D + k) * 8 + ((n - 4) & 7)]) * gf[k];
        const bf16 hi = f2bf(v); RT[i] = hi; RT[64 * D + i] = f2bf(v - bf2f(hi));
    }
}
__device__ __forceinline__ void f_router(LAS unsigned char* lds, const float* h, const bf16* __restrict__ RT, const float* __restrict__ brg, const float* __restrict__ bre,
                                         bf16* __restrict__ hb, float* __restrict__ rstd, int* __restrict__ eid, float* __restrict__ gw, int* counts, int* __restrict__ elist) {
    const int tid = opaque_tid(), lane = tid & 63, r32 = lane & 31, hi = lane >> 5, wv = __builtin_amdgcn_readfirstlane(tid >> 6);
    LAS float* Ps = (LAS float*)lds;
    LAS float* Qs = Ps + 8 * 64 * 37;
    LAS float* Ls = Qs + 8 * 2 * 64;
    LAS float* Ss = Ls + 64 * 37;
    LAS int* Hc = (LAS int*)(Ss + 64);
    for (int tile = blockIdx.x; tile < T / 64; tile += gridDim.x) {
        const int r0 = tile * 64;
        if (tid < 64) Hc[tid] = 0;
        f32x16 acc[2][2];
#pragma unroll
        for (int x = 0; x < 2; ++x) { acc[x][0] = (f32x16){}; acc[x][1] = (f32x16){}; }
        float ssq[2] = {0.f, 0.f};
#pragma unroll 2
        for (int ks = 0; ks < 8; ++ks) {
            const int k0 = wv * 128 + ks * 16 + 8 * hi;
            bf16x8 ah[2], al[2], bh[2], bl[2];
#pragma unroll
            for (int rb = 0; rb < 2; ++rb) {
                const size_t go = (size_t)(r0 + 32 * rb + r32) * D + k0;
                const f32x4 x0 = *(const f32x4*)(h + go), x1 = *(const f32x4*)(h + go + 4);
                ssq[rb] += (x0.x * x0.x + x0.y * x0.y) + (x0.z * x0.z + x0.w * x0.w) + (x1.x * x1.x + x1.y * x1.y) + (x1.z * x1.z + x1.w * x1.w);
                u32x4 wh; wh.x = pk2(x0.x, x0.y); wh.y = pk2(x0.z, x0.w); wh.z = pk2(x1.x, x1.y); wh.w = pk2(x1.z, x1.w);
                *(u32x4*)(hb + go) = wh;
                u32x4 wl;
                wl.x = pk2(x0.x - __uint_as_float(wh.x << 16), x0.y - __uint_as_float(wh.x & 0xffff0000u)); wl.y = pk2(x0.z - __uint_as_float(wh.y << 16), x0.w - __uint_as_float(wh.y & 0xffff0000u));
                wl.z = pk2(x1.x - __uint_as_float(wh.z << 16), x1.y - __uint_as_float(wh.z & 0xffff0000u)); wl.w = pk2(x1.z - __uint_as_float(wh.w << 16), x1.w - __uint_as_float(wh.w & 0xffff0000u));
                ah[rb] = __builtin_bit_cast(bf16x8, wh); al[rb] = __builtin_bit_cast(bf16x8, wl);
            }
#pragma unroll
            for (int cb = 0; cb < 2; ++cb) { const bf16* wp = RT + (size_t)(32 * cb + r32) * D + k0; bh[cb] = *(const bf16x8*)wp; bl[cb] = *(const bf16x8*)(wp + 64 * D); }
#pragma unroll
            for (int rb = 0; rb < 2; ++rb)
#pragma unroll
                for (int cb = 0; cb < 2; ++cb) {
                    acc[rb][cb] = __builtin_amdgcn_mfma_f32_32x32x16_bf16(ah[rb], bh[cb], acc[rb][cb], 0, 0, 0);
                    acc[rb][cb] = __builtin_amdgcn_mfma_f32_32x32x16_bf16(al[rb], bh[cb], acc[rb][cb], 0, 0, 0);
                    acc[rb][cb] = __builtin_amdgcn_mfma_f32_32x32x16_bf16(ah[rb], bl[cb], acc[rb][cb], 0, 0, 0);
                }
        }
#pragma unroll
        for (int rb = 0; rb < 2; ++rb) {
#pragma unroll
            for (int r = 0; r < 16; ++r) { LAS float* pr = Ps + (wv * 64 + 32 * rb + crow(r, hi)) * 37; pr[r32] = acc[rb][0][r]; if (r32 < 4) pr[32 + r32] = acc[rb][1][r]; }
            Qs[(wv * 2 + hi) * 64 + 32 * rb + r32] = ssq[rb];
        }
        __syncthreads();
        {
            const int row = tid & 63, cg = tid >> 6;
#pragma unroll
            for (int c = 0; c < 5; ++c) { const int n = cg * 5 + c; if (n < 36) { float v = 0.f;
#pragma unroll
                for (int w8 = 0; w8 < 8; ++w8) v += Ps[(w8 * 64 + row) * 37 + n]; Ls[row * 37 + n] = v; } }
            if (cg == 7) { float v = 0.f;
#pragma unroll
                for (int w8 = 0; w8 < 16; ++w8) v += Qs[w8 * 64 + row]; Ss[row] = v; }
        }
        __syncthreads();
        int e0 = 0, e1 = 0, k0r = 0, k1r = 0;
        if (tid < 64) {
            const int r = r0 + tid; const LAS float* L = Ls + tid * 37;
            const float rs = 1.0f / sqrtf(Ss[tid] * (1.0f / D) + EPS);
            float lg[4];
#pragma unroll
            for (int g = 0; g < 4; ++g) lg[g] = L[g] * rs + brg[g];
            int gi = 0; float lmax = lg[0];
#pragma unroll
            for (int g = 1; g < 4; ++g) if (lg[g] > lmax) { lmax = lg[g]; gi = g; }
            float zs = 0.f;
#pragma unroll
            for (int g = 0; g < 4; ++g) zs += expf(lg[g] - lmax);
            const float ptop = 1.0f / zs;
            int i0 = 0, i1 = -1; float l0 = -INFINITY, l1 = -INFINITY;
#pragma unroll 1
            for (int e = 0; e < 8; ++e) { const float v = L[4 + gi * 8 + e] * rs + bre[gi * 8 + e];
                if (v > l0) { l1 = l0; i1 = i0; l0 = v; i0 = e; } else if (v > l1) { l1 = v; i1 = e; } }
            const float r1 = expf(l1 - l0); const float g0 = ptop / (1.0f + r1), g1 = ptop * r1 / (1.0f + r1);
            rstd[r] = rs; e0 = gi * 8 + i0; e1 = gi * 8 + i1;
            eid[r * 2] = e0; eid[r * 2 + 1] = e1; gw[r * 2] = g0; gw[r * 2 + 1] = g1;
            k0r = __hip_atomic_fetch_add(&Hc[e0], 1, __ATOMIC_RELAXED, __HIP_MEMORY_SCOPE_WORKGROUP); k1r = __hip_atomic_fetch_add(&Hc[e1], 1, __ATOMIC_RELAXED, __HIP_MEMORY_SCOPE_WORKGROUP);
        }
        __syncthreads();
        if (tid < 32) { const int c = Hc[tid]; Hc[32 + tid] = c ? atomicAdd(&counts[tid], c) : 0; }
        __syncthreads();
        if (tid < 64) { const int r = r0 + tid; elist[e0 * T + Hc[32 + e0] + k0r] = r * 2; elist[e1 * T + Hc[32 + e1] + k1r] = r * 2 + 1; }
        __syncthreads();
    }
}
__device__ __forceinline__ void f_combine(float* h, const bf16* __restrict__ yp, bf16* __restrict__ hb, float* __restrict__ rstd, float* hdst) {
    const int tid = opaque_tid(), lane = tid & 63;
    const int gwv = blockIdx.x * NWAVES + (tid >> 6), nw = gridDim.x * NWAVES;
    for (int r = gwv; r < T; r += nw) {
        f32x4* hr = (f32x4*)(h + (size_t)r * D) + lane;
        const u32x2* y0 = (const u32x2*)(yp + (size_t)(2 * r) * D) + lane; const u32x2* y1 = (const u32x2*)(yp + (size_t)(2 * r + 1) * D) + lane;
        float s = 0.f;
#pragma unroll
        for (int j = 0; j < 4; ++j) { f32x4 v = hr[64 * j]; const u32x2 a = y0[64 * j], b = y1[64 * j];
            v.x += __uint_as_float(a.x << 16) + __uint_as_float(b.x << 16); v.y += __uint_as_float(a.x & 0xffff0000u) + __uint_as_float(b.x & 0xffff0000u);
            v.z += __uint_as_float(a.y << 16) + __uint_as_float(b.y << 16); v.w += __uint_as_float(a.y & 0xffff0000u) + __uint_as_float(b.y & 0xffff0000u);
            ((f32x4*)(hdst + (size_t)r * D) + lane)[64 * j] = v; s += (v.x * v.x + v.y * v.y) + (v.z * v.z + v.w * v.w);
            if (hb) { u32x2 w; w.x = pk2(v.x, v.y); w.y = pk2(v.z, v.w); ((u32x2*)(hb + (size_t)r * D) + lane)[64 * j] = w; } }
        if (rstd) { s = wave_sum(s); if (lane == 0) rstd[r] = 1.0f / sqrtf(s * (1.0f / D) + EPS); }
    }
}

__device__ __forceinline__ float gelu_tanh(float x) { const float u = 0.7978845608028654f * (x + 0.044715f * x * x * x); return 0.5f * x * (1.0f + tanhf(u)); }
__device__ void n_rowprep(const float* __restrict__ src, bf16* __restrict__ hb, float* __restrict__ rstd) {
    const int gw = blockIdx.x * NWAVES + (threadIdx.x >> 6), lane = threadIdx.x & 63, nw = gridDim.x * NWAVES;
    for (int r = gw; r < T; r += nw) {
        const float* p = src + (size_t)r * D; float s = 0.f;
        for (int c = lane; c < D; c += 64) { float v = p[c]; s += v * v; hb[(size_t)r * D + c] = f2bf(v); }
        for (int o = 1; o < 64; o <<= 1) s += __shfl_xor(s, o);
        if (lane == 0) rstd[r] = 1.0f / sqrtf(s * (1.0f / D) + EPS);
    }
}
__device__ void n_rope_tab(const int* __restrict__ pos, float* __restrict__ cs, float* __restrict__ sn) {
    for (int i = blockIdx.x * NTHR + opaque_tid(); i < T * 8; i += gridDim.x * NTHR) {
        const int t = i >> 3, f = i & 7;
        const float inv = powf(500000.0f, -(float)f / 8.0f);
        const float ang = (float)pos[t] * inv;
        const double rev = (double)ang * 0.15915494309189535;
        const float fr = (float)(rev - floor(rev));
        cs[i] = __builtin_amdgcn_cosf(fr); sn[i] = __builtin_amdgcn_sinf(fr);
    }
}
__device__ void n_gemm(LAS unsigned char* lds, const bf16* __restrict__ A, int lda, const float* __restrict__ W, int M, int N, int K, const float* __restrict__ gain,
                       const float* __restrict__ rowscale, const float* resid, bf16* __restrict__ outb, int ldo, float* outf) {
    const int half = threadIdx.x >> 8, tid = threadIdx.x & 255;
    LAS float* sA = (LAS float*)(lds + half * 16384); LAS float* sB = sA + 16 * 65;
    const int tx = tid & 15, ty = tid >> 4, ntn = N / 64, nvb = ntn * (M / 64);
    for (int it = 0; (it * (int)gridDim.x) * 2 < nvb; ++it) {
        const int vb = (it * gridDim.x + blockIdx.x) * 2 + half; const bool ok = vb < nvb;
        const int m0 = ok ? (vb / ntn) * 64 : 0, n0 = ok ? (vb % ntn) * 64 : 0;
        float acc[4][4] = {};
        for (int k0 = 0; k0 < K; k0 += 16) {
            for (int e = tid; e < 1024; e += 256) { const int r = e >> 4, c = e & 15; sA[c * 65 + r] = bf2f(A[(size_t)(m0 + r) * lda + k0 + c]); }
            for (int e = tid; e < 1024; e += 256) { const int r = e >> 6, c = e & 63; sB[r * 65 + c] = W[(size_t)(k0 + r) * N + n0 + c] * (gain ? gain[k0 + r] : 1.0f); }
            __syncthreads();
#pragma unroll
            for (int k = 0; k < 16; ++k) {
                float a[4], b[4];
#pragma unroll
                for (int i = 0; i < 4; ++i) { a[i] = sA[k * 65 + ty * 4 + i]; b[i] = sB[k * 65 + tx * 4 + i]; }
#pragma unroll
                for (int i = 0; i < 4; ++i)
#pragma unroll
                    for (int j = 0; j < 4; ++j) acc[i][j] += a[i] * b[j];
            }
            __syncthreads();
        }
        if (ok)
#pragma unroll
        for (int i = 0; i < 4; ++i)
#pragma unroll
            for (int j = 0; j < 4; ++j) {
            const int m = m0 + ty * 4 + i, n = n0 + tx * 4 + j; float v = acc[i][j];
            if (rowscale) v *= rowscale[m];
            if (resid) v += resid[(size_t)m * N + n];
            if (outb) outb[(size_t)m * ldo + n] = f2bf(v);
            if (outf) outf[(size_t)m * N + n] = v;
        }
    }
}
__device__ void n_post(LAS unsigned char* lds, bf16* __restrict__ Y, int ld, int ngelu, int nq, int nk, float* __restrict__ vss, const float* __restrict__ cs, const float* __restrict__ sn,
                       const float* __restrict__ qn, const float* __restrict__ kn) {
    const int half = threadIdx.x >> 8, tid = threadIdx.x & 255;
    LAS float* red = (LAS float*)(lds + half * 16384); LAS float* hv = red + 256;
    const int nqk = (nq + nk) * 64;
    for (int it = 0; it * (int)gridDim.x * 2 < T; ++it) {
        const int t = (it * gridDim.x + blockIdx.x) * 2 + half; bf16* y = Y + (size_t)t * ld;
        if (ngelu) {
            float ss = 0.f;
            for (int c = tid; c < ngelu; c += 256) { float g = gelu_tanh(bf2f(y[c])); bf16 gb = f2bf(g); y[c] = gb; if (c >= ngelu / 2) { float gr = bf2f(gb); ss += gr * gr; } }
            red[tid] = ss; __syncthreads();
            for (int o = 128; o > 0; o >>= 1) { if (tid < o) red[tid] += red[tid + o]; __syncthreads(); }
            if (tid < 8) vss[(size_t)t * 8 + tid] = (tid == 0) ? red[0] : 0.f;
        }
        __syncthreads();
        for (int c = tid; c < nqk; c += 256) hv[c] = bf2f(y[ngelu + c]);
        __syncthreads();
        for (int c = tid; c < nqk; c += 256) {
            const int h = c >> 6, d = c & 63; const bool isq = h < nq; const float* gn = isq ? qn : kn;
            float s = 0.f; for (int j = 0; j < 64; ++j) { float v = hv[h * 64 + j]; s += v * v; }
            const float rs = 1.0f / sqrtf(s * (1.0f / 64.0f) + EPS);
            float o = hv[c] * rs * gn[d];
            if (d < 16) { const int f = d & 7; const float co = cs[t * 8 + f], si = sn[t * 8 + f];
                const float x1 = hv[h * 64 + f] * rs * gn[f], x2 = hv[h * 64 + 8 + f] * rs * gn[8 + f];
                o = (d < 8) ? (x1 * co - x2 * si) : (x2 * co + x1 * si); }
            if (isq) o *= QSCALE;
            y[ngelu + c] = f2bf(o);
        }
        __syncthreads();
    }
}
__device__ void n_sgu(const bf16* __restrict__ Y, const float* __restrict__ vss, const float* __restrict__ gn, const float* __restrict__ w, const float* __restrict__ bs, bf16* __restrict__ A2) {
    for (int i = blockIdx.x * NTHR + threadIdx.x; i < T * 512; i += gridDim.x * NTHR) {
        const int row = i >> 9, ch = i & 511, g = ch >> 6, tt = row & 127, r0 = row - tt;
        float acc = 0.f;
        for (int s = 0; s <= tt; ++s) {
            const int rs_ = r0 + s; float sum = 0.f; for (int j = 0; j < 8; ++j) sum += vss[(size_t)rs_ * 8 + j];
            const float rstd = 1.0f / sqrtf(sum * (1.0f / 512.0f) + EPS);
            const float v = bf2f(f2bf(bf2f(Y[(size_t)rs_ * IN0 + 512 + ch]) * rstd * gn[ch]));
            acc += bf2f(f2bf(w[(g * 128 + tt) * 128 + s])) * v;
        }
        acc += bs[g * 128 + tt];
        A2[(size_t)row * OUT0K + ch] = f2bf(bf2f(Y[(size_t)row * IN0 + ch]) * acc);
    }
}
__device__ void n_dil(const bf16* __restrict__ Y, bf16* __restrict__ A2) {
    const int d = threadIdx.x & 63;
    for (int i = blockIdx.x * NWAVES + (threadIdx.x >> 6); i < T * 4; i += gridDim.x * NWAVES) {
        const int row = i >> 2, j = i & 3, b = row / SEQ, t = row % SEQ;
        float m = -INFINITY, l = 0.f, o = 0.f;
        for (int g = 0; g < 3; ++g) {
            const int dil = (g == 0) ? 1 : (g == 1 ? 4 : 16), h = g * 4 + j;
            const float q = bf2f(Y[(size_t)row * IN0 + 1024 + h * 64 + d]);
            for (int n = 0; n <= 128; ++n) {
                const int tk = t - n * dil; if (tk < 0) break;
                const size_t kr = (size_t)(b * SEQ + tk) * IN0;
                float s = q * bf2f(Y[kr + 1792 + h * 64 + d]);
                for (int x = 1; x < 64; x <<= 1) s += __shfl_xor(s, x);
                const float mn = fmaxf(m, s), a = exp2f(m - mn), p = exp2f(s - mn);
                l = l * a + p; o = o * a + p * bf2f(Y[kr + 2560 + h * 64 + d]);
                m = mn;
            }
        }
        A2[(size_t)row * OUT0K + 512 + j * 64 + d] = f2bf(o / l);
    }
}
__device__ void n_swa(const bf16* __restrict__ Y, const float* __restrict__ sinks, bf16* __restrict__ O) {
    const int d = threadIdx.x & 63;
    for (int i = blockIdx.x * NWAVES + (threadIdx.x >> 6); i < T * 16; i += gridDim.x * NWAVES) {
        const int row = i >> 4, h = i & 15, kvh = h >> 3, b = row / SEQ, t = row % SEQ;
        const float q = bf2f(Y[(size_t)row * IN1 + h * 64 + d]);
        float m = sinks[h] * 1.4426950408889634f, l = 1.0f, o = 0.f;
        for (int n = 0; n < 128; ++n) {
            const int tk = t - n; if (tk < 0) break;
            const size_t kr = (size_t)(b * SEQ + tk) * IN1;
            float s = q * bf2f(Y[kr + 1024 + kvh * 64 + d]);
            for (int x = 1; x < 64; x <<= 1) s += __shfl_xor(s, x);
            const float mn = fmaxf(m, s), a = exp2f(m - mn), p = exp2f(s - mn);
            l = l * a + p; o = o * a + p * bf2f(Y[kr + 1152 + kvh * 64 + d]);
            m = mn;
        }
        O[(size_t)row * D + h * 64 + d] = f2bf(o / l);
    }
}
__device__ void n_router(const float* h, const float* __restrict__ gf, const float* __restrict__ wrg, const float* __restrict__ brg, const float* __restrict__ wre, const float* __restrict__ bre,
                         bf16* __restrict__ hb, float* __restrict__ rstd, int* __restrict__ eid, float* __restrict__ gw, int* counts, int* __restrict__ elist) {
    const int gwv = blockIdx.x * NWAVES + (threadIdx.x >> 6), lane = threadIdx.x & 63, nw = gridDim.x * NWAVES;
    for (int r = gwv; r < T; r += nw) {
        const float* p = h + (size_t)r * D; float s = 0.f;
        for (int c = lane; c < D; c += 64) { float v = p[c]; s += v * v; hb[(size_t)r * D + c] = f2bf(v); }
        for (int o = 1; o < 64; o <<= 1) s += __shfl_xor(s, o);
        const float rs = 1.0f / sqrtf(s * (1.0f / D) + EPS);
        float lg[4] = {0.f, 0.f, 0.f, 0.f};
        for (int c = lane; c < D; c += 64) { const float xn = p[c] * rs * gf[c];
#pragma unroll
            for (int g = 0; g < 4; ++g) lg[g] += xn * wrg[c * 4 + g]; }
#pragma unroll
        for (int g = 0; g < 4; ++g) { for (int o = 1; o < 64; o <<= 1) lg[g] += __shfl_xor(lg[g], o); lg[g] += brg[g]; }
        int gi = 0; float lmax = lg[0];
#pragma unroll
        for (int g = 1; g < 4; ++g) if (lg[g] > lmax) { lmax = lg[g]; gi = g; }
        float zs = 0.f;
#pragma unroll
        for (int g = 0; g < 4; ++g) zs += expf(lg[g] - lmax);
        const float ptop = 1.0f / zs;
        float le[8] = {0.f, 0.f, 0.f, 0.f, 0.f, 0.f, 0.f, 0.f};
        for (int c = lane; c < D; c += 64) { const float xn = p[c] * rs * gf[c];
#pragma unroll
            for (int e = 0; e < 8; ++e) le[e] += xn * wre[((size_t)gi * D + c) * 8 + e]; }
#pragma unroll
        for (int e = 0; e < 8; ++e) { for (int o = 1; o < 64; o <<= 1) le[e] += __shfl_xor(le[e], o); le[e] += bre[gi * 8 + e]; }
        int i0 = 0; float l0 = le[0];
#pragma unroll
        for (int e = 1; e < 8; ++e) if (le[e] > l0) { l0 = le[e]; i0 = e; }
        int i1 = -1; float l1 = -INFINITY;
#pragma unroll
        for (int e = 0; e < 8; ++e) if (e != i0 && le[e] > l1) { l1 = le[e]; i1 = e; }
        const float r1 = expf(l1 - l0); const float g0 = ptop / (1.0f + r1), g1 = ptop * r1 / (1.0f + r1);
        if (lane == 0) {
            rstd[r] = rs; const int e0 = gi * 8 + i0, e1 = gi * 8 + i1;
            eid[r * 2] = e0; eid[r * 2 + 1] = e1; gw[r * 2] = g0; gw[r * 2 + 1] = g1;
            const int p0 = atomicAdd(&counts[e0], 1); elist[e0 * T + p0] = r * 2;
            const int p1 = atomicAdd(&counts[e1], 1); elist[e1 * T + p1] = r * 2 + 1;
        }
    }
}
__device__ __forceinline__ bool slot_lookup(const int* counts, int slot, int& e, int& pos) {
    int base = 0; e = -1; pos = 0; bool ok = false;
    for (int x = 0; x < NE; ++x) { const int c = counts[x], pc = (c + 255) & ~255; if (e < 0 && slot < base + pc) { e = x; pos = slot - base; ok = pos < c; } base += pc; }
    if (e < 0) e = 0;
    return ok;
}
__device__ void n_gateup(LAS unsigned char* lds, const bf16* __restrict__ hb, const float* __restrict__ rstd, const float* __restrict__ gf, const float* __restrict__ wg, const float* __restrict__ wu,
                         const int* counts, const int* elist, bf16* __restrict__ hid) {
    const int half = threadIdx.x >> 8, j = threadIdx.x & 255; LAS float* xs = (LAS float*)(lds + half * 16384);
    for (int it = 0; it * (int)gridDim.x * 2 < SLOT_CAP; ++it) {
        const int slot = (it * gridDim.x + blockIdx.x) * 2 + half; int e, pos; const bool ok = slot_lookup(counts, slot, e, pos);
        const int pair = ok ? elist[e * T + pos] : 0, t = pair >> 1;
        for (int c = j; c < D; c += 256) xs[c] = bf2f(hb[(size_t)t * D + c]);
        __syncthreads();
        if (ok) {
            float g = 0.f, u = 0.f; const float* pg = wg + (size_t)e * D * FF + j; const float* pu = wu + (size_t)e * D * FF + j;
            for (int k = 0; k < D; ++k) { const float gk = gf[k]; g += xs[k] * bf2f(f2bf(pg[(size_t)k * FF] * gk)); u += xs[k] * bf2f(f2bf(pu[(size_t)k * FF] * gk)); }
            const float rs = rstd[t]; g *= rs; u *= rs;
            hid[(size_t)slot * FF + j] = f2bf(g / (1.0f + expf(-g)) * u);
        }
        __syncthreads();
    }
}
__device__ void n_down(LAS unsigned char* lds, const bf16* __restrict__ hid, const float* __restrict__ wd, const float* __restrict__ gw, const int* counts, const int* elist, bf16* __restrict__ yp) {
    const int half = threadIdx.x >> 8, tid = threadIdx.x & 255; LAS float* hs = (LAS float*)(lds + half * 16384);
    for (int it = 0; it * (int)gridDim.x * 2 < SLOT_CAP; ++it) {
        const int slot = (it * gridDim.x + blockIdx.x) * 2 + half; int e, pos; const bool ok = slot_lookup(counts, slot, e, pos);
        const int pair = ok ? elist[e * T + pos] : 0;
        hs[tid] = ok ? bf2f(hid[(size_t)slot * FF + tid]) : 0.f;
        __syncthreads();
        if (ok) {
            const float gwt = gw[pair];
            for (int n = tid; n < D; n += 256) {
                float a = 0.f; const float* p = wd + (size_t)e * FF * D + n;
                for (int k = 0; k < FF; ++k) a += hs[k] * bf2f(f2bf(p[(size_t)k * D]));
                yp[(size_t)pair * D + n] = f2bf(a * gwt);
            }
        }
        __syncthreads();
    }
}
__device__ void n_combine(float* h, const bf16* __restrict__ yp, bf16* __restrict__ hb, float* __restrict__ rstd) {
    const int gwv = blockIdx.x * NWAVES + (threadIdx.x >> 6), lane = threadIdx.x & 63, nw = gridDim.x * NWAVES;
    for (int r = gwv; r < T; r += nw) {
        float s = 0.f;
        for (int c = lane; c < D; c += 64) { const float v = h[(size_t)r * D + c] + bf2f(yp[(size_t)(2 * r) * D + c]) + bf2f(yp[(size_t)(2 * r + 1) * D + c]);
            h[(size_t)r * D + c] = v; s += v * v; if (hb) hb[(size_t)r * D + c] = f2bf(v); }
        for (int o = 1; o < 64; o <<= 1) s += __shfl_xor(s, o);
        if (rstd && lane == 0) rstd[r] = 1.0f / sqrtf(s * (1.0f / D) + EPS);
    }
}


__device__ __forceinline__ void cvt_experts(const float* wg, const float* wu, const float* wd, const float* gain, bf16* WGU, bf16* WDT, LAS unsigned char* lds) {
    const int tid = opaque_tid(), lane = tid & 63, wave = tid >> 6;
    LAS float* scr = (LAS float*)(lds + wave * 9216);
    const int gwv = blockIdx.x * NWAVES + wave, NGW = gridDim.x * NWAVES;
    const CvtFam g0{wg, WGU, gain, D, FF, NE, 2, 512};
    const CvtFam g1{wu, WGU, gain, D, FF, NE, 3, 512};
    const CvtFam g2{wd, WDT, nullptr, FF, D, NE, 0, 1024};
    const int n0 = cvt_fam_items(g0), n1 = n0 + cvt_fam_items(g1), n2 = n1 + cvt_fam_items(g2);
    for (int it = gwv; it < n2; it += NGW) {
        if (it < n0) cvt_fam_run(g0, it, scr, lane);
        else if (it < n1) cvt_fam_run(g1, it - n0, scr, lane);
        else cvt_fam_run(g2, it - n1, scr, lane);
    }
}

enum { A_X, A_POS, A_NMIX, A_NFFN, A_WINE, A_WOUTE, A_SGUN, A_SGUW, A_SGUB, A_QND, A_KND, A_WINO, A_WOUTO, A_QNS, A_KNS, A_SINK, A_WRG, A_BRG, A_WRE, A_BRE, A_WG, A_WU, A_WD, A_OUT, A_WS, A_N };
struct Args { const void* p[A_N]; };
constexpr int LDS_ARGS = LDS_MISC + 1024;
__device__ __forceinline__ const void* ldarg(int i) {
    volatile LAS unsigned* q = (volatile LAS unsigned*)((LAS unsigned char*)0 + LDS_ARGS) + 2 * i;
    const unsigned lo = __builtin_amdgcn_readfirstlane(q[0]), hi = __builtin_amdgcn_readfirstlane(q[1]);
    return (const void*)(((unsigned long long)hi << 32) | lo);
}
#define ARGF(i) ((const float*)ldarg(i))
#define WSP(T, off) ((T*)((unsigned char*)ldarg(A_WS) + (off)))
__device__ __forceinline__ void grid_bar() {
    XcdBarrier b; b.bar = WSP(unsigned, WS_CTL) + CW_BAR; b.x = xb_xcc_id(); b.st = (volatile LAS unsigned*)((LAS unsigned char*)0 + LDS_MISC) + 8;
    xcd_barrier(b);
}
__device__ __forceinline__ void moe_phases(LAS unsigned char* lds, int cofs) {
    volatile LAS int* tb = (volatile LAS int*)(lds + LDS_MISC + 256);
    pg8::moe_setup(tb, WSP(int, WS_CTL) + cofs);
#pragma unroll 1
    for (int rep_ = 0; rep_ < REP_GU; ++rep_)
    {
        pg8::MoeOrder<2, true> S{tb, WSP(int, WS_CTL) + cofs, WSP(int, WS_ELIST), (int)gridDim.x, (int)blockIdx.x, D, 512, WSP(bf16, WS_WGU)};
        pg8::EpiGU E{WSP(bf16, WS_HID), WSP(float, WS_RSTD), WSP(int, WS_CTL) + cofs, WSP(int, WS_ELIST)};
        pg8::gemm_phase<pg8::EpiGU, pg8::MoeOrder<2, true>, true>(lds, WSP(bf16, WS_HB), D, S, E);
    }
    grid_bar();
#pragma unroll 1
    for (int rep_ = 0; rep_ < REP_DN; ++rep_)
    {
        pg8::MoeOrder<4, false> S{tb, WSP(int, WS_CTL) + cofs, WSP(int, WS_ELIST), (int)gridDim.x, (int)blockIdx.x, FF, 1024, WSP(bf16, WS_WD)};
        pg8::EpiDown E{WSP(bf16, WS_YP), WSP(float, WS_GW), WSP(int, WS_CTL) + cofs, WSP(int, WS_ELIST)};
        pg8::gemm_phase<pg8::EpiDown, pg8::MoeOrder<4, false>, true>(lds, WSP(bf16, WS_HID), FF, S, E);
    }
}
__global__ void __launch_bounds__(NTHR, 2) mega_fwd(Args a) {
    extern __shared__ __attribute__((aligned(16))) unsigned char lds_raw[];
    LAS unsigned char* lds = (LAS unsigned char*)lds_raw;
    {
        volatile LAS unsigned* MISC = (volatile LAS unsigned*)(lds + LDS_MISC);
        if (threadIdx.x < 64) MISC[threadIdx.x] = 0u;
        if (threadIdx.x < 2 * A_N) ((volatile LAS unsigned*)(lds + LDS_ARGS))[threadIdx.x] = ((const unsigned*)&a)[threadIdx.x];
        __syncthreads();
        (void)xcd_barrier_post(WSP(unsigned, WS_CTL) + CW_BAR, MISC + 8);
    }
    constexpr size_t SN_OFF = WS_CS + (size_t)T * 8 * 4;
    constexpr size_t EW1 = (size_t)NE * D * FF;
#pragma unroll 1
    for (int rep_ = 0; rep_ < REP_P0; ++rep_) {
    {
        const int tid = opaque_tid(), lane = tid & 63, wave = tid >> 6;
        LAS float* scr = (LAS float*)(lds + wave * 9216);
        const int gwv = blockIdx.x * NWAVES + wave, NGW = gridDim.x * NWAVES;
        const CvtFam f0{ARGF(A_WINE), WSP(bf16, WS_WIN0), ARGF(A_NMIX), D, IN0, 1, 1, 0};
        const CvtFam f1{ARGF(A_WOUTE), WSP(bf16, WS_WOUT0), nullptr, OUT0K, D, 1, 0, 0};
        const CvtFam f2{ARGF(A_WINO), WSP(bf16, WS_WIN1), ARGF(A_NMIX) + D, D, IN1, 1, 1, 0};
        const CvtFam f3{ARGF(A_WOUTO), WSP(bf16, WS_WOUT1), nullptr, D, D, 1, 0, 0};
        const int n0 = cvt_fam_items(f0), n1 = n0 + cvt_fam_items(f1), n2 = n1 + cvt_fam_items(f2), n3 = n2 + cvt_fam_items(f3);
        for (int it = gwv; it < n3; it += NGW) {
            if (it < n0) cvt_fam_run(f0, it, scr, lane);
            else if (it < n1) cvt_fam_run(f1, it - n0, scr, lane);
            else if (it < n2) cvt_fam_run(f2, it - n1, scr, lane);
            else cvt_fam_run(f3, it - n2, scr, lane);
        }
    }
    cvt_experts(ARGF(A_WG), ARGF(A_WU), ARGF(A_WD), ARGF(A_NFFN), WSP(bf16, WS_WGU), WSP(bf16, WS_WD), lds);
    build_router_tab(ARGF(A_NFFN), ARGF(A_WRG), ARGF(A_WRE), WSP(bf16, WS_RTAB));
    build_router_tab(ARGF(A_NFFN) + D, ARGF(A_WRG) + D * 4, ARGF(A_WRE) + (size_t)4 * D * 8, WSP(bf16, WS_RTAB) + 2 * 64 * D);
    n_rope_tab((const int*)ldarg(A_POS), WSP(float, WS_CS), WSP(float, SN_OFF));
    f_rowprep(ARGF(A_X), WSP(bf16, WS_HB), WSP(float, WS_RSTD));
    }
    grid_bar();
#pragma unroll 1
    for (int rep_ = 0; rep_ < REP_P1; ++rep_) {
    {
        pg8::DenseOrder S; S.init(T, IN0, D, WSP(bf16, WS_WIN0), gridDim.x, blockIdx.x);
        pg8::EpiIn<0> E{WSP(bf16, WS_Y), WSP(float, WS_RSTD), WSP(float, WS_VSS), WSP(float, WS_CS), WSP(float, SN_OFF), ARGF(A_QND), ARGF(A_KND)};
        pg8::gemm_phase<pg8::EpiIn<0>, pg8::DenseOrder, true>(lds, WSP(bf16, WS_HB), D, S, E);
    }
    }
    grid_bar();
#pragma unroll 1
    for (int rep_ = 0; rep_ < REP_P2; ++rep_) {
    f_mixers0(lds, WSP(bf16, WS_Y), WSP(float, WS_VSS), ARGF(A_SGUN), ARGF(A_SGUW), ARGF(A_SGUB), WSP(bf16, WS_A2));
    }
    grid_bar();
#pragma unroll 1
    for (int rep_ = 0; rep_ < REP_P3; ++rep_) {
    {
        pg8::DenseOrder S; S.init(T, D, OUT0K, WSP(bf16, WS_WOUT0), gridDim.x, blockIdx.x);
        pg8::EpiRes E{ARGF(A_X), (float*)ldarg(A_OUT)};
        pg8::gemm_phase<pg8::EpiRes, pg8::DenseOrder, true>(lds, WSP(bf16, WS_A2), OUT0K, S, E);
    }
    }
    grid_bar();
    if (PROBE_ROUTER) f_router(lds, (float*)ldarg(A_OUT), WSP(bf16, WS_RTAB), ARGF(A_BRG), ARGF(A_BRE), WSP(bf16, WS_HB), WSP(float, WS_RSTD), WSP(int, WS_EID), WSP(float, WS_GW), WSP(int, WS_CTL) + 256, WSP(int, WS_ELIST));
    f_router(lds, (float*)ldarg(A_OUT), WSP(bf16, WS_RTAB), ARGF(A_BRG), ARGF(A_BRE), WSP(bf16, WS_HB), WSP(float, WS_RSTD), WSP(int, WS_EID), WSP(float, WS_GW), WSP(int, WS_CTL), WSP(int, WS_ELIST));
    grid_bar();
    moe_phases(lds, 0);
    grid_bar();
    if (PROBE_COMBINE) f_combine((float*)ldarg(A_OUT), WSP(bf16, WS_YP), WSP(bf16, WS_HB), WSP(float, WS_RSTD), WSP(float, WS_HID));
    f_combine((float*)ldarg(A_OUT), WSP(bf16, WS_YP), WSP(bf16, WS_HB), WSP(float, WS_RSTD), (float*)ldarg(A_OUT));
    for (int xb_ = 0; xb_ < PROBE_BARS; ++xb_) grid_bar();
#pragma unroll 1
    for (int rep_ = 0; rep_ < REP_CVT1; ++rep_) {
    cvt_experts(ARGF(A_WG) + EW1, ARGF(A_WU) + EW1, ARGF(A_WD) + EW1, ARGF(A_NFFN) + D, WSP(bf16, WS_WGU), WSP(bf16, WS_WD), lds);
    }
    grid_bar();
#pragma unroll 1
    for (int rep_ = 0; rep_ < REP_P5; ++rep_) {
    {
        pg8::DenseOrder S; S.init(T, IN1, D, WSP(bf16, WS_WIN1), gridDim.x, blockIdx.x);
        pg8::EpiIn<1> E{WSP(bf16, WS_Y1), WSP(float, WS_RSTD), nullptr, WSP(float, WS_CS), WSP(float, SN_OFF), ARGF(A_QNS), ARGF(A_KNS)};
        pg8::gemm_phase<pg8::EpiIn<1>, pg8::DenseOrder, true>(lds, WSP(bf16, WS_HB), D, S, E);
    }
    }
    grid_bar();
#pragma unroll 1
    for (int rep_ = 0; rep_ < REP_P6; ++rep_) {
    f_swa(lds, WSP(bf16, WS_Y1), ARGF(A_SINK), WSP(bf16, WS_A2));
    }
    grid_bar();
    {
        pg8::DenseOrder S; S.init(T, D, D, WSP(bf16, WS_WOUT1), gridDim.x, blockIdx.x);
        pg8::EpiRes E{(const float*)ldarg(A_OUT), (float*)ldarg(A_OUT)};
        pg8::gemm_phase<pg8::EpiRes, pg8::DenseOrder, true>(lds, WSP(bf16, WS_A2), D, S, E);
    }
    grid_bar();
    f_router(lds, (float*)ldarg(A_OUT), WSP(bf16, WS_RTAB) + 2 * 64 * D, ARGF(A_BRG) + 4, ARGF(A_BRE) + 32, WSP(bf16, WS_HB), WSP(float, WS_RSTD), WSP(int, WS_EID), WSP(float, WS_GW), WSP(int, WS_CTL) + 64, WSP(int, WS_ELIST));
    grid_bar();
    moe_phases(lds, 64);
    grid_bar();
    f_combine((float*)ldarg(A_OUT), WSP(bf16, WS_YP), nullptr, nullptr, (float*)ldarg(A_OUT));
}

extern "C" void kernel_launch(void* const* d_in, const int* in_sizes, int n_in, void* d_out, int out_size, void* d_ws, size_t ws_size, hipStream_t stream) {
    static int grid = 0;
    if (grid == 0) {
        int dev = 0, cus = 0, per_cu = 0;
        if (hipGetDevice(&dev) != hipSuccess || hipDeviceGetAttribute(&cus, hipDeviceAttributeMultiprocessorCount, dev) != hipSuccess) { fprintf(stderr, "kernel_launch: device query failed\n"); grid = -1; return; }
        if (hipFuncSetAttribute((const void*)mega_fwd, hipFuncAttributeMaxDynamicSharedMemorySize, LDS_BYTES) != hipSuccess) { fprintf(stderr, "kernel_launch: hipFuncSetAttribute failed\n"); grid = -1; return; }
        if (hipOccupancyMaxActiveBlocksPerMultiprocessor(&per_cu, (const void*)mega_fwd, NTHR, LDS_BYTES) != hipSuccess || per_cu < 1) { fprintf(stderr, "kernel_launch: occupancy query says %d blocks/CU\n", per_cu); grid = -1; (void)hipGetLastError(); return; }
        grid = cus;
    }
    if (grid < 0) return;
    if (hipMemsetAsync((char*)d_ws + WS_CTL, 0, MiB, stream) != hipSuccess) return;
    Args a{};
    for (int i = 0; i < 23; ++i) a.p[i] = d_in[i];
    a.p[A_OUT] = d_out; a.p[A_WS] = d_ws;
    hipLaunchKernelGGL(mega_fwd, dim3(grid), dim3(NTHR), LDS_BYTES, stream, a);
}
```

```cpp
#include <hip/hip_runtime.h>
#include <stdint.h>
#include <math.h>
#include <cstdio>

typedef unsigned short bf16;
__device__ __forceinline__ float bf2f(bf16 v) { return __uint_as_float((unsigned)v << 16); }
__device__ __forceinline__ bf16 f2bf(float f) { unsigned u = __float_as_uint(f); return (bf16)((u + 0x7fffu + ((u >> 16) & 1u)) >> 16); }

constexpr int T = 16384, SEQ = 8192, D = 1024;
constexpr int IN0 = 3328, OUT0K = 768, IN1 = 1280;
constexpr int NE = 32, FF = 256;
constexpr float EPS = 1e-6f;
constexpr float QSCALE = 0.125f * 1.4426950408889634f;
constexpr int SLOT_CAP = 40960;

constexpr size_t MiB = 1u << 20;
constexpr size_t WS_CTL = 0;
constexpr size_t WS_RSTD = 1 * MiB;
constexpr size_t WS_VSS = WS_RSTD + 65536;
constexpr size_t WS_CS = 2 * MiB;
constexpr size_t WS_EID = 3 * MiB;
constexpr size_t WS_GW = WS_EID + 131072;
constexpr size_t WS_ELIST = 4 * MiB;
constexpr size_t WS_RTAB = 6 * MiB;
constexpr size_t WS_WIN0 = 8 * MiB;
constexpr size_t WS_WOUT0 = 15 * MiB;
constexpr size_t WS_WIN1 = 17 * MiB;
constexpr size_t WS_WOUT1 = 20 * MiB;
constexpr size_t WS_WGU = 22 * MiB;
constexpr size_t WS_WD = 54 * MiB;
constexpr size_t WS_HB = 70 * MiB;
constexpr size_t WS_Y = 102 * MiB;
constexpr size_t WS_YP = 102 * MiB;
constexpr size_t WS_HID = 166 * MiB;
constexpr size_t WS_Y1 = 166 * MiB;
constexpr size_t WS_A2 = 206 * MiB;


#define REP_P0 1
#define REP_P1 1
#define REP_P2 1
#define REP_P3 1
#define REP_GU 1
#define REP_DN 1
#define REP_CVT1 1
#define REP_P5 1
#define REP_P6 1
#define PROBE_ROUTER 0
#define PROBE_COMBINE 0
#define PROBE_BARS 0
#define LAS __attribute__((address_space(3)))
constexpr int NTHR = 512, NWAVES = 8;
constexpr int LDS_BYTES = 147456;
constexpr int LDS_MISC = 145408;
constexpr int CW_BAR = 4096;

#define XB_TMO      128
#define XB_XCNT(j)  (256  + 64 * (j))
#define XB_XSUB(j)  (1280 + 64 * (j))
#define XB_XGEN(j)  (2304 + 64 * (j))
#define XB_TOP      3328
#define XB_TOPGEN   3392
#define XCD_BAR_WORDS 3456
#define XB_SPIN_CAP (1u << 20)
__device__ __forceinline__ unsigned xb_ld(unsigned* p)              { return __hip_atomic_load(p, __ATOMIC_RELAXED, __HIP_MEMORY_SCOPE_AGENT); }
__device__ __forceinline__ unsigned xb_add(unsigned* p, unsigned v) { return __hip_atomic_fetch_add(p, v, __ATOMIC_RELAXED, __HIP_MEMORY_SCOPE_AGENT); }
__device__ __forceinline__ unsigned xb_xcc_id() { return (unsigned)__builtin_amdgcn_s_getreg((3 << 11) | 20) & 0xFu; }
#define XB_SPIN(cond, bar) do { unsigned _sp = 0; while (cond) { __builtin_amdgcn_s_sleep(1); \
    if ((++_sp & 255u) == 0u) { if (xb_ld(&(bar)[XB_TMO])) break; if (_sp > XB_SPIN_CAP) { atomicAdd(&(bar)[XB_TMO], 1u); break; } } } } while (0)
struct XcdBarrier { unsigned* bar; unsigned x; volatile LAS unsigned* st; };
__device__ __forceinline__ XcdBarrier xcd_barrier_post(unsigned* bar, volatile LAS unsigned* st) {
    XcdBarrier b; b.bar = bar; b.x = xb_xcc_id(); b.st = st;
    if (threadIdx.x == 0) (void)xb_add(&bar[XB_XCNT(b.x)], 1u);
    return b;
}
__device__ __forceinline__ void xcd_barrier_complete(unsigned* bar, unsigned x, unsigned& nloc, unsigned& nx) {
    const unsigned G = gridDim.x * gridDim.y * gridDim.z;
    unsigned sum, cnt, mine, sp = 0u;
    for (;;) {
        sum = 0u; cnt = 0u; mine = 0u;
#pragma unroll
        for (unsigned j = 0; j < 16; ++j) { const unsigned c = xb_ld(&bar[XB_XCNT(j)]); sum += c; cnt += (c > 0u) ? 1u : 0u; mine = (j == x) ? c : mine; }
        if (sum == G) break;
        __builtin_amdgcn_s_sleep(1);
        if ((++sp & 255u) == 0u) { if (xb_ld(&bar[XB_TMO])) break; if (sp > XB_SPIN_CAP) { atomicAdd(&bar[XB_TMO], 1u); break; } }
    }
    nloc = mine > 0u ? mine : 1u; nx = cnt > 0u ? cnt : 1u;
}
__device__ __forceinline__ void xcd_barrier(const XcdBarrier& b) {
    asm volatile("s_waitcnt vmcnt(0)" ::: "memory");
    __syncthreads();
    if (threadIdx.x == 0) {
        unsigned* bar = b.bar;
        __builtin_amdgcn_s_waitcnt(0);
        unsigned nloc = b.st[0], nx = b.st[1];
        if (nloc == 0u) { xcd_barrier_complete(bar, b.x, nloc, nx); b.st[0] = nloc; b.st[1] = nx; }
        const unsigned old = xb_add(&bar[XB_XSUB(b.x)], 1u);
        const unsigned gen = old / nloc;
        if (old + 1u == (gen + 1u) * nloc) {
            __builtin_amdgcn_fence(__ATOMIC_RELEASE, "agent");
            asm volatile("s_waitcnt vmcnt(0)" ::: "memory");
            const unsigned og = xb_add(&bar[XB_TOP], 1u);
            const unsigned tg = og / nx;
            if (og + 1u == (tg + 1u) * nx) xb_add(&bar[XB_TOPGEN], 1u);
            else XB_SPIN(xb_ld(&bar[XB_TOPGEN]) == tg, bar);
            __builtin_amdgcn_fence(__ATOMIC_ACQUIRE, "agent");
            xb_add(&bar[XB_XGEN(b.x)], 1u);
            asm volatile("s_waitcnt vmcnt(0)" ::: "memory");
        } else {
            XB_SPIN(xb_ld(&bar[XB_XGEN(b.x)]) == gen, bar);
            __builtin_amdgcn_fence(__ATOMIC_ACQUIRE, "agent");
            asm volatile("s_waitcnt vmcnt(0)" ::: "memory");
        }
    }
    __syncthreads();
}


__device__ __forceinline__ int vcu_id() { const int G = gridDim.x, bx = blockIdx.x; return (G % 8 == 0) ? (bx % 8) * (G / 8) + bx / 8 : bx; }
__device__ __forceinline__ int opaque_tid() { int t = threadIdx.x; asm volatile("" : "+v"(t)); return t; }
typedef short bf16x8 __attribute__((ext_vector_type(8)));
typedef float f32x4 __attribute__((ext_vector_type(4)));
typedef float f32x2 __attribute__((ext_vector_type(2)));
typedef unsigned u32x4 __attribute__((ext_vector_type(4)));
typedef unsigned u32x2 __attribute__((ext_vector_type(2)));
typedef __bf16 bf16x2_t __attribute__((ext_vector_type(2)));
__device__ __forceinline__ unsigned pk2(float lo, float hi) { f32x2 v = {lo, hi}; bf16x2_t b = __builtin_convertvector(v, bf16x2_t); return __builtin_bit_cast(unsigned, b); }
__device__ __forceinline__ float gelu_fast(float x) { const float u = x * (0.7978845608028654f + 0.0356774081363001f * x * x);
    return x * __builtin_amdgcn_rcpf(1.0f + __builtin_amdgcn_exp2f(-2.885390081777927f * u)); }

__device__ __forceinline__ void cvt_item(const float* __restrict__ W, int N, int k0, int n0, const float* __restrict__ gain, bf16* __restrict__ WT, int K, int drow0, LAS float* scr, int lane) {
#pragma unroll
    for (int i = 0; i < 8; ++i) {
        const int kk = i * 8 + (lane >> 3);
        f32x4 v = *(const f32x4*)(W + (size_t)(k0 + kk) * N + n0 + 4 * (lane & 7));
        if (gain) v = v * gain[k0 + kk];
        *(LAS f32x4*)(scr + kk * 36 + 4 * (lane & 7)) = v;
    }
    const int n = lane & 31;
#pragma unroll
    for (int cc = 0; cc < 4; ++cc) {
        const int c = (lane >> 5) * 4 + cc; const LAS float* q = scr + (8 * c) * 36 + n;
        u32x4 o; o.x = pk2(q[0], q[36]); o.y = pk2(q[72], q[108]); o.z = pk2(q[144], q[180]); o.w = pk2(q[216], q[252]);
        *(u32x4*)(WT + (size_t)(drow0 + n) * K + k0 + 8 * c) = o;
    }
}
__device__ __forceinline__ int inproj_pos(int n0) { return (n0 & ~255) | (((n0 >> 5) & 1) << 7) | (((n0 >> 6) & 3) << 5); }
__device__ __forceinline__ void cvt_matrix_items(const float* W, int K, int N, const float* gain, bf16* WT, int mode, int item, LAS float* scr, int lane) {
    const int nblk = N / 32, kb = item / nblk, nb = item % nblk, n0 = nb * 32;
    int d0 = n0;
    if (mode == 1) d0 = inproj_pos(n0);
    else if (mode == 2) d0 = 256 * (n0 >> 7) + (n0 & 127);
    else if (mode == 3) d0 = 256 * (n0 >> 7) + 128 + (n0 & 127);
    cvt_item(W, N, kb * 64, n0, gain, WT, K, d0, scr, lane);
}
struct CvtFam { const float* src; bf16* dst; const float* gain; int K, N, nmat, mode; int dstride_rows; };
__device__ __forceinline__ int cvt_fam_items(const CvtFam& f) { return f.nmat * (f.K / 64) * (f.N / 32); }
__device__ __forceinline__ void cvt_fam_run(const CvtFam& f, int item, LAS float* scr, int lane) {
    const int per = (f.K / 64) * (f.N / 32), e = item / per, it = item % per;
    cvt_matrix_items(f.src + (size_t)e * f.K * f.N, f.K, f.N, f.gain, f.dst + (size_t)e * f.dstride_rows * f.K, f.mode, it, scr, lane);
}

__device__ __forceinline__ float wave_sum(float v) {
#pragma unroll
    for (int o = 1; o < 64; o <<= 1) v += __shfl_xor(v, o);
    return v;
}
__device__ __forceinline__ void f_rowprep(const float* __restrict__ src, bf16* __restrict__ hb, float* __restrict__ rstd) {
    const int tid = opaque_tid(); const int gw = blockIdx.x * NWAVES + (tid >> 6), lane = tid & 63, nw = gridDim.x * NWAVES;
    for (int r = gw; r < T; r += nw) {
        const f32x4* xr = (const f32x4*)(src + (size_t)r * D) + lane; f32x4 v[4]; float s = 0.f;
#pragma unroll
        for (int j = 0; j < 4; ++j) { v[j] = xr[64 * j]; s += (v[j].x * v[j].x + v[j].y * v[j].y) + (v[j].z * v[j].z + v[j].w * v[j].w); }
        s = wave_sum(s);
        u32x2* o = (u32x2*)(hb + (size_t)r * D) + lane;
#pragma unroll
        for (int j = 0; j < 4; ++j) { u32x2 w; w.x = pk2(v[j].x, v[j].y); w.y = pk2(v[j].z, v[j].w); o[64 * j] = w; }
        if (lane == 0) rstd[r] = 1.0f / sqrtf(s * (1.0f / D) + EPS);
    }
}

namespace pg8 {
constexpr int BM = 256, BK = 64, HALF = 128, HTB = HALF * BK * 2, STAGE_BYTES = 8 * HTB, NXCD = 8, WGM = 8;
__device__ __forceinline__ int lds_byte(int r, int c) { const int st = (r >> 4) * 2 + (c >> 5), rr = r & 15, cc = c & 31, ob = rr * 64 + cc * 2; return st * 1024 + (ob ^ (((ob >> 9) & 1) << 5)); }
__device__ __forceinline__ void stage_rc(int b, int& R, int& C) { const int st = b / 1024, sb = b % 1024, swz = sb ^ (((sb >> 9) & 1) << 5); R = (st >> 1) * 16 + swz / 64; C = (st & 1) * 32 + (swz % 64) / 2; }
__device__ __forceinline__ int perm32(int rho) { const int n = rho >> 4, i = rho & 15; return 8 * (i >> 2) + 4 * n + (i & 3); }
struct Unit { int pm, pn, e, aux; };
struct DenseOrder {
    int nM, nN, nwg, G, c, K; const bf16* Bt;
    __device__ void init(int M, int N, int K_, const bf16* Bt_, int G_, int c_) { nM = M / BM; nN = N / BM; nwg = nM * nN; G = G_; c = c_; K = K_; Bt = Bt_; }
    __device__ __forceinline__ bool next(int i, Unit& u) const {
        const long L = (long)i * G + c; if (L >= nwg) return false;
        int wgid = (int)L; { const int q = nwg / NXCD, r = nwg % NXCD, xcd = wgid % NXCD, off = wgid / NXCD; wgid = (xcd < r ? xcd * (q + 1) : r * (q + 1) + (xcd - r) * q) + off; }
        const int nig = WGM * nN, gid = wgid / nig, fm = gid * WGM, gsz = (nM - fm) < WGM ? (nM - fm) : WGM;
        u.pm = fm + ((wgid % nig) % gsz); u.pn = (wgid % nig) / gsz; u.e = 0; u.aux = 0; return true;
    }
    __device__ __forceinline__ unsigned a_rowoff(const Unit& u, int r) const { return (unsigned)(u.pm * BM + r) * (unsigned)(K * 2); }
    __device__ __forceinline__ const char* b_base(const Unit& u) const { return (const char*)Bt + (size_t)u.pn * BM * K * 2; }
};

template <class Epi, class Sched, bool ALIGN_EPI>
__device__ __forceinline__ void gemm_phase(LAS unsigned char* lds, const bf16* Abase, const int K, const Sched& S, const Epi& E) {
    int tid_ = threadIdx.x; asm volatile("" : "+v"(tid_));
    const int tid = tid_, wid = __builtin_amdgcn_readfirstlane(tid >> 6), lane = tid & 63, wr = wid >> 2, wc = wid & 3, fr = lane & 15, fq = lane >> 4;
    const int nt = K / BK;
    unsigned voffB[2];
#pragma unroll
    for (int i = 0; i < 2; ++i) { int R, C; stage_rc(tid * 16 + i * 8192, R, C); const int Rb = Epi::PERM ? ((R & ~31) + perm32(R & 31)) : R;
        voffB[i] = (unsigned)(Rb * K + C) * 2u; }
    const size_t kstep = (size_t)(BK * 2);
    const size_t hstep = (size_t)HALF * K * 2;
    const unsigned ldsw = (unsigned)wid * 1024u;
    const int aoff = lds_byte(wr * 64 + fr, fq * 8), boff = lds_byte(wc * 32 + fr, fq * 8);
#define PG8_SA(b, h) (((b) * 2 + (h)) * HTB)
#define PG8_SB(b, h) ((4 + (b) * 2 + (h)) * HTB)
#define PG8_STAGE_B(bufoff, gbase) do { _Pragma("unroll") for (int _i = 0; _i < 2; ++_i) \
        __builtin_amdgcn_global_load_lds((const unsigned*)((const char*)(gbase) + voffB[_i]), (LAS unsigned*)(lds + (bufoff) + ldsw + _i * 8192), 16, 0, 0); } while (0)
#define PG8_STAGE_A(bufoff, offs, kb) do { _Pragma("unroll") for (int _i = 0; _i < 2; ++_i) \
        __builtin_amdgcn_global_load_lds((const unsigned*)((const char*)Abase + (size_t)(offs)[_i] + (size_t)(kb)), (LAS unsigned*)(lds + (bufoff) + ldsw + _i * 8192), 16, 0, 0); } while (0)
#define PG8_LDA(dst, b, h) do { _Pragma("unroll") for (int m = 0; m < 4; ++m) _Pragma("unroll") for (int k = 0; k < 2; ++k) dst[m][k] = *(const LAS bf16x8*)(lds + PG8_SA(b, h) + aoff + m * 2048 + k * 1024); } while (0)
#define PG8_LDB(dst, b, h) do { _Pragma("unroll") for (int n = 0; n < 2; ++n) _Pragma("unroll") for (int k = 0; k < 2; ++k) dst[n][k] = *(const LAS bf16x8*)(lds + PG8_SB(b, h) + boff + n * 2048 + k * 1024); } while (0)
#define PG8_MMA(ai, bj, At, Bt) do { __builtin_amdgcn_s_setprio(1); _Pragma("unroll") for (int m = 0; m < 4; ++m) _Pragma("unroll") for (int n = 0; n < 2; ++n) _Pragma("unroll") for (int k = 0; k < 2; ++k) \
        acc[ai][bj][m][n] = __builtin_amdgcn_mfma_f32_16x16x32_bf16(Bt[n][k], At[m][k], acc[ai][bj][m][n], 0, 0, 0); __builtin_amdgcn_s_setprio(0); } while (0)
#define PG8_WAIT_V(n) asm volatile("s_waitcnt vmcnt(" #n ")" ::: "memory")
#define PG8_WAIT_L(n) asm volatile("s_waitcnt lgkmcnt(" #n ")" ::: "memory")
#define PG8_BAR __builtin_amdgcn_s_barrier()
#define PG8_SCHED __builtin_amdgcn_sched_barrier(0)
#define PG8_AOFF(dst, u) do { int _t = tid; asm volatile("" : "+v"(_t)); _Pragma("unroll") for (int _i = 0; _i < 2; ++_i) { int _R, _C; stage_rc(_t * 16 + _i * 8192, _R, _C); \
        _Pragma("unroll") for (int _h = 0; _h < 2; ++_h) dst[_h][_i] = S.a_rowoff(u, _h * HALF + _R) + (unsigned)(_C * 2); } } while (0)
    Unit cur, nxt; int ui = 0;
    if (!S.next(0, cur)) return;
    f32x4 acc[2][2][4][2];
#pragma unroll
    for (int a = 0; a < 2; ++a)
#pragma unroll
        for (int b = 0; b < 2; ++b)
#pragma unroll
            for (int m = 0; m < 4; ++m)
#pragma unroll
                for (int n = 0; n < 2; ++n) acc[a][b][m][n] = (f32x4){0.f, 0.f, 0.f, 0.f};
    bf16x8 At[4][2], B0[2][2], B1[2][2];
    unsigned cA[2][2];
    PG8_AOFF(cA, cur);
    const char* cB = S.b_base(cur);
    PG8_STAGE_B(PG8_SB(0, 0), cB); PG8_STAGE_B(PG8_SB(0, 1), cB + hstep); PG8_STAGE_A(PG8_SA(0, 0), cA[0], 0); PG8_STAGE_A(PG8_SA(0, 1), cA[1], 0);
    if (wr == 1) PG8_BAR;
    PG8_WAIT_V(2); PG8_BAR;
    PG8_STAGE_B(PG8_SB(1, 0), cB + kstep); PG8_STAGE_A(PG8_SA(1, 0), cA[0], kstep); PG8_STAGE_B(PG8_SB(1, 1), cB + hstep + kstep);
    PG8_WAIT_V(6); PG8_BAR;
    for (;;) {
        const bool has_next = S.next(ui + 1, nxt);
        const char* nB = has_next ? S.b_base(nxt) : cB;
#pragma unroll 1
        for (int t = 0; t < nt; t += 2) {
            const bool last = (t == nt - 2);
            const size_t k1 = (size_t)(t + 1) * kstep;
            const size_t k2 = last ? (size_t)0 : (size_t)(t + 2) * kstep, k3 = k2 + kstep;
            const char* b2 = last ? nB : cB + (size_t)(t + 2) * kstep; const char* b3 = b2 + kstep;
            PG8_LDB(B0, 0, 0); PG8_LDB(B1, 0, 1); PG8_SCHED; PG8_LDA(At, 0, 0); PG8_STAGE_A(PG8_SA(1, 1), cA[1], k1);
            if (last && has_next) { PG8_AOFF(cA, nxt); }
            PG8_WAIT_V(8); PG8_WAIT_L(0); PG8_BAR; PG8_MMA(0, 0, At, B0); PG8_MMA(0, 1, At, B1); PG8_BAR; PG8_SCHED;
            PG8_LDA(At, 0, 1); PG8_STAGE_B(PG8_SB(0, 0), b2); PG8_STAGE_B(PG8_SB(0, 1), b2 + hstep); PG8_STAGE_A(PG8_SA(0, 0), cA[0], k2);
            PG8_WAIT_V(8); PG8_WAIT_L(0); PG8_BAR; PG8_MMA(1, 0, At, B0); PG8_MMA(1, 1, At, B1); PG8_BAR; PG8_SCHED;
            PG8_LDB(B0, 1, 0); PG8_LDB(B1, 1, 1); PG8_SCHED; PG8_LDA(At, 1, 0); PG8_STAGE_A(PG8_SA(0, 1), cA[1], k2);
            PG8_WAIT_V(8); PG8_WAIT_L(0); PG8_BAR; PG8_MMA(0, 0, At, B0); PG8_MMA(0, 1, At, B1); PG8_BAR; PG8_SCHED;
            PG8_LDA(At, 1, 1); PG8_STAGE_B(PG8_SB(1, 0), b3); PG8_STAGE_B(PG8_SB(1, 1), b3 + hstep); PG8_STAGE_A(PG8_SA(1, 0), cA[0], k3);
            PG8_WAIT_V(8); PG8_WAIT_L(0); PG8_BAR; PG8_MMA(1, 0, At, B0); PG8_MMA(1, 1, At, B1); PG8_BAR; PG8_SCHED;
        }
        if constexpr (ALIGN_EPI) { if (wr == 0) PG8_BAR; }
        E(acc, cur, wr, wc, fr, fq);
        if (!has_next) break;
#pragma unroll
        for (int a = 0; a < 2; ++a)
#pragma unroll
            for (int b = 0; b < 2; ++b)
#pragma unroll
                for (int m = 0; m < 4; ++m)
#pragma unroll
                    for (int n = 0; n < 2; ++n) acc[a][b][m][n] = (f32x4){0.f, 0.f, 0.f, 0.f};
        cur = nxt; cB = nB; ++ui;
        if constexpr (ALIGN_EPI) { if (wr == 1) PG8_BAR; }
    }
    PG8_WAIT_V(0);
    if constexpr (!ALIGN_EPI) { if (wr == 0) PG8_BAR; }
    PG8_BAR;
#undef PG8_SA
#undef PG8_SB
#undef PG8_STAGE_A
#undef PG8_STAGE_B
#undef PG8_LDA
#undef PG8_LDB
#undef PG8_MMA
#undef PG8_WAIT_V
#undef PG8_WAIT_L
#undef PG8_BAR
#undef PG8_SCHED
#undef PG8_AOFF
}

template <int LAYER> struct EpiIn {
    static constexpr bool PERM = true;
    bf16* Y; const float* rstd; float* vss; const float* cs; const float* sn; const float* qn; const float* kn;
    __device__ __forceinline__ void operator()(const f32x4 (&acc)[2][2][4][2], const Unit& u, int wr, int wc, int fr, int fq) const {
        constexpr int LD = LAYER == 0 ? IN0 : IN1;
        int type; bool isq;
        if (LAYER == 0) { type = u.pn < 2 ? 0 : (u.pn < 4 ? 1 : (u.pn < 10 ? 2 : 3)); isq = u.pn < 7; }
        else { type = (u.pn < 4 || wc < 2) ? 2 : 3; isq = u.pn < 4; }
        f32x4 g[2][2];
        if (type == 2) { const float* gn = isq ? qn : kn;
#pragma unroll
            for (int bj = 0; bj < 2; ++bj)
#pragma unroll
                for (int n = 0; n < 2; ++n) { g[bj][n] = *(const f32x4*)(gn + 32 * bj + 8 * fq + 4 * n); if (isq) g[bj][n] = g[bj][n] * QSCALE; } }
        const int colb = u.pn * BM + 64 * wc + 8 * fq;
#pragma unroll
        for (int ai = 0; ai < 2; ++ai)
#pragma unroll
            for (int m = 0; m < 4; ++m) {
                const int row = u.pm * BM + ai * HALF + wr * 64 + m * 16 + fr;
                const float rs = rstd[row];
                f32x4 v[2][2];
#pragma unroll
                for (int bj = 0; bj < 2; ++bj)
#pragma unroll
                    for (int n = 0; n < 2; ++n) v[bj][n] = acc[ai][bj][m][n] * rs;
                if (type <= 1) {
#pragma unroll
                    for (int bj = 0; bj < 2; ++bj)
#pragma unroll
                        for (int n = 0; n < 2; ++n) { v[bj][n].x = gelu_fast(v[bj][n].x); v[bj][n].y = gelu_fast(v[bj][n].y); v[bj][n].z = gelu_fast(v[bj][n].z); v[bj][n].w = gelu_fast(v[bj][n].w); }
                } else if (type == 2) {
                    float ss = 0.f;
#pragma unroll
                    for (int bj = 0; bj < 2; ++bj)
#pragma unroll
                        for (int n = 0; n < 2; ++n) ss += (v[bj][n].x * v[bj][n].x + v[bj][n].y * v[bj][n].y) + (v[bj][n].z * v[bj][n].z + v[bj][n].w * v[bj][n].w);
                    ss += __shfl_xor(ss, 16); ss += __shfl_xor(ss, 32);
                    const float hr = 1.0f / sqrtf(ss * (1.0f / 64.0f) + EPS);
#pragma unroll
                    for (int bj = 0; bj < 2; ++bj)
#pragma unroll
                        for (int n = 0; n < 2; ++n) v[bj][n] = v[bj][n] * g[bj][n] * hr;
                    f32x4 o[2];
#pragma unroll
                    for (int n = 0; n < 2; ++n) { o[n].x = __shfl_xor(v[0][n].x, 16); o[n].y = __shfl_xor(v[0][n].y, 16); o[n].z = __shfl_xor(v[0][n].z, 16); o[n].w = __shfl_xor(v[0][n].w, 16); }
                    if (fq < 2) {
                        const f32x4 c0 = *(const f32x4*)(cs + (size_t)row * 8), c1 = *(const f32x4*)(cs + (size_t)row * 8 + 4);
                        f32x4 s0 = *(const f32x4*)(sn + (size_t)row * 8), s1 = *(const f32x4*)(sn + (size_t)row * 8 + 4);
                        if (fq == 0) { s0 = -s0; s1 = -s1; }
                        v[0][0] = v[0][0] * c0 + o[0] * s0; v[0][1] = v[0][1] * c1 + o[1] * s1;
                    }
                }
                bf16* rowp = Y + (size_t)row * LD + colb;
                float vsum = 0.f;
#pragma unroll
                for (int bj = 0; bj < 2; ++bj) {
                    u32x4 w; w.x = pk2(v[bj][0].x, v[bj][0].y); w.y = pk2(v[bj][0].z, v[bj][0].w); w.z = pk2(v[bj][1].x, v[bj][1].y); w.w = pk2(v[bj][1].z, v[bj][1].w);
                    *(u32x4*)(rowp + 32 * bj) = w;
                    if (LAYER == 0 && type == 1) {
#pragma unroll
                        for (int q = 0; q < 4; ++q) { const float lo = __uint_as_float(w[q] << 16), hi = __uint_as_float(w[q] & 0xffff0000u); vsum += lo * lo + hi * hi; }
                    }
                }
                if (LAYER == 0 && type == 1) { vsum += __shfl_xor(vsum, 16); vsum += __shfl_xor(vsum, 32); if (fq == 0) vss[(size_t)row * 8 + (u.pn - 2) * 4 + wc] = vsum; }
            }
    }
};
template <bool RESID_BF16> struct EpiRes {
    static constexpr bool PERM = true;
    const float* xres; bf16* hbuf;
    __device__ __forceinline__ void operator()(const f32x4 (&acc)[2][2][4][2], const Unit& u, int wr, int wc, int fr, int fq) const {
        const int row0 = u.pm * BM + wr * 64 + fr, col0 = u.pn * BM + wc * 32 + 8 * fq;
#pragma unroll
        for (int ai = 0; ai < 2; ++ai)
#pragma unroll
            for (int m = 0; m < 4; ++m) { const size_t off = (size_t)(row0 + ai * HALF + m * 16) * D + col0;
#pragma unroll
                for (int bj = 0; bj < 2; ++bj) {
                    f32x4 r0, r1;
                    if (RESID_BF16) { const u32x4 t = *(const u32x4*)(hbuf + off + bj * HALF);
                        r0 = (f32x4){__uint_as_float(t.x << 16), __uint_as_float(t.x & 0xffff0000u), __uint_as_float(t.y << 16), __uint_as_float(t.y & 0xffff0000u)};
                        r1 = (f32x4){__uint_as_float(t.z << 16), __uint_as_float(t.z & 0xffff0000u), __uint_as_float(t.w << 16), __uint_as_float(t.w & 0xffff0000u)}; }
                    else { r0 = *(const f32x4*)(xres + off + bj * HALF); r1 = *(const f32x4*)(xres + off + bj * HALF + 4); }
                    const f32x4 v0 = r0 + acc[ai][bj][m][0], v1 = r1 + acc[ai][bj][m][1];
                    u32x4 w; w.x = pk2(v0.x, v0.y); w.y = pk2(v0.z, v0.w); w.z = pk2(v1.x, v1.y); w.w = pk2(v1.z, v1.w);
                    *(u32x4*)(hbuf + off + bj * HALF) = w; } }
    }
};
__device__ __forceinline__ void moe_setup(volatile LAS int* tb, const int* counts) {
    if (threadIdx.x == 0) { int sacc = 0; for (int e = 0; e < NE; ++e) { tb[e] = sacc; sacc += (counts[e] + 255) >> 8; } tb[NE] = sacc; }
    __syncthreads();
}
template <int NPN, bool GATHER> struct MoeOrder {
    const volatile LAS int* tb; const int* counts; const int* elist; int K, brows; const bf16* Bt;
    int tile0, ntiles, cc, nwg;
    __device__ __forceinline__ bool next(int i, Unit& u) const {
        const int L = i * nwg + cc; if (L >= ntiles * NPN) return false;
        const int tile = tile0 + L / NPN; int e = 0, te = 0;
#pragma unroll 1
        for (int x = 1; x < NE; ++x) { const int v = __builtin_amdgcn_readfirstlane(tb[x]); if (v <= tile) { e = x; te = v; } }
        u.e = e; u.pm = tile - te; u.pn = L % NPN; u.aux = tile; return true;
    }
    __device__ __forceinline__ unsigned a_rowoff(const Unit& u, int r) const {
        if (GATHER) { const int pos = u.pm * BM + r; const int tok = pos < counts[u.e] ? (elist[u.e * T + pos] >> 1) : 0; return (unsigned)tok * (unsigned)(K * 2); }
        return (unsigned)(u.aux * BM + r) * (unsigned)(K * 2);
    }
    __device__ __forceinline__ const char* b_base(const Unit& u) const { return (const char*)Bt + ((size_t)u.e * brows + (size_t)u.pn * BM) * K * 2; }
};
struct EpiGU {
    static constexpr bool PERM = true;
    bf16* hid; const float* rstd; const int* counts; const int* elist;
    __device__ __forceinline__ void operator()(const f32x4 (&acc)[2][2][4][2], const Unit& u, int wr, int wc, int fr, int fq) const {
        const int cnt = counts[u.e];
#pragma unroll
        for (int ai = 0; ai < 2; ++ai)
#pragma unroll
            for (int m = 0; m < 4; ++m) {
                const int r = ai * HALF + wr * 64 + m * 16 + fr, pos = u.pm * BM + r;
                if (pos < cnt) {
                    const int tok = elist[u.e * T + pos] >> 1; const float rs = rstd[tok];
                    u32x4 w;
#pragma unroll
                    for (int n = 0; n < 2; ++n) {
                        const f32x4 g = acc[ai][0][m][n] * rs, up = acc[ai][1][m][n] * rs; f32x4 h;
                        h.x = g.x * __builtin_amdgcn_rcpf(1.0f + __builtin_amdgcn_exp2f(-1.4426950408889634f * g.x)) * up.x;
                        h.y = g.y * __builtin_amdgcn_rcpf(1.0f + __builtin_amdgcn_exp2f(-1.4426950408889634f * g.y)) * up.y;
                        h.z = g.z * __builtin_amdgcn_rcpf(1.0f + __builtin_amdgcn_exp2f(-1.4426950408889634f * g.z)) * up.z;
                        h.w = g.w * __builtin_amdgcn_rcpf(1.0f + __builtin_amdgcn_exp2f(-1.4426950408889634f * g.w)) * up.w;
                        if (n == 0) { w.x = pk2(h.x, h.y); w.y = pk2(h.z, h.w); } else { w.z = pk2(h.x, h.y); w.w = pk2(h.z, h.w); }
                    }
                    *(u32x4*)(hid + (size_t)(u.aux * BM + r) * FF + u.pn * HALF + wc * 32 + 8 * fq) = w;
                }
            }
    }
};
struct EpiDown {
    static constexpr bool PERM = true;
    bf16* yp; const float* gw; const int* counts; const int* elist;
    __device__ __forceinline__ void operator()(const f32x4 (&acc)[2][2][4][2], const Unit& u, int wr, int wc, int fr, int fq) const {
        const int cnt = counts[u.e];
#pragma unroll
        for (int ai = 0; ai < 2; ++ai)
#pragma unroll
            for (int m = 0; m < 4; ++m) {
                const int r = ai * HALF + wr * 64 + m * 16 + fr, pos = u.pm * BM + r;
                if (pos < cnt) {
                    const int pair = elist[u.e * T + pos]; const float gv = gw[pair];
                    bf16* rowp = yp + (size_t)pair * D + u.pn * BM + wc * 32 + 8 * fq;
#pragma unroll
                    for (int bj = 0; bj < 2; ++bj) { const f32x4 v0 = acc[ai][bj][m][0] * gv, v1 = acc[ai][bj][m][1] * gv;
                        u32x4 w; w.x = pk2(v0.x, v0.y); w.y = pk2(v0.z, v0.w); w.z = pk2(v1.x, v1.y); w.w = pk2(v1.z, v1.w);
                        *(u32x4*)(rowp + bj * HALF) = w; }
                }
            }
    }
};
}


typedef float f32x16 __attribute__((ext_vector_type(16)));
typedef short s16x4 __attribute__((ext_vector_type(4)));
__device__ __forceinline__ int crow(int r, int hi) { return (r & 3) + 8 * (r >> 2) + 4 * hi; }
__device__ __forceinline__ s16x4 lds_tr(LAS unsigned char* p) { return __builtin_bit_cast(s16x4, __builtin_amdgcn_ds_read_tr16_b64_v4i16((LAS s16x4*)p)); }
constexpr int VST_PITCH = 144, VST_BYTES = 32 * VST_PITCH;
template <int W> __device__ __forceinline__ void attn_tile(const bf16* __restrict__ Qp, size_t qstride, const bf16* __restrict__ Kp, const bf16* __restrict__ Vp, size_t kvstride, int q0,
                                                          LAS unsigned char* vst, float sinkv, f32x16 (&o)[2], float& m_out, float& l_out, const int lane) {
    const int r32 = lane & 31, hi = lane >> 5;
    bf16x8 qf[4];
#pragma unroll
    for (int d0 = 0; d0 < 4; ++d0) qf[d0] = *(const bf16x8*)(Qp + (size_t)r32 * qstride + d0 * 16 + hi * 8);
    f32x16 sc[5];
#pragma unroll
    for (int c = 0; c < 5; ++c) {
        int ki = q0 - 128 + 32 * c + r32; ki = ki < 0 ? 0 : ki;
        const bf16* kp = Kp + (size_t)ki * kvstride + hi * 8;
        f32x16 acc = {};
#pragma unroll
        for (int d0 = 0; d0 < 4; ++d0) { const bf16x8 kf = *(const bf16x8*)(kp + d0 * 16); acc = __builtin_amdgcn_mfma_f32_32x32x16_bf16(kf, qf[d0], acc, 0, 0, 0); }
        sc[c] = acc;
    }
    float m = sinkv;
#pragma unroll
    for (int c = 0; c < 5; ++c)
#pragma unroll
        for (int r = 0; r < 16; ++r) {
            const int kk = 32 * c + crow(r, hi), rel = 128 + r32 - kk;
            const bool ok = (rel >= 0) && (rel <= W) && (q0 - 128 + kk >= 0);
            const float v = ok ? sc[c][r] : -INFINITY; sc[c][r] = v; m = fmaxf(m, v);
        }
    m = fmaxf(m, __shfl_xor(m, 32));
    float l = 0.f;
#pragma unroll
    for (int c = 0; c < 5; ++c)
#pragma unroll
        for (int r = 0; r < 16; ++r) { const float pv = __builtin_amdgcn_exp2f(sc[c][r] - m); sc[c][r] = pv; l += pv; }
    l += __shfl_xor(l, 32);
    l += __builtin_amdgcn_exp2f(sinkv - m);
    o[0] = (f32x16){}; o[1] = (f32x16){};
    const int vr = lane >> 1, vcb = (lane & 1) * 64;
    const int g16 = lane >> 4, q4 = (lane & 15) >> 2, p4 = lane & 3;
    LAS unsigned char* trbase = vst + (4 * (g16 >> 1) + q4) * VST_PITCH + (16 * (g16 & 1) + 4 * p4) * 2;
#pragma unroll
    for (int c = 0; c < 5; ++c) {
        LAS unsigned char* buf = vst + (c & 1) * VST_BYTES;
        int ki = q0 - 128 + 32 * c + vr; ki = ki < 0 ? 0 : ki;
        const u32x4* vp = (const u32x4*)((const unsigned char*)(Vp + (size_t)ki * kvstride) + vcb);
        u32x4 t0 = vp[0], t1 = vp[1], t2 = vp[2], t3 = vp[3];
        LAS u32x4* wp = (LAS u32x4*)(buf + vr * VST_PITCH + vcb);
        wp[0] = t0; wp[1] = t1; wp[2] = t2; wp[3] = t3;
#pragma unroll
        for (int ks = 0; ks < 2; ++ks) {
            bf16x8 pb;
#pragma unroll
            for (int j = 0; j < 4; ++j) { const unsigned w = pk2(sc[c][8 * ks + 2 * j], sc[c][8 * ks + 2 * j + 1]); pb[2 * j] = (short)(w & 0xffffu); pb[2 * j + 1] = (short)(w >> 16); }
#pragma unroll
            for (int db = 0; db < 2; ++db) {
                LAS unsigned char* tp = trbase + (c & 1) * VST_BYTES + (16 * ks) * VST_PITCH + db * 64;
                const s16x4 lo = lds_tr(tp), hi4 = lds_tr(tp + 8 * VST_PITCH);
                const bf16x8 vf = {lo[0], lo[1], lo[2], lo[3], hi4[0], hi4[1], hi4[2], hi4[3]};
                o[db] = __builtin_amdgcn_mfma_f32_32x32x16_bf16(vf, pb, o[db], 0, 0, 0);
            }
        }
    }
    m_out = m; l_out = l;
}
__device__ __forceinline__ void f_swa(LAS unsigned char* lds, const bf16* __restrict__ Y1, const float* __restrict__ sinks, bf16* __restrict__ O) {
    const int tid = opaque_tid(), lane = tid & 63, wave = __builtin_amdgcn_readfirstlane(tid >> 6), r32 = lane & 31, hi = lane >> 5;
    LAS unsigned char* vst = lds + wave * (2 * VST_BYTES);
    for (int it = vcu_id(); it < 1024; it += gridDim.x) {
        const int kvh = it & 1, qt = (it >> 1) & 255, b = it >> 9, hq = kvh * 8 + wave, q0 = qt * 32;
        const bf16* rowb = Y1 + (size_t)b * SEQ * IN1;
        f32x16 o[2]; float m, l;
        attn_tile<127>(rowb + (size_t)q0 * IN1 + hq * 64, IN1, rowb + 1024 + kvh * 64, rowb + 1152 + kvh * 64, IN1, q0, vst, sinks[hq] * 1.4426950408889634f, o, m, l, lane);
        const float inv = 1.0f / l;
        bf16* op = O + (size_t)(b * SEQ + q0 + r32) * D + hq * 64 + 4 * hi;
#pragma unroll
        for (int db = 0; db < 2; ++db)
#pragma unroll
            for (int g4 = 0; g4 < 4; ++g4) { u32x2 w; w.x = pk2(o[db][4 * g4] * inv, o[db][4 * g4 + 1] * inv); w.y = pk2(o[db][4 * g4 + 2] * inv, o[db][4 * g4 + 3] * inv);
                *(u32x2*)(op + 32 * db + 8 * g4) = w; }
    }
}


constexpr int OB_OFF = 73728, OB_PITCH = 136, LSE_OFF = 143360;
__device__ __forceinline__ void dil_item(LAS unsigned char* lds, const bf16* __restrict__ Y, bf16* __restrict__ A2, int item) {
    const int tid = opaque_tid(), lane = tid & 63, wave = __builtin_amdgcn_readfirstlane(tid >> 6), r32 = lane & 31, hi = lane >> 5;
    const int blk = item & 15, j = (item >> 4) & 3, b = item >> 6;
    LAS unsigned char* vst = lds + wave * (2 * VST_BYTES);
    LAS unsigned char* OB = lds + OB_OFF; LAS float* LSE = (LAS float*)(lds + LSE_OFF);
    const bf16* rowb = Y + (size_t)b * SEQ * IN0;
#pragma unroll 1
    for (int pass = 0; pass < 3; ++pass) {
        const int g = 2 - pass, dil = 1 << (2 * g), tpc = 16 >> (2 * g), h = g * 4 + j;
#pragma unroll 1
        for (int tt = 0; tt < 2; ++tt) {
            const int tile = wave + 8 * tt, r = tile / tpc, ti = tile % tpc;
            const int q0 = (blk * 512) / dil + 32 * ti;
            const bf16* base = rowb + (size_t)r * IN0;
            f32x16 o[2]; float m, l;
            attn_tile<128>(base + (size_t)q0 * dil * IN0 + 1024 + h * 64, (size_t)dil * IN0, base + 1792 + h * 64, base + 2560 + h * 64, (size_t)dil * IN0, q0, vst, -INFINITY, o, m, l, lane);
            const int tok = r + dil * (32 * ti + r32);
            float lse = m + __builtin_amdgcn_logf(l);
            float wb = 1.0f / l, wa = 0.f;
            if (pass > 0) {
                const float lp = LSE[tok], M = fmaxf(lp, lse);
                const float ea = __builtin_amdgcn_exp2f(lp - M), eb = __builtin_amdgcn_exp2f(lse - M), inv = 1.0f / (ea + eb);
                wa = ea * inv; wb = eb * inv / l; lse = M + __builtin_amdgcn_logf(ea + eb);
            }
            LAS unsigned char* ob = OB + tok * OB_PITCH + 8 * hi;
            bf16* gp = A2 + (size_t)(b * SEQ + blk * 512 + tok) * OUT0K + 512 + j * 64 + 4 * hi;
#pragma unroll
            for (int db = 0; db < 2; ++db)
#pragma unroll
                for (int g4 = 0; g4 < 4; ++g4) {
                    float v0 = o[db][4 * g4] * wb, v1 = o[db][4 * g4 + 1] * wb, v2 = o[db][4 * g4 + 2] * wb, v3 = o[db][4 * g4 + 3] * wb;
                    LAS u32x2* q = (LAS u32x2*)(ob + 64 * db + 16 * g4);
                    if (pass > 0) { const u32x2 pw = *q;
                        v0 += wa * __uint_as_float(pw.x << 16); v1 += wa * __uint_as_float(pw.x & 0xffff0000u); v2 += wa * __uint_as_float(pw.y << 16); v3 += wa * __uint_as_float(pw.y & 0xffff0000u); }
                    u32x2 w; w.x = pk2(v0, v1); w.y = pk2(v2, v3);
                    if (pass < 2) *q = w; else *(u32x2*)(gp + 32 * db + 8 * g4) = w;
                }
            if (pass < 2) LSE[tok] = lse;
        }
        __syncthreads();
    }
}
__device__ __forceinline__ void sgu_item(LAS unsigned char* lds, const bf16* __restrict__ Y, const float* __restrict__ vss, const float* __restrict__ gn, const float* __restrict__ w, const float* __restrict__ bs,
                                         bf16* __restrict__ A2, int cidx) {
    const int tid = opaque_tid(), lane = tid & 63, g = __builtin_amdgcn_readfirstlane(tid >> 6), r32 = lane & 31, hi = lane >> 5;
    LAS unsigned char* vst = lds + g * (2 * VST_BYTES);
    const int r0 = cidx * 128;
    f32x16 acc[4][2];
#pragma unroll
    for (int a = 0; a < 4; ++a) { acc[a][0] = (f32x16){}; acc[a][1] = (f32x16){}; }
    const int vr = lane >> 1, vhalf = lane & 1;
    const int g16 = lane >> 4, q4 = (lane & 15) >> 2, p4 = lane & 3;
    LAS unsigned char* trbase = vst + (4 * (g16 >> 1) + q4) * VST_PITCH + (16 * (g16 & 1) + 4 * p4) * 2;
#pragma unroll
    for (int sc = 0; sc < 4; ++sc) {
        LAS unsigned char* buf = vst + (sc & 1) * VST_BYTES;
        {
            const int row = r0 + 32 * sc + vr;
            const f32x4 p0 = *(const f32x4*)(vss + (size_t)row * 8), p1 = *(const f32x4*)(vss + (size_t)row * 8 + 4);
            const float rs = 1.0f / sqrtf(((p0.x + p0.y) + (p0.z + p0.w) + (p1.x + p1.y) + (p1.z + p1.w)) * (1.0f / 512.0f) + EPS);
            const u32x4* vp = (const u32x4*)(Y + (size_t)row * IN0 + 512 + g * 64 + 32 * vhalf);
            const float* gp = gn + g * 64 + 32 * vhalf;
            LAS u32x4* wp = (LAS u32x4*)(buf + vr * VST_PITCH + 64 * vhalf);
#pragma unroll
            for (int i = 0; i < 4; ++i) { const u32x4 t = vp[i]; const f32x4 ga = *(const f32x4*)(gp + 8 * i), gb = *(const f32x4*)(gp + 8 * i + 4); u32x4 o;
                o.x = pk2(__uint_as_float(t.x << 16) * rs * ga.x, __uint_as_float(t.x & 0xffff0000u) * rs * ga.y);
                o.y = pk2(__uint_as_float(t.y << 16) * rs * ga.z, __uint_as_float(t.y & 0xffff0000u) * rs * ga.w);
                o.z = pk2(__uint_as_float(t.z << 16) * rs * gb.x, __uint_as_float(t.z & 0xffff0000u) * rs * gb.y);
                o.w = pk2(__uint_as_float(t.w << 16) * rs * gb.z, __uint_as_float(t.w & 0xffff0000u) * rs * gb.w);
                wp[i] = o; }
        }
#pragma unroll
        for (int ks = 0; ks < 2; ++ks) {
            bf16x8 vf[2];
#pragma unroll
            for (int db = 0; db < 2; ++db) { LAS unsigned char* tp = trbase + (sc & 1) * VST_BYTES + (16 * ks) * VST_PITCH + db * 64;
                const s16x4 lo = lds_tr(tp), hi4 = lds_tr(tp + 8 * VST_PITCH); vf[db] = (bf16x8){lo[0], lo[1], lo[2], lo[3], hi4[0], hi4[1], hi4[2], hi4[3]}; }
#pragma unroll
            for (int tt = sc; tt < 4; ++tt) {
                const int t = 32 * tt + r32, s0 = 32 * sc + 16 * ks + 4 * hi;
                const float* wrow = w + ((size_t)(g * 128 + t) * 128 + s0);
                f32x4 w0 = *(const f32x4*)wrow, w1 = *(const f32x4*)(wrow + 8);
                if (tt == sc) {
                    w0.x = (s0 + 0 <= t) ? w0.x : 0.f; w0.y = (s0 + 1 <= t) ? w0.y : 0.f; w0.z = (s0 + 2 <= t) ? w0.z : 0.f; w0.w = (s0 + 3 <= t) ? w0.w : 0.f;
                    w1.x = (s0 + 8 <= t) ? w1.x : 0.f; w1.y = (s0 + 9 <= t) ? w1.y : 0.f; w1.z = (s0 + 10 <= t) ? w1.z : 0.f; w1.w = (s0 + 11 <= t) ? w1.w : 0.f;
                }
                const unsigned a0 = pk2(w0.x, w0.y), a1 = pk2(w0.z, w0.w), a2 = pk2(w1.x, w1.y), a3 = pk2(w1.z, w1.w);
                const bf16x8 wf = {(short)(a0 & 0xffffu), (short)(a0 >> 16), (short)(a1 & 0xffffu), (short)(a1 >> 16), (short)(a2 & 0xffffu), (short)(a2 >> 16), (short)(a3 & 0xffffu), (short)(a3 >> 16)};
#pragma unroll
                for (int db = 0; db < 2; ++db) acc[tt][db] = __builtin_amdgcn_mfma_f32_32x32x16_bf16(vf[db], wf, acc[tt][db], 0, 0, 0);
            }
        }
    }
#pragma unroll
    for (int tt = 0; tt < 4; ++tt) {
        const int t = 32 * tt + r32; const float bias = bs[g * 128 + t];
        const size_t row = (size_t)(r0 + t);
        const bf16* up = Y + row * IN0 + g * 64 + 4 * hi; bf16* op = A2 + row * OUT0K + g * 64 + 4 * hi;
#pragma unroll
        for (int db = 0; db < 2; ++db)
#pragma unroll
            for (int g4 = 0; g4 < 4; ++g4) { const u32x2 uu = *(const u32x2*)(up + 32 * db + 8 * g4); u32x2 o;
                o.x = pk2((acc[tt][db][4 * g4] + bias) * __uint_as_float(uu.x << 16), (acc[tt][db][4 * g4 + 1] + bias) * __uint_as_float(uu.x & 0xffff0000u));
                o.y = pk2((acc[tt][db][4 * g4 + 2] + bias) * __uint_as_float(uu.y << 16), (acc[tt][db][4 * g4 + 3] + bias) * __uint_as_float(uu.y & 0xffff0000u));
                *(u32x2*)(op + 32 * db + 8 * g4) = o; }
    }
}
__device__ __forceinline__ void f_mixers0(LAS unsigned char* lds, const bf16* Y, const float* vss, const float* gn, const float* w, const float* bs, bf16* A2) {
    for (int id = vcu_id(); id < 256; id += gridDim.x) {
        if (id < 128) dil_item(lds, Y, A2, id);
        else sgu_item(lds, Y, vss, gn, w, bs, A2, id - 128);
    }
}


__device__ __forceinline__ void build_router_tab(const float* __restrict__ gf, const float* __restrict__ wrg, const float* __restrict__ wre, bf16* __restrict__ RT) {
    for (int i = blockIdx.x * NTHR + opaque_tid(); i < 64 * D; i += gridDim.x * NTHR) {
        const int n = i >> 10, k = i & 1023; float v = 0.f;
        if (n < 36) v = ((n < 4) ? wrg[k * 4 + n] : wre[((size_t)((n - 4) >> 3) * D + k) * 8 + ((n - 4) & 7)]) * gf[k];
        const bf16 hi = f2bf(v); RT[i] = hi; RT[64 * D + i] = f2bf(v - bf2f(hi));
    }
}
__device__ __forceinline__ void f_router(LAS unsigned char* lds, const bf16* __restrict__ hb, const bf16* __restrict__ RT, const float* __restrict__ brg, const float* __restrict__ bre,
                                         float* __restrict__ rstd, int* __restrict__ eid, float* __restrict__ gw, int* counts, int* __restrict__ elist) {
    const int tid = opaque_tid(), lane = tid & 63, r32 = lane & 31, hi = lane >> 5, wv = __builtin_amdgcn_readfirstlane(tid >> 6);
    LAS float* Ps = (LAS float*)lds;
    LAS float* Qs = Ps + 8 * 64 * 37;
    LAS float* Ls = Qs + 8 * 2 * 64;
    LAS float* Ss = Ls + 64 * 37;
    LAS int* Hc = (LAS int*)(Ss + 64);
    for (int tile = vcu_id(); tile < T / 64; tile += gridDim.x) {
        const int r0 = tile * 64;
        if (tid < 64) Hc[tid] = 0;
        f32x16 acc[2][2];
#pragma unroll
        for (int x = 0; x < 2; ++x) { acc[x][0] = (f32x16){}; acc[x][1] = (f32x16){}; }
        float ssq[2] = {0.f, 0.f};
#pragma unroll 4
        for (int ks = 0; ks < 8; ++ks) {
            const int k0 = wv * 128 + ks * 16 + 8 * hi;
            bf16x8 ah[2], bh[2], bl[2];
#pragma unroll
            for (int rb = 0; rb < 2; ++rb) {
                const u32x4 t = *(const u32x4*)(hb + (size_t)(r0 + 32 * rb + r32) * D + k0);
                ah[rb] = __builtin_bit_cast(bf16x8, t);
#pragma unroll
                for (int q = 0; q < 4; ++q) { const float lo = __uint_as_float(t[q] << 16), hf = __uint_as_float(t[q] & 0xffff0000u); ssq[rb] += lo * lo + hf * hf; }
            }
#pragma unroll
            for (int cb = 0; cb < 2; ++cb) { const bf16* wp = RT + (size_t)(32 * cb + r32) * D + k0; bh[cb] = *(const bf16x8*)wp; bl[cb] = *(const bf16x8*)(wp + 64 * D); }
#pragma unroll
            for (int rb = 0; rb < 2; ++rb)
#pragma unroll
                for (int cb = 0; cb < 2; ++cb) {
                    acc[rb][cb] = __builtin_amdgcn_mfma_f32_32x32x16_bf16(ah[rb], bh[cb], acc[rb][cb], 0, 0, 0);
                    acc[rb][cb] = __builtin_amdgcn_mfma_f32_32x32x16_bf16(ah[rb], bl[cb], acc[rb][cb], 0, 0, 0);
                }
        }
#pragma unroll
        for (int rb = 0; rb < 2; ++rb) {
#pragma unroll
            for (int r = 0; r < 16; ++r) { LAS float* pr = Ps + (wv * 64 + 32 * rb + crow(r, hi)) * 37; pr[r32] = acc[rb][0][r]; if (r32 < 4) pr[32 + r32] = acc[rb][1][r]; }
            Qs[(wv * 2 + hi) * 64 + 32 * rb + r32] = ssq[rb];
        }
        __syncthreads();
        {
            const int row = tid & 63, cg = tid >> 6;
#pragma unroll
            for (int c = 0; c < 5; ++c) { const int n = cg * 5 + c; if (n < 36) { float v = 0.f;
#pragma unroll
                for (int w8 = 0; w8 < 8; ++w8) v += Ps[(w8 * 64 + row) * 37 + n]; Ls[row * 37 + n] = v; } }
            if (cg == 7) { float v = 0.f;
#pragma unroll
                for (int w8 = 0; w8 < 16; ++w8) v += Qs[w8 * 64 + row]; Ss[row] = v; }
        }
        __syncthreads();
        int e0 = 0, e1 = 0, k0r = 0, k1r = 0;
        if (tid < 64) {
            const int r = r0 + tid; const LAS float* L = Ls + tid * 37;
            const float rs = 1.0f / sqrtf(Ss[tid] * (1.0f / D) + EPS);
            float lg[4];
#pragma unroll
            for (int g = 0; g < 4; ++g) lg[g] = L[g] * rs + brg[g];
            int gi = 0; float lmax = lg[0];
#pragma unroll
            for (int g = 1; g < 4; ++g) if (lg[g] > lmax) { lmax = lg[g]; gi = g; }
            float zs = 0.f;
#pragma unroll
            for (int g = 0; g < 4; ++g) zs += expf(lg[g] - lmax);
            const float ptop = 1.0f / zs;
            int i0 = 0, i1 = -1; float l0 = -INFINITY, l1 = -INFINITY;
#pragma unroll 1
            for (int e = 0; e < 8; ++e) { const float v = L[4 + gi * 8 + e] * rs + bre[gi * 8 + e];
                if (v > l0) { l1 = l0; i1 = i0; l0 = v; i0 = e; } else if (v > l1) { l1 = v; i1 = e; } }
            const float r1 = expf(l1 - l0); const float g0 = ptop / (1.0f + r1), g1 = ptop * r1 / (1.0f + r1);
            rstd[r] = rs; e0 = gi * 8 + i0; e1 = gi * 8 + i1;
            eid[r * 2] = e0; eid[r * 2 + 1] = e1; gw[r * 2] = g0; gw[r * 2 + 1] = g1;
            k0r = __hip_atomic_fetch_add(&Hc[e0], 1, __ATOMIC_RELAXED, __HIP_MEMORY_SCOPE_WORKGROUP); k1r = __hip_atomic_fetch_add(&Hc[e1], 1, __ATOMIC_RELAXED, __HIP_MEMORY_SCOPE_WORKGROUP);
        }
        __syncthreads();
        if (tid < 32) { const int c = Hc[tid]; Hc[32 + tid] = c ? atomicAdd(&counts[tid], c) : 0; }
        __syncthreads();
        if (tid < 64) { const int r = r0 + tid; elist[e0 * T + Hc[32 + e0] + k0r] = r * 2; elist[e1 * T + Hc[32 + e1] + k1r] = r * 2 + 1; }
        __syncthreads();
    }
}
__device__ __forceinline__ void f_combine(bf16* hb, const bf16* __restrict__ yp, float* __restrict__ rstd, float* __restrict__ outf) {
    const int tid = opaque_tid(), lane = tid & 63;
    const int gwv = blockIdx.x * NWAVES + (tid >> 6), nw = gridDim.x * NWAVES;
    for (int r = gwv; r < T; r += nw) {
        u32x4* hr = (u32x4*)(hb + (size_t)r * D) + lane;
        const u32x4* y0 = (const u32x4*)(yp + (size_t)(2 * r) * D) + lane; const u32x4* y1 = (const u32x4*)(yp + (size_t)(2 * r + 1) * D) + lane;
        float s = 0.f;
#pragma unroll
        for (int j = 0; j < 2; ++j) { const u32x4 hv = hr[64 * j], a = y0[64 * j], b = y1[64 * j]; float v[8];
#pragma unroll
            for (int q = 0; q < 4; ++q) { v[2 * q] = __uint_as_float(hv[q] << 16) + __uint_as_float(a[q] << 16) + __uint_as_float(b[q] << 16);
                v[2 * q + 1] = __uint_as_float(hv[q] & 0xffff0000u) + __uint_as_float(a[q] & 0xffff0000u) + __uint_as_float(b[q] & 0xffff0000u); }
            if (outf) { f32x4* o = (f32x4*)(outf + (size_t)r * D + 512 * j) + 2 * lane; o[0] = (f32x4){v[0], v[1], v[2], v[3]}; o[1] = (f32x4){v[4], v[5], v[6], v[7]}; }
            else { u32x4 w; w.x = pk2(v[0], v[1]); w.y = pk2(v[2], v[3]); w.z = pk2(v[4], v[5]); w.w = pk2(v[6], v[7]); hr[64 * j] = w;
#pragma unroll
                for (int q = 0; q < 4; ++q) { const float lo = __uint_as_float(w[q] << 16), hf = __uint_as_float(w[q] & 0xffff0000u); s += lo * lo + hf * hf; } } }
        if (rstd) { s = wave_sum(s); if (lane == 0) rstd[r] = 1.0f / sqrtf(s * (1.0f / D) + EPS); }
    }
}

__device__ __forceinline__ float gelu_tanh(float x) { const float u = 0.7978845608028654f * (x + 0.044715f * x * x * x); return 0.5f * x * (1.0f + tanhf(u)); }
__device__ void n_rowprep(const float* __restrict__ src, bf16* __restrict__ hb, float* __restrict__ rstd) {
    const int gw = blockIdx.x * NWAVES + (threadIdx.x >> 6), lane = threadIdx.x & 63, nw = gridDim.x * NWAVES;
    for (int r = gw; r < T; r += nw) {
        const float* p = src + (size_t)r * D; float s = 0.f;
        for (int c = lane; c < D; c += 64) { float v = p[c]; s += v * v; hb[(size_t)r * D + c] = f2bf(v); }
        for (int o = 1; o < 64; o <<= 1) s += __shfl_xor(s, o);
        if (lane == 0) rstd[r] = 1.0f / sqrtf(s * (1.0f / D) + EPS);
    }
}
__device__ void n_rope_tab(const int* __restrict__ pos, float* __restrict__ cs, float* __restrict__ sn) {
    for (int i = blockIdx.x * NTHR + opaque_tid(); i < T * 8; i += gridDim.x * NTHR) {
        const int t = i >> 3, f = i & 7;
        const float inv = powf(500000.0f, -(float)f / 8.0f);
        const float ang = (float)pos[t] * inv;
        const double rev = (double)ang * 0.15915494309189535;
        const float fr = (float)(rev - floor(rev));
        cs[i] = __builtin_amdgcn_cosf(fr); sn[i] = __builtin_amdgcn_sinf(fr);
    }
}
__device__ void n_gemm(LAS unsigned char* lds, const bf16* __restrict__ A, int lda, const float* __restrict__ W, int M, int N, int K, const float* __restrict__ gain,
                       const float* __restrict__ rowscale, const float* resid, bf16* __restrict__ outb, int ldo, float* outf) {
    const int half = threadIdx.x >> 8, tid = threadIdx.x & 255;
    LAS float* sA = (LAS float*)(lds + half * 16384); LAS float* sB = sA + 16 * 65;
    const int tx = tid & 15, ty = tid >> 4, ntn = N / 64, nvb = ntn * (M / 64);
    for (int it = 0; (it * (int)gridDim.x) * 2 < nvb; ++it) {
        const int vb = (it * gridDim.x + blockIdx.x) * 2 + half; const bool ok = vb < nvb;
        const int m0 = ok ? (vb / ntn) * 64 : 0, n0 = ok ? (vb % ntn) * 64 : 0;
        float acc[4][4] = {};
        for (int k0 = 0; k0 < K; k0 += 16) {
            for (int e = tid; e < 1024; e += 256) { const int r = e >> 4, c = e & 15; sA[c * 65 + r] = bf2f(A[(size_t)(m0 + r) * lda + k0 + c]); }
            for (int e = tid; e < 1024; e += 256) { const int r = e >> 6, c = e & 63; sB[r * 65 + c] = W[(size_t)(k0 + r) * N + n0 + c] * (gain ? gain[k0 + r] : 1.0f); }
            __syncthreads();
#pragma unroll
            for (int k = 0; k < 16; ++k) {
                float a[4], b[4];
#pragma unroll
                for (int i = 0; i < 4; ++i) { a[i] = sA[k * 65 + ty * 4 + i]; b[i] = sB[k * 65 + tx * 4 + i]; }
#pragma unroll
                for (int i = 0; i < 4; ++i)
#pragma unroll
                    for (int j = 0; j < 4; ++j) acc[i][j] += a[i] * b[j];
            }
            __syncthreads();
        }
        if (ok)
#pragma unroll
        for (int i = 0; i < 4; ++i)
#pragma unroll
            for (int j = 0; j < 4; ++j) {
            const int m = m0 + ty * 4 + i, n = n0 + tx * 4 + j; float v = acc[i][j];
            if (rowscale) v *= rowscale[m];
            if (resid) v += resid[(size_t)m * N + n];
            if (outb) outb[(size_t)m * ldo + n] = f2bf(v);
            if (outf) outf[(size_t)m * N + n] = v;
        }
    }
}
__device__ void n_post(LAS unsigned char* lds, bf16* __restrict__ Y, int ld, int ngelu, int nq, int nk, float* __restrict__ vss, const float* __restrict__ cs, const float* __restrict__ sn,
                       const float* __restrict__ qn, const float* __restrict__ kn) {
    const int half = threadIdx.x >> 8, tid = threadIdx.x & 255;
    LAS float* red = (LAS float*)(lds + half * 16384); LAS float* hv = red + 256;
    const int nqk = (nq + nk) * 64;
    for (int it = 0; it * (int)gridDim.x * 2 < T; ++it) {
        const int t = (it * gridDim.x + blockIdx.x) * 2 + half; bf16* y = Y + (size_t)t * ld;
        if (ngelu) {
            float ss = 0.f;
            for (int c = tid; c < ngelu; c += 256) { float g = gelu_tanh(bf2f(y[c])); bf16 gb = f2bf(g); y[c] = gb; if (c >= ngelu / 2) { float gr = bf2f(gb); ss += gr * gr; } }
            red[tid] = ss; __syncthreads();
            for (int o = 128; o > 0; o >>= 1) { if (tid < o) red[tid] += red[tid + o]; __syncthreads(); }
            if (tid < 8) vss[(size_t)t * 8 + tid] = (tid == 0) ? red[0] : 0.f;
        }
        __syncthreads();
        for (int c = tid; c < nqk; c += 256) hv[c] = bf2f(y[ngelu + c]);
        __syncthreads();
        for (int c = tid; c < nqk; c += 256) {
            const int h = c >> 6, d = c & 63; const bool isq = h < nq; const float* gn = isq ? qn : kn;
            float s = 0.f; for (int j = 0; j < 64; ++j) { float v = hv[h * 64 + j]; s += v * v; }
            const float rs = 1.0f / sqrtf(s * (1.0f / 64.0f) + EPS);
            float o = hv[c] * rs * gn[d];
            if (d < 16) { const int f = d & 7; const float co = cs[t * 8 + f], si = sn[t * 8 + f];
                const float x1 = hv[h * 64 + f] * rs * gn[f], x2 = hv[h * 64 + 8 + f] * rs * gn[8 + f];
                o = (d < 8) ? (x1 * co - x2 * si) : (x2 * co + x1 * si); }
            if (isq) o *= QSCALE;
            y[ngelu + c] = f2bf(o);
        }
        __syncthreads();
    }
}
__device__ void n_sgu(const bf16* __restrict__ Y, const float* __restrict__ vss, const float* __restrict__ gn, const float* __restrict__ w, const float* __restrict__ bs, bf16* __restrict__ A2) {
    for (int i = blockIdx.x * NTHR + threadIdx.x; i < T * 512; i += gridDim.x * NTHR) {
        const int row = i >> 9, ch = i & 511, g = ch >> 6, tt = row & 127, r0 = row - tt;
        float acc = 0.f;
        for (int s = 0; s <= tt; ++s) {
            const int rs_ = r0 + s; float sum = 0.f; for (int j = 0; j < 8; ++j) sum += vss[(size_t)rs_ * 8 + j];
            const float rstd = 1.0f / sqrtf(sum * (1.0f / 512.0f) + EPS);
            const float v = bf2f(f2bf(bf2f(Y[(size_t)rs_ * IN0 + 512 + ch]) * rstd * gn[ch]));
            acc += bf2f(f2bf(w[(g * 128 + tt) * 128 + s])) * v;
        }
        acc += bs[g * 128 + tt];
        A2[(size_t)row * OUT0K + ch] = f2bf(bf2f(Y[(size_t)row * IN0 + ch]) * acc);
    }
}
__device__ void n_dil(const bf16* __restrict__ Y, bf16* __restrict__ A2) {
    const int d = threadIdx.x & 63;
    for (int i = blockIdx.x * NWAVES + (threadIdx.x >> 6); i < T * 4; i += gridDim.x * NWAVES) {
        const int row = i >> 2, j = i & 3, b = row / SEQ, t = row % SEQ;
        float m = -INFINITY, l = 0.f, o = 0.f;
        for (int g = 0; g < 3; ++g) {
            const int dil = (g == 0) ? 1 : (g == 1 ? 4 : 16), h = g * 4 + j;
            const float q = bf2f(Y[(size_t)row * IN0 + 1024 + h * 64 + d]);
            for (int n = 0; n <= 128; ++n) {
                const int tk = t - n * dil; if (tk < 0) break;
                const size_t kr = (size_t)(b * SEQ + tk) * IN0;
                float s = q * bf2f(Y[kr + 1792 + h * 64 + d]);
                for (int x = 1; x < 64; x <<= 1) s += __shfl_xor(s, x);
                const float mn = fmaxf(m, s), a = exp2f(m - mn), p = exp2f(s - mn);
                l = l * a + p; o = o * a + p * bf2f(Y[kr + 2560 + h * 64 + d]);
                m = mn;
            }
        }
        A2[(size_t)row * OUT0K + 512 + j * 64 + d] = f2bf(o / l);
    }
}
__device__ void n_swa(const bf16* __restrict__ Y, const float* __restrict__ sinks, bf16* __restrict__ O) {
    const int d = threadIdx.x & 63;
    for (int i = blockIdx.x * NWAVES + (threadIdx.x >> 6); i < T * 16; i += gridDim.x * NWAVES) {
        const int row = i >> 4, h = i & 15, kvh = h >> 3, b = row / SEQ, t = row % SEQ;
        const float q = bf2f(Y[(size_t)row * IN1 + h * 64 + d]);
        float m = sinks[h] * 1.4426950408889634f, l = 1.0f, o = 0.f;
        for (int n = 0; n < 128; ++n) {
            const int tk = t - n; if (tk < 0) break;
            const size_t kr = (size_t)(b * SEQ + tk) * IN1;
            float s = q * bf2f(Y[kr + 1024 + kvh * 64 + d]);
            for (int x = 1; x < 64; x <<= 1) s += __shfl_xor(s, x);
            const float mn = fmaxf(m, s), a = exp2f(m - mn), p = exp2f(s - mn);
            l = l * a + p; o = o * a + p * bf2f(Y[kr + 1152 + kvh * 64 + d]);
            m = mn;
        }
        O[(size_t)row * D + h * 64 + d] = f2bf(o / l);
    }
}
__device__ void n_router(const float* h, const float* __restrict__ gf, const float* __restrict__ wrg, const float* __restrict__ brg, const float* __restrict__ wre, const float* __restrict__ bre,
                         bf16* __restrict__ hb, float* __restrict__ rstd, int* __restrict__ eid, float* __restrict__ gw, int* counts, int* __restrict__ elist) {
    const int gwv = blockIdx.x * NWAVES + (threadIdx.x >> 6), lane = threadIdx.x & 63, nw = gridDim.x * NWAVES;
    for (int r = gwv; r < T; r += nw) {
        const float* p = h + (size_t)r * D; float s = 0.f;
        for (int c = lane; c < D; c += 64) { float v = p[c]; s += v * v; hb[(size_t)r * D + c] = f2bf(v); }
        for (int o = 1; o < 64; o <<= 1) s += __shfl_xor(s, o);
        const float rs = 1.0f / sqrtf(s * (1.0f / D) + EPS);
        float lg[4] = {0.f, 0.f, 0.f, 0.f};
        for (int c = lane; c < D; c += 64) { const float xn = p[c] * rs * gf[c];
#pragma unroll
            for (int g = 0; g < 4; ++g) lg[g] += xn * wrg[c * 4 + g]; }
#pragma unroll
        for (int g = 0; g < 4; ++g) { for (int o = 1; o < 64; o <<= 1) lg[g] += __shfl_xor(lg[g], o); lg[g] += brg[g]; }
        int gi = 0; float lmax = lg[0];
#pragma unroll
        for (int g = 1; g < 4; ++g) if (lg[g] > lmax) { lmax = lg[g]; gi = g; }
        float zs = 0.f;
#pragma unroll
        for (int g = 0; g < 4; ++g) zs += expf(lg[g] - lmax);
        const float ptop = 1.0f / zs;
        float le[8] = {0.f, 0.f, 0.f, 0.f, 0.f, 0.f, 0.f, 0.f};
        for (int c = lane; c < D; c += 64) { const float xn = p[c] * rs * gf[c];
#pragma unroll
            for (int e = 0; e < 8; ++e) le[e] += xn * wre[((size_t)gi * D + c) * 8 + e]; }
#pragma unroll
        for (int e = 0; e < 8; ++e) { for (int o = 1; o < 64; o <<= 1) le[e] += __shfl_xor(le[e], o); le[e] += bre[gi * 8 + e]; }
        int i0 = 0; float l0 = le[0];
#pragma unroll
        for (int e = 1; e < 8; ++e) if (le[e] > l0) { l0 = le[e]; i0 = e; }
        int i1 = -1; float l1 = -INFINITY;
#pragma unroll
        for (int e = 0; e < 8; ++e) if (e != i0 && le[e] > l1) { l1 = le[e]; i1 = e; }
        const float r1 = expf(l1 - l0); const float g0 = ptop / (1.0f + r1), g1 = ptop * r1 / (1.0f + r1);
        if (lane == 0) {
            rstd[r] = rs; const int e0 = gi * 8 + i0, e1 = gi * 8 + i1;
            eid[r * 2] = e0; eid[r * 2 + 1] = e1; gw[r * 2] = g0; gw[r * 2 + 1] = g1;
            const int p0 = atomicAdd(&counts[e0], 1); elist[e0 * T + p0] = r * 2;
            const int p1 = atomicAdd(&counts[e1], 1); elist[e1 * T + p1] = r * 2 + 1;
        }
    }
}
__device__ __forceinline__ bool slot_lookup(const int* counts, int slot, int& e, int& pos) {
    int base = 0; e = -1; pos = 0; bool ok = false;
    for (int x = 0; x < NE; ++x) { const int c = counts[x], pc = (c + 255) & ~255; if (e < 0 && slot < base + pc) { e = x; pos = slot - base; ok = pos < c; } base += pc; }
    if (e < 0) e = 0;
    return ok;
}
__device__ void n_gateup(LAS unsigned char* lds, const bf16* __restrict__ hb, const float* __restrict__ rstd, const float* __restrict__ gf, const float* __restrict__ wg, const float* __restrict__ wu,
                         const int* counts, const int* elist, bf16* __restrict__ hid) {
    const int half = threadIdx.x >> 8, j = threadIdx.x & 255; LAS float* xs = (LAS float*)(lds + half * 16384);
    for (int it = 0; it * (int)gridDim.x * 2 < SLOT_CAP; ++it) {
        const int slot = (it * gridDim.x + blockIdx.x) * 2 + half; int e, pos; const bool ok = slot_lookup(counts, slot, e, pos);
        const int pair = ok ? elist[e * T + pos] : 0, t = pair >> 1;
        for (int c = j; c < D; c += 256) xs[c] = bf2f(hb[(size_t)t * D + c]);
        __syncthreads();
        if (ok) {
            float g = 0.f, u = 0.f; const float* pg = wg + (size_t)e * D * FF + j; const float* pu = wu + (size_t)e * D * FF + j;
            for (int k = 0; k < D; ++k) { const float gk = gf[k]; g += xs[k] * bf2f(f2bf(pg[(size_t)k * FF] * gk)); u += xs[k] * bf2f(f2bf(pu[(size_t)k * FF] * gk)); }
            const float rs = rstd[t]; g *= rs; u *= rs;
            hid[(size_t)slot * FF + j] = f2bf(g / (1.0f + expf(-g)) * u);
        }
        __syncthreads();
    }
}
__device__ void n_down(LAS unsigned char* lds, const bf16* __restrict__ hid, const float* __restrict__ wd, const float* __restrict__ gw, const int* counts, const int* elist, bf16* __restrict__ yp) {
    const int half = threadIdx.x >> 8, tid = threadIdx.x & 255; LAS float* hs = (LAS float*)(lds + half * 16384);
    for (int it = 0; it * (int)gridDim.x * 2 < SLOT_CAP; ++it) {
        const int slot = (it * gridDim.x + blockIdx.x) * 2 + half; int e, pos; const bool ok = slot_lookup(counts, slot, e, pos);
        const int pair = ok ? elist[e * T + pos] : 0;
        hs[tid] = ok ? bf2f(hid[(size_t)slot * FF + tid]) : 0.f;
        __syncthreads();
        if (ok) {
            const float gwt = gw[pair];
            for (int n = tid; n < D; n += 256) {
                float a = 0.f; const float* p = wd + (size_t)e * FF * D + n;
                for (int k = 0; k < FF; ++k) a += hs[k] * bf2f(f2bf(p[(size_t)k * D]));
                yp[(size_t)pair * D + n] = f2bf(a * gwt);
            }
        }
        __syncthreads();
    }
}
__device__ void n_combine(float* h, const bf16* __restrict__ yp, bf16* __restrict__ hb, float* __restrict__ rstd) {
    const int gwv = blockIdx.x * NWAVES + (threadIdx.x >> 6), lane = threadIdx.x & 63, nw = gridDim.x * NWAVES;
    for (int r = gwv; r < T; r += nw) {
        float s = 0.f;
        for (int c = lane; c < D; c += 64) { const float v = h[(size_t)r * D + c] + bf2f(yp[(size_t)(2 * r) * D + c]) + bf2f(yp[(size_t)(2 * r + 1) * D + c]);
            h[(size_t)r * D + c] = v; s += v * v; if (hb) hb[(size_t)r * D + c] = f2bf(v); }
        for (int o = 1; o < 64; o <<= 1) s += __shfl_xor(s, o);
        if (rstd && lane == 0) rstd[r] = 1.0f / sqrtf(s * (1.0f / D) + EPS);
    }
}


__device__ __forceinline__ void cvt_experts(const float* wg, const float* wu, const float* wd, const float* gain, bf16* WGU, bf16* WDT, LAS unsigned char* lds, int wg0, int nwg) {
    const int tid = opaque_tid(), lane = tid & 63, wave = tid >> 6;
    LAS float* scr = (LAS float*)(lds + wave * 9216);
    const int gwv = ((int)blockIdx.x - wg0) * NWAVES + wave, NGW = nwg * NWAVES;
    const CvtFam g0{wg, WGU, gain, D, FF, NE, 2, 512};
    const CvtFam g1{wu, WGU, gain, D, FF, NE, 3, 512};
    const CvtFam g2{wd, WDT, nullptr, FF, D, NE, 0, 1024};
    const int n0 = cvt_fam_items(g0), n1 = n0 + cvt_fam_items(g1), n2 = n1 + cvt_fam_items(g2);
    for (int it = gwv; it < n2; it += NGW) {
        if (it < n0) cvt_fam_run(g0, it, scr, lane);
        else if (it < n1) cvt_fam_run(g1, it - n0, scr, lane);
        else cvt_fam_run(g2, it - n1, scr, lane);
    }
}

enum { A_X, A_POS, A_NMIX, A_NFFN, A_WINE, A_WOUTE, A_SGUN, A_SGUW, A_SGUB, A_QND, A_KND, A_WINO, A_WOUTO, A_QNS, A_KNS, A_SINK, A_WRG, A_BRG, A_WRE, A_BRE, A_WG, A_WU, A_WD, A_OUT, A_WS, A_N };
struct Args { const void* p[A_N]; };
constexpr int LDS_ARGS = LDS_MISC + 1024;
__device__ __forceinline__ const void* ldarg(int i) {
    volatile LAS unsigned* q = (volatile LAS unsigned*)((LAS unsigned char*)0 + LDS_ARGS) + 2 * i;
    const unsigned lo = __builtin_amdgcn_readfirstlane(q[0]), hi = __builtin_amdgcn_readfirstlane(q[1]);
    return (const void*)(((unsigned long long)hi << 32) | lo);
}
#define ARGF(i) ((const float*)ldarg(i))
#define WSP(T, off) ((T*)((unsigned char*)ldarg(A_WS) + (off)))
__device__ __forceinline__ void grid_bar() {
    XcdBarrier b; b.bar = WSP(unsigned, WS_CTL) + CW_BAR; b.x = xb_xcc_id(); b.st = (volatile LAS unsigned*)((LAS unsigned char*)0 + LDS_MISC) + 8;
    xcd_barrier(b);
}
__device__ __forceinline__ void moe_phases(LAS unsigned char* lds, int cofs) {
    volatile LAS int* tb = (volatile LAS int*)(lds + LDS_MISC + 256);
    pg8::moe_setup(tb, WSP(int, WS_CTL) + cofs);
    const int G = gridDim.x, c = vcu_id();
    const int NT = __builtin_amdgcn_readfirstlane(tb[NE]), S1 = NT < G / 2 ? NT : G / 2, R = NT - S1;
    const int nGUw = (2 * R < G / 2) ? 2 * R : G / 2;
#pragma unroll 1
    for (int step = 0; step < 3; ++step) {
        int gt0 = 0, gnt = 0, gc = 0, gn = 1, dt0 = 0, dnt = 0, dc = 0, dn = 1; bool doG = false, doD = false;
        if (step == 0) { gt0 = 0; gnt = S1; gc = c; gn = G; doG = true; }
        else if (step == 1) { if (c < nGUw) { gt0 = S1; gnt = R; gc = c; gn = nGUw; doG = true; } else { dt0 = 0; dnt = S1; dc = c - nGUw; dn = G - nGUw; doD = true; } }
        else { dt0 = S1; dnt = R; dc = c; dn = G; doD = true; }
        if (step == 2 && R == 0) break;
#pragma unroll 1
        for (int rep_ = 0; rep_ < REP_GU; ++rep_)
        if (doG) {
            pg8::MoeOrder<2, true> S{tb, WSP(int, WS_CTL) + cofs, WSP(int, WS_ELIST), D, 512, WSP(bf16, WS_WGU), gt0, gnt, gc, gn};
            pg8::EpiGU E{WSP(bf16, WS_HID), WSP(float, WS_RSTD), WSP(int, WS_CTL) + cofs, WSP(int, WS_ELIST)};
            pg8::gemm_phase<pg8::EpiGU, pg8::MoeOrder<2, true>, true>(lds, WSP(bf16, WS_HB), D, S, E);
        }
#pragma unroll 1
        for (int rep_ = 0; rep_ < REP_DN; ++rep_)
        if (doD) {
            pg8::MoeOrder<4, false> S{tb, WSP(int, WS_CTL) + cofs, WSP(int, WS_ELIST), FF, 1024, WSP(bf16, WS_WD), dt0, dnt, dc, dn};
            pg8::EpiDown E{WSP(bf16, WS_YP), WSP(float, WS_GW), WSP(int, WS_CTL) + cofs, WSP(int, WS_ELIST)};
            pg8::gemm_phase<pg8::EpiDown, pg8::MoeOrder<4, false>, true>(lds, WSP(bf16, WS_HID), FF, S, E);
        }
        if (step < 2 && !(step == 1 && R == 0)) grid_bar();
    }
}
__global__ void __launch_bounds__(NTHR, 2) mega_fwd(Args a) {
    extern __shared__ __attribute__((aligned(16))) unsigned char lds_raw[];
    LAS unsigned char* lds = (LAS unsigned char*)lds_raw;
    {
        volatile LAS unsigned* MISC = (volatile LAS unsigned*)(lds + LDS_MISC);
        if (threadIdx.x < 64) MISC[threadIdx.x] = 0u;
        if (threadIdx.x < 2 * A_N) ((volatile LAS unsigned*)(lds + LDS_ARGS))[threadIdx.x] = ((const unsigned*)&a)[threadIdx.x];
        __syncthreads();
        (void)xcd_barrier_post(WSP(unsigned, WS_CTL) + CW_BAR, MISC + 8);
    }
    constexpr size_t SN_OFF = WS_CS + (size_t)T * 8 * 4;
    constexpr size_t EW1 = (size_t)NE * D * FF;
#pragma unroll 1
    for (int rep_ = 0; rep_ < REP_P0; ++rep_) {
    {
        const int tid = opaque_tid(), lane = tid & 63, wave = tid >> 6;
        LAS float* scr = (LAS float*)(lds + wave * 9216);
        const int gwv = blockIdx.x * NWAVES + wave, NGW = gridDim.x * NWAVES;
        const CvtFam f0{ARGF(A_WINE), WSP(bf16, WS_WIN0), ARGF(A_NMIX), D, IN0, 1, 1, 0};
        const CvtFam f1{ARGF(A_WOUTE), WSP(bf16, WS_WOUT0), nullptr, OUT0K, D, 1, 0, 0};
        const CvtFam f2{ARGF(A_WINO), WSP(bf16, WS_WIN1), ARGF(A_NMIX) + D, D, IN1, 1, 1, 0};
        const CvtFam f3{ARGF(A_WOUTO), WSP(bf16, WS_WOUT1), nullptr, D, D, 1, 0, 0};
        const int n0 = cvt_fam_items(f0), n1 = n0 + cvt_fam_items(f1), n2 = n1 + cvt_fam_items(f2), n3 = n2 + cvt_fam_items(f3);
        for (int it = gwv; it < n3; it += NGW) {
            if (it < n0) cvt_fam_run(f0, it, scr, lane);
            else if (it < n1) cvt_fam_run(f1, it - n0, scr, lane);
            else if (it < n2) cvt_fam_run(f2, it - n1, scr, lane);
            else cvt_fam_run(f3, it - n2, scr, lane);
        }
    }
    build_router_tab(ARGF(A_NFFN), ARGF(A_WRG), ARGF(A_WRE), WSP(bf16, WS_RTAB));
    build_router_tab(ARGF(A_NFFN) + D, ARGF(A_WRG) + D * 4, ARGF(A_WRE) + (size_t)4 * D * 8, WSP(bf16, WS_RTAB) + 2 * 64 * D);
    n_rope_tab((const int*)ldarg(A_POS), WSP(float, WS_CS), WSP(float, SN_OFF));
    f_rowprep(ARGF(A_X), WSP(bf16, WS_HB), WSP(float, WS_RSTD));
    }
    grid_bar();
#pragma unroll 1
    for (int rep_ = 0; rep_ < REP_P1; ++rep_) {
    {
        pg8::DenseOrder S; S.init(T, IN0, D, WSP(bf16, WS_WIN0), gridDim.x, blockIdx.x);
        pg8::EpiIn<0> E{WSP(bf16, WS_Y), WSP(float, WS_RSTD), WSP(float, WS_VSS), WSP(float, WS_CS), WSP(float, SN_OFF), ARGF(A_QND), ARGF(A_KND)};
        pg8::gemm_phase<pg8::EpiIn<0>, pg8::DenseOrder, true>(lds, WSP(bf16, WS_HB), D, S, E);
    }
    if (rep_ == 0) { const int G_ = gridDim.x, w0 = (G_ == 256) ? 64 : 0; if ((int)blockIdx.x >= w0) cvt_experts(ARGF(A_WG), ARGF(A_WU), ARGF(A_WD), ARGF(A_NFFN), WSP(bf16, WS_WGU), WSP(bf16, WS_WD), lds, w0, G_ - w0); }
    }
    grid_bar();
#pragma unroll 1
    for (int rep_ = 0; rep_ < REP_P2; ++rep_) {
    f_mixers0(lds, WSP(bf16, WS_Y), WSP(float, WS_VSS), ARGF(A_SGUN), ARGF(A_SGUW), ARGF(A_SGUB), WSP(bf16, WS_A2));
    }
    grid_bar();
#pragma unroll 1
    for (int rep_ = 0; rep_ < REP_P3; ++rep_) {
    {
        pg8::DenseOrder S; S.init(T, D, OUT0K, WSP(bf16, WS_WOUT0), gridDim.x, blockIdx.x);
        pg8::EpiRes<false> E{ARGF(A_X), WSP(bf16, WS_HB)};
        pg8::gemm_phase<pg8::EpiRes<false>, pg8::DenseOrder, true>(lds, WSP(bf16, WS_A2), OUT0K, S, E);
    }
    }
    grid_bar();
    if (PROBE_ROUTER) f_router(lds, WSP(bf16, WS_HB), WSP(bf16, WS_RTAB), ARGF(A_BRG), ARGF(A_BRE), WSP(float, WS_RSTD), WSP(int, WS_EID), WSP(float, WS_GW), WSP(int, WS_CTL) + 256, WSP(int, WS_ELIST));
    f_router(lds, WSP(bf16, WS_HB), WSP(bf16, WS_RTAB), ARGF(A_BRG), ARGF(A_BRE), WSP(float, WS_RSTD), WSP(int, WS_EID), WSP(float, WS_GW), WSP(int, WS_CTL), WSP(int, WS_ELIST));
    grid_bar();
    moe_phases(lds, 0);
    grid_bar();
    f_combine(WSP(bf16, WS_HB), WSP(bf16, WS_YP), WSP(float, WS_RSTD), nullptr);
    for (int xb_ = 0; xb_ < PROBE_BARS; ++xb_) grid_bar();
    grid_bar();
#pragma unroll 1
    for (int rep_ = 0; rep_ < REP_P5; ++rep_) {
    {
        pg8::DenseOrder S; S.init(T, IN1, D, WSP(bf16, WS_WIN1), gridDim.x, blockIdx.x);
        pg8::EpiIn<1> E{WSP(bf16, WS_Y1), WSP(float, WS_RSTD), nullptr, WSP(float, WS_CS), WSP(float, SN_OFF), ARGF(A_QNS), ARGF(A_KNS)};
        pg8::gemm_phase<pg8::EpiIn<1>, pg8::DenseOrder, true>(lds, WSP(bf16, WS_HB), D, S, E);
    }
    if (rep_ == 0) { const int G_ = gridDim.x, w0 = (G_ == 256) ? 64 : 0; if ((int)blockIdx.x >= w0) cvt_experts(ARGF(A_WG) + EW1, ARGF(A_WU) + EW1, ARGF(A_WD) + EW1, ARGF(A_NFFN) + D, WSP(bf16, WS_WGU), WSP(bf16, WS_WD), lds, w0, G_ - w0); }
    }
    grid_bar();
#pragma unroll 1
    for (int rep_ = 0; rep_ < REP_P6; ++rep_) {
    f_swa(lds, WSP(bf16, WS_Y1), ARGF(A_SINK), WSP(bf16, WS_A2));
    }
    grid_bar();
    {
        pg8::DenseOrder S; S.init(T, D, D, WSP(bf16, WS_WOUT1), gridDim.x, blockIdx.x);
        pg8::EpiRes<true> E{nullptr, WSP(bf16, WS_HB)};
        pg8::gemm_phase<pg8::EpiRes<true>, pg8::DenseOrder, true>(lds, WSP(bf16, WS_A2), D, S, E);
    }
    grid_bar();
    f_router(lds, WSP(bf16, WS_HB), WSP(bf16, WS_RTAB) + 2 * 64 * D, ARGF(A_BRG) + 4, ARGF(A_BRE) + 32, WSP(float, WS_RSTD), WSP(int, WS_EID), WSP(float, WS_GW), WSP(int, WS_CTL) + 64, WSP(int, WS_ELIST));
    grid_bar();
    moe_phases(lds, 64);
    grid_bar();
    f_combine(WSP(bf16, WS_HB), WSP(bf16, WS_YP), nullptr, (float*)ldarg(A_OUT));
}

extern "C" void kernel_launch(void* const* d_in, const int* in_sizes, int n_in, void* d_out, int out_size, void* d_ws, size_t ws_size, hipStream_t stream) {
    static int grid = 0;
    if (grid == 0) {
        int dev = 0, cus = 0, per_cu = 0;
        if (hipGetDevice(&dev) != hipSuccess || hipDeviceGetAttribute(&cus, hipDeviceAttributeMultiprocessorCount, dev) != hipSuccess) { fprintf(stderr, "kernel_launch: device query failed\n"); grid = -1; return; }
        if (hipFuncSetAttribute((const void*)mega_fwd, hipFuncAttributeMaxDynamicSharedMemorySize, LDS_BYTES) != hipSuccess) { fprintf(stderr, "kernel_launch: hipFuncSetAttribute failed\n"); grid = -1; return; }
        if (hipOccupancyMaxActiveBlocksPerMultiprocessor(&per_cu, (const void*)mega_fwd, NTHR, LDS_BYTES) != hipSuccess || per_cu < 1) { fprintf(stderr, "kernel_launch: occupancy query says %d blocks/CU\n", per_cu); grid = -1; (void)hipGetLastError(); return; }
        grid = cus;
    }
    if (grid < 0) return;
    if (hipMemsetAsync((char*)d_ws + WS_CTL, 0, MiB, stream) != hipSuccess) return;
    Args a{};
    for (int i = 0; i < 23; ++i) a.p[i] = d_in[i];
    a.p[A_OUT] = d_out; a.p[A_WS] = d_ws;
    hipLaunchKernelGGL(mega_fwd, dim3(grid), dim3(NTHR), LDS_BYTES, stream, a);
}
```

```cpp
#include <hip/hip_runtime.h>
#include <stdint.h>
#include <math.h>
#include <cstdio>

typedef unsigned short bf16;
__device__ __forceinline__ float bf2f(bf16 v) { return __uint_as_float((unsigned)v << 16); }
__device__ __forceinline__ bf16 f2bf(float f) { unsigned u = __float_as_uint(f); return (bf16)((u + 0x7fffu + ((u >> 16) & 1u)) >> 16); }

constexpr int T = 16384, SEQ = 8192, D = 1024;
constexpr int IN0 = 3328, OUT0K = 768, IN1 = 1280;
constexpr int NE = 32, FF = 256;
constexpr float EPS = 1e-6f;
constexpr float QSCALE = 0.125f * 1.4426950408889634f;
constexpr int SLOT_CAP = 40960;

constexpr size_t MiB = 1u << 20;
constexpr size_t WS_CTL = 0;
constexpr size_t WS_RSTD = 1 * MiB;
constexpr size_t WS_VSS = WS_RSTD + 65536;
constexpr size_t WS_CS = 2 * MiB;
constexpr size_t WS_EID = 3 * MiB;
constexpr size_t WS_GW = WS_EID + 131072;
constexpr size_t WS_ELIST = 4 * MiB;
constexpr size_t WS_RTAB = 6 * MiB;
constexpr size_t WS_WIN0 = 8 * MiB;
constexpr size_t WS_WOUT0 = 15 * MiB;
constexpr size_t WS_WIN1 = 17 * MiB;
constexpr size_t WS_WOUT1 = 20 * MiB;
constexpr size_t WS_WGU = 22 * MiB;
constexpr size_t WS_WD = 54 * MiB;
constexpr size_t WS_HB = 70 * MiB;
constexpr size_t WS_Y = 102 * MiB;
constexpr size_t WS_YP = 102 * MiB;
constexpr size_t WS_HID = 166 * MiB;
constexpr size_t WS_Y1 = 166 * MiB;
constexpr size_t WS_A2 = 206 * MiB;


#define NPASS 1
#define STOP_AT 12
#define LAS __attribute__((address_space(3)))
constexpr int LDS_WID = 147456 - 2048 + 1536;
__device__ __forceinline__ int hw_wave_slot() { return (int)(__builtin_amdgcn_s_getreg((5 << 11) | 4) & 63u); }
__device__ __forceinline__ int opaque_tid() {
    const int wv = __builtin_amdgcn_readfirstlane(((volatile LAS int*)((LAS unsigned char*)0 + LDS_WID))[hw_wave_slot()]);
    unsigned z = 0u; asm volatile("" : "+v"(z));
    int t = wv * 64 + (int)__builtin_amdgcn_mbcnt_hi(~0u, __builtin_amdgcn_mbcnt_lo(~0u, z));
    asm volatile("" : "+v"(t)); return t;
}
constexpr int NTHR = 512, NWAVES = 8;
constexpr int LDS_BYTES = 147456;
constexpr int LDS_MISC = 145408;
constexpr int CW_BAR = 4096;

#define XB_TMO      128
#define XB_XCNT(j)  (256  + 64 * (j))
#define XB_XSUB(j)  (1280 + 64 * (j))
#define XB_XGEN(j)  (2304 + 64 * (j))
#define XB_TOP      3328
#define XB_TOPGEN   3392
#define XCD_BAR_WORDS 3456
#define XB_SPIN_CAP (1u << 20)
__device__ __forceinline__ unsigned xb_ld(unsigned* p)              { return __hip_atomic_load(p, __ATOMIC_RELAXED, __HIP_MEMORY_SCOPE_AGENT); }
__device__ __forceinline__ unsigned xb_add(unsigned* p, unsigned v) { return __hip_atomic_fetch_add(p, v, __ATOMIC_RELAXED, __HIP_MEMORY_SCOPE_AGENT); }
__device__ __forceinline__ unsigned xb_xcc_id() { return (unsigned)__builtin_amdgcn_s_getreg((3 << 11) | 20) & 0xFu; }
#define XB_SPIN(cond, bar) do { unsigned _sp = 0; while (cond) { __builtin_amdgcn_s_sleep(1); \
    if ((++_sp & 255u) == 0u) { if (xb_ld(&(bar)[XB_TMO])) break; if (_sp > XB_SPIN_CAP) { atomicAdd(&(bar)[XB_TMO], 1u); break; } } } } while (0)
struct XcdBarrier { unsigned* bar; unsigned x; volatile LAS unsigned* st; };
__device__ __forceinline__ XcdBarrier xcd_barrier_post(unsigned* bar, volatile LAS unsigned* st) {
    XcdBarrier b; b.bar = bar; b.x = xb_xcc_id(); b.st = st;
    if (threadIdx.x == 0) (void)xb_add(&bar[XB_XCNT(b.x)], 1u);
    return b;
}
__device__ __forceinline__ void xcd_barrier_complete(unsigned* bar, unsigned x, unsigned& nloc, unsigned& nx) {
    const unsigned G = gridDim.x * gridDim.y * gridDim.z;
    unsigned sum, cnt, mine, sp = 0u;
    for (;;) {
        sum = 0u; cnt = 0u; mine = 0u;
#pragma unroll
        for (unsigned j = 0; j < 16; ++j) { const unsigned c = xb_ld(&bar[XB_XCNT(j)]); sum += c; cnt += (c > 0u) ? 1u : 0u; mine = (j == x) ? c : mine; }
        if (sum == G) break;
        __builtin_amdgcn_s_sleep(1);
        if ((++sp & 255u) == 0u) { if (xb_ld(&bar[XB_TMO])) break; if (sp > XB_SPIN_CAP) { atomicAdd(&bar[XB_TMO], 1u); break; } }
    }
    nloc = mine > 0u ? mine : 1u; nx = cnt > 0u ? cnt : 1u;
}
__device__ __forceinline__ void xcd_barrier(const XcdBarrier& b) {
    asm volatile("s_waitcnt vmcnt(0)" ::: "memory");
    __syncthreads();
    if (opaque_tid() == 0) {
        unsigned* bar = b.bar;
        __builtin_amdgcn_s_waitcnt(0);
        unsigned nloc = b.st[0], nx = b.st[1];
        if (nloc == 0u) { xcd_barrier_complete(bar, b.x, nloc, nx); b.st[0] = nloc; b.st[1] = nx; }
        const unsigned old = xb_add(&bar[XB_XSUB(b.x)], 1u);
        const unsigned gen = old / nloc;
        if (old + 1u == (gen + 1u) * nloc) {
            __builtin_amdgcn_fence(__ATOMIC_RELEASE, "agent");
            asm volatile("s_waitcnt vmcnt(0)" ::: "memory");
            const unsigned og = xb_add(&bar[XB_TOP], 1u);
            const unsigned tg = og / nx;
            if (og + 1u == (tg + 1u) * nx) xb_add(&bar[XB_TOPGEN], 1u);
            else XB_SPIN(xb_ld(&bar[XB_TOPGEN]) == tg, bar);
            __builtin_amdgcn_fence(__ATOMIC_ACQUIRE, "agent");
            xb_add(&bar[XB_XGEN(b.x)], 1u);
            asm volatile("s_waitcnt vmcnt(0)" ::: "memory");
        } else {
            XB_SPIN(xb_ld(&bar[XB_XGEN(b.x)]) == gen, bar);
            __builtin_amdgcn_fence(__ATOMIC_ACQUIRE, "agent");
            asm volatile("s_waitcnt vmcnt(0)" ::: "memory");
        }
    }
    __syncthreads();
}


__device__ __forceinline__ int vcu_id() { const int G = gridDim.x, bx = blockIdx.x; return (G % 8 == 0) ? (bx % 8) * (G / 8) + bx / 8 : bx; }
typedef short bf16x8 __attribute__((ext_vector_type(8)));
typedef float f32x4 __attribute__((ext_vector_type(4)));
typedef float f32x2 __attribute__((ext_vector_type(2)));
typedef unsigned u32x4 __attribute__((ext_vector_type(4)));
typedef unsigned u32x2 __attribute__((ext_vector_type(2)));
typedef __bf16 bf16x2_t __attribute__((ext_vector_type(2)));
__device__ __forceinline__ unsigned pk2(float lo, float hi) { f32x2 v = {lo, hi}; bf16x2_t b = __builtin_convertvector(v, bf16x2_t); return __builtin_bit_cast(unsigned, b); }
__device__ __forceinline__ float gelu_fast(float x) { const float u = x * (0.7978845608028654f + 0.0356774081363001f * x * x);
    return x * __builtin_amdgcn_rcpf(1.0f + __builtin_amdgcn_exp2f(-2.885390081777927f * u)); }

__device__ __forceinline__ void cvt_item(const float* __restrict__ W, int N, int k0, int n0, const float* __restrict__ gain, bf16* __restrict__ WT, int K, int drow0, LAS float* scr, int lane) {
#pragma unroll
    for (int i = 0; i < 8; ++i) {
        const int kk = i * 8 + (lane >> 3);
        f32x4 v = *(const f32x4*)(W + (size_t)(k0 + kk) * N + n0 + 4 * (lane & 7));
        if (gain) v = v * gain[k0 + kk];
        *(LAS f32x4*)(scr + kk * 36 + 4 * (lane & 7)) = v;
    }
    const int n = lane & 31;
#pragma unroll
    for (int cc = 0; cc < 4; ++cc) {
        const int c = (lane >> 5) * 4 + cc; const LAS float* q = scr + (8 * c) * 36 + n;
        u32x4 o; o.x = pk2(q[0], q[36]); o.y = pk2(q[72], q[108]); o.z = pk2(q[144], q[180]); o.w = pk2(q[216], q[252]);
        *(u32x4*)(WT + (size_t)(drow0 + n) * K + k0 + 8 * c) = o;
    }
}
__device__ __forceinline__ int inproj_pos(int n0) { return (n0 & ~255) | (((n0 >> 5) & 1) << 7) | (((n0 >> 6) & 3) << 5); }
__device__ __forceinline__ void cvt_matrix_items(const float* W, int K, int N, const float* gain, bf16* WT, int mode, int item, LAS float* scr, int lane) {
    const int nblk = N / 32, kb = item / nblk, nb = item % nblk, n0 = nb * 32;
    int d0 = n0;
    if (mode == 1) d0 = inproj_pos(n0);
    else if (mode == 2) d0 = 256 * (n0 >> 7) + (n0 & 127);
    else if (mode == 3) d0 = 256 * (n0 >> 7) + 128 + (n0 & 127);
    cvt_item(W, N, kb * 64, n0, gain, WT, K, d0, scr, lane);
}
struct CvtFam { const float* src; bf16* dst; const float* gain; int K, N, nmat, mode; int dstride_rows; };
__device__ __forceinline__ int cvt_fam_items(const CvtFam& f) { return f.nmat * (f.K / 64) * (f.N / 32); }
__device__ __forceinline__ void cvt_fam_run(const CvtFam& f, int item, LAS float* scr, int lane) {
    const int per = (f.K / 64) * (f.N / 32), e = item / per, it = item % per;
    cvt_matrix_items(f.src + (size_t)e * f.K * f.N, f.K, f.N, f.gain, f.dst + (size_t)e * f.dstride_rows * f.K, f.mode, it, scr, lane);
}

struct CvtItem { const float* W; const float* gain; bf16* WT; int N, K; };
__device__ __forceinline__ CvtItem cvt_resolve(const CvtFam& f, int item) {
    const int per = (f.K / 64) * (f.N / 32), e = item / per, it = item % per, nblk = f.N / 32, kb = it / nblk, n0 = (it % nblk) * 32;
    int d0 = n0;
    if (f.mode == 1) d0 = inproj_pos(n0);
    else if (f.mode == 2) d0 = 256 * (n0 >> 7) + (n0 & 127);
    else if (f.mode == 3) d0 = 256 * (n0 >> 7) + 128 + (n0 & 127);
    CvtItem c; c.W = f.src + (size_t)e * f.K * f.N + (size_t)(kb * 64) * f.N + n0; c.gain = f.gain ? f.gain + kb * 64 : nullptr;
    c.WT = f.dst + ((size_t)e * f.dstride_rows + d0) * f.K + kb * 64; c.N = f.N; c.K = f.K; return c;
}
__device__ __forceinline__ void cvt_load(const CvtItem& c, f32x4 (&r)[8], float (&g)[8], int lane) {
#pragma unroll
    for (int i = 0; i < 8; ++i) { const int kk = i * 8 + (lane >> 3); r[i] = *(const f32x4*)(c.W + (size_t)kk * c.N + 4 * (lane & 7)); g[i] = c.gain ? c.gain[kk] : 1.0f; }
}
__device__ __forceinline__ void cvt_store(const CvtItem& c, const f32x4 (&r)[8], const float (&g)[8], LAS float* scr, int lane) {
#pragma unroll
    for (int i = 0; i < 8; ++i) { const int kk = i * 8 + (lane >> 3); *(LAS f32x4*)(scr + kk * 36 + 4 * (lane & 7)) = r[i] * g[i]; }
    const int n = lane & 31;
#pragma unroll
    for (int cc = 0; cc < 4; ++cc) {
        const int ch = (lane >> 5) * 4 + cc; const LAS float* q = scr + (8 * ch) * 36 + n;
        u32x4 o; o.x = pk2(q[0], q[36]); o.y = pk2(q[72], q[108]); o.z = pk2(q[144], q[180]); o.w = pk2(q[216], q[252]);
        *(u32x4*)(c.WT + (size_t)n * c.K + 8 * ch) = o;
    }
}
__device__ __forceinline__ void cvt_run(const CvtFam& f0, const CvtFam& f1, const CvtFam& f2, const CvtFam& f3, int b0, int b1, int b2, int n, int gwv, int NGW, LAS float* scr, int lane) {
#pragma unroll 1
    for (int it = gwv; it < n; it += 3 * NGW) {
        CvtItem c[3]; f32x4 r[3][8]; float g[3][8]; bool ok[3];
#pragma unroll
        for (int j = 0; j < 3; ++j) { const int x = it + j * NGW; ok[j] = x < n;
            if (ok[j]) { c[j] = (x < b0) ? cvt_resolve(f0, x) : (x < b1) ? cvt_resolve(f1, x - b0) : (x < b2) ? cvt_resolve(f2, x - b1) : cvt_resolve(f3, x - b2); cvt_load(c[j], r[j], g[j], lane); } }
#pragma unroll
        for (int j = 0; j < 3; ++j) if (ok[j]) cvt_store(c[j], r[j], g[j], scr, lane);
    }
}

__device__ __forceinline__ float wave_sum(float v) {
#pragma unroll
    for (int o = 1; o < 64; o <<= 1) v += __shfl_xor(v, o);
    return v;
}
__device__ __forceinline__ void f_rowprep(const float* __restrict__ src, bf16* __restrict__ hb, float* __restrict__ rstd) {
    const int tid = opaque_tid(); const int gw = blockIdx.x * NWAVES + (tid >> 6), lane = tid & 63, nw = gridDim.x * NWAVES;
    for (int r = gw; r < T; r += nw) {
        const f32x4* xr = (const f32x4*)(src + (size_t)r * D) + lane; f32x4 v[4]; float s = 0.f;
#pragma unroll
        for (int j = 0; j < 4; ++j) { v[j] = xr[64 * j]; s += (v[j].x * v[j].x + v[j].y * v[j].y) + (v[j].z * v[j].z + v[j].w * v[j].w); }
        s = wave_sum(s);
        u32x2* o = (u32x2*)(hb + (size_t)r * D) + lane;
#pragma unroll
        for (int j = 0; j < 4; ++j) { u32x2 w; w.x = pk2(v[j].x, v[j].y); w.y = pk2(v[j].z, v[j].w); o[64 * j] = w; }
        if (lane == 0) rstd[r] = 1.0f / sqrtf(s * (1.0f / D) + EPS);
    }
}

namespace pg8 {
constexpr int BM = 256, BK = 64, HALF = 128, HTB = HALF * BK * 2, STAGE_BYTES = 8 * HTB, NXCD = 8, WGM = 8;
__device__ __forceinline__ int lds_byte(int r, int c) { const int st = (r >> 4) * 2 + (c >> 5), rr = r & 15, cc = c & 31, ob = rr * 64 + cc * 2; return st * 1024 + (ob ^ (((ob >> 9) & 1) << 5)); }
__device__ __forceinline__ void stage_rc(int b, int& R, int& C) { const int st = b / 1024, sb = b % 1024, swz = sb ^ (((sb >> 9) & 1) << 5); R = (st >> 1) * 16 + swz / 64; C = (st & 1) * 32 + (swz % 64) / 2; }
__device__ __forceinline__ int perm32(int rho) { const int n = rho >> 4, i = rho & 15; return 8 * (i >> 2) + 4 * n + (i & 3); }
struct Unit { int pm, pn, e, aux; };
struct DenseOrder {
    int nM, nN, nwg, G, c, K; const bf16* Bt;
    __device__ void init(int M, int N, int K_, const bf16* Bt_, int G_, int c_) { nM = M / BM; nN = N / BM; nwg = nM * nN; G = G_; c = c_; K = K_; Bt = Bt_; }
    __device__ __forceinline__ bool next(int i, Unit& u) const {
        const long L = (long)i * G + c; if (L >= nwg) return false;
        int wgid = (int)L; { const int q = nwg / NXCD, r = nwg % NXCD, xcd = wgid % NXCD, off = wgid / NXCD; wgid = (xcd < r ? xcd * (q + 1) : r * (q + 1) + (xcd - r) * q) + off; }
        const int nig = WGM * nN, gid = wgid / nig, fm = gid * WGM, gsz = (nM - fm) < WGM ? (nM - fm) : WGM;
        u.pm = fm + ((wgid % nig) % gsz); u.pn = (wgid % nig) / gsz; u.e = 0; u.aux = 0; return true;
    }
    __device__ __forceinline__ unsigned a_rowoff(const Unit& u, int r) const { return (unsigned)(u.pm * BM + r) * (unsigned)(K * 2); }
    __device__ __forceinline__ const char* b_base(const Unit& u) const { return (const char*)Bt + (size_t)u.pn * BM * K * 2; }
};

template <class Epi, class Sched, bool ALIGN_EPI>
__device__ __forceinline__ void gemm_phase(LAS unsigned char* lds, const bf16* Abase, const int K, const Sched& S, const Epi& E) {
    const int tid = opaque_tid(), wid = __builtin_amdgcn_readfirstlane(tid >> 6), lane = tid & 63, wr = wid >> 2, wc = wid & 3, fr = lane & 15, fq = lane >> 4;
    const int nt = K / BK;
    unsigned voffB[2];
#pragma unroll
    for (int i = 0; i < 2; ++i) { int R, C; stage_rc(tid * 16 + i * 8192, R, C); const int Rb = Epi::PERM ? ((R & ~31) + perm32(R & 31)) : R;
        voffB[i] = (unsigned)(Rb * K + C) * 2u; }
    const size_t kstep = (size_t)(BK * 2);
    const size_t hstep = (size_t)HALF * K * 2;
    const unsigned ldsw = (unsigned)wid * 1024u;
    const int aoff = lds_byte(wr * 64 + fr, fq * 8), boff = lds_byte(wc * 32 + fr, fq * 8);
#define PG8_SA(b, h) (((b) * 2 + (h)) * HTB)
#define PG8_SB(b, h) ((4 + (b) * 2 + (h)) * HTB)
#define PG8_STAGE_B(bufoff, gbase) do { _Pragma("unroll") for (int _i = 0; _i < 2; ++_i) \
        __builtin_amdgcn_global_load_lds((const unsigned*)((const char*)(gbase) + voffB[_i]), (LAS unsigned*)(lds + (bufoff) + ldsw + _i * 8192), 16, 0, 0); } while (0)
#define PG8_STAGE_A(bufoff, offs, kb) do { _Pragma("unroll") for (int _i = 0; _i < 2; ++_i) \
        __builtin_amdgcn_global_load_lds((const unsigned*)((const char*)Abase + (size_t)(offs)[_i] + (size_t)(kb)), (LAS unsigned*)(lds + (bufoff) + ldsw + _i * 8192), 16, 0, 0); } while (0)
#define PG8_LDA(dst, b, h) do { _Pragma("unroll") for (int m = 0; m < 4; ++m) _Pragma("unroll") for (int k = 0; k < 2; ++k) dst[m][k] = *(const LAS bf16x8*)(lds + PG8_SA(b, h) + aoff + m * 2048 + k * 1024); } while (0)
#define PG8_LDB(dst, b, h) do { _Pragma("unroll") for (int n = 0; n < 2; ++n) _Pragma("unroll") for (int k = 0; k < 2; ++k) dst[n][k] = *(const LAS bf16x8*)(lds + PG8_SB(b, h) + boff + n * 2048 + k * 1024); } while (0)
#define PG8_MMA(ai, bj, At, Bt) do { __builtin_amdgcn_s_setprio(1); _Pragma("unroll") for (int m = 0; m < 4; ++m) _Pragma("unroll") for (int n = 0; n < 2; ++n) _Pragma("unroll") for (int k = 0; k < 2; ++k) \
        acc[ai][bj][m][n] = __builtin_amdgcn_mfma_f32_16x16x32_bf16(Bt[n][k], At[m][k], acc[ai][bj][m][n], 0, 0, 0); __builtin_amdgcn_s_setprio(0); } while (0)
#define PG8_WAIT_V(n) asm volatile("s_waitcnt vmcnt(" #n ")" ::: "memory")
#define PG8_WAIT_L(n) asm volatile("s_waitcnt lgkmcnt(" #n ")" ::: "memory")
#define PG8_BAR __builtin_amdgcn_s_barrier()
#define PG8_SCHED __builtin_amdgcn_sched_barrier(0)
#define PG8_AOFF(dst, u) do { int _t = tid; asm volatile("" : "+v"(_t)); _Pragma("unroll") for (int _i = 0; _i < 2; ++_i) { int _R, _C; stage_rc(_t * 16 + _i * 8192, _R, _C); \
        _Pragma("unroll") for (int _h = 0; _h < 2; ++_h) dst[_h][_i] = S.a_rowoff(u, _h * HALF + _R) + (unsigned)(_C * 2); } } while (0)
    Unit cur, nxt; int ui = 0;
    if (!S.next(0, cur)) return;
    f32x4 acc[2][2][4][2];
#pragma unroll
    for (int a = 0; a < 2; ++a)
#pragma unroll
        for (int b = 0; b < 2; ++b)
#pragma unroll
            for (int m = 0; m < 4; ++m)
#pragma unroll
                for (int n = 0; n < 2; ++n) acc[a][b][m][n] = (f32x4){0.f, 0.f, 0.f, 0.f};
    bf16x8 At[4][2], B0[2][2], B1[2][2];
    unsigned cA[2][2];
    PG8_AOFF(cA, cur);
    const char* cB = S.b_base(cur);
    PG8_STAGE_B(PG8_SB(0, 0), cB); PG8_STAGE_B(PG8_SB(0, 1), cB + hstep); PG8_STAGE_A(PG8_SA(0, 0), cA[0], 0); PG8_STAGE_A(PG8_SA(0, 1), cA[1], 0);
    if (wr == 1) PG8_BAR;
    PG8_WAIT_V(2); PG8_BAR;
    PG8_STAGE_B(PG8_SB(1, 0), cB + kstep); PG8_STAGE_A(PG8_SA(1, 0), cA[0], kstep); PG8_STAGE_B(PG8_SB(1, 1), cB + hstep + kstep);
    PG8_WAIT_V(6); PG8_BAR;
    for (;;) {
        const bool has_next = S.next(ui + 1, nxt);
        const char* nB = has_next ? S.b_base(nxt) : cB;
#pragma unroll 1
        for (int t = 0; t < nt; t += 2) {
            const bool last = (t == nt - 2);
            const size_t k1 = (size_t)(t + 1) * kstep;
            const size_t k2 = last ? (size_t)0 : (size_t)(t + 2) * kstep, k3 = k2 + kstep;
            const char* b2 = last ? nB : cB + (size_t)(t + 2) * kstep; const char* b3 = b2 + kstep;
            PG8_LDB(B0, 0, 0); PG8_LDB(B1, 0, 1); PG8_SCHED; PG8_LDA(At, 0, 0); PG8_STAGE_A(PG8_SA(1, 1), cA[1], k1);
            if (last && has_next) { PG8_AOFF(cA, nxt); }
            PG8_WAIT_V(8); PG8_WAIT_L(0); PG8_BAR; PG8_MMA(0, 0, At, B0); PG8_MMA(0, 1, At, B1); PG8_BAR; PG8_SCHED;
            PG8_LDA(At, 0, 1); PG8_STAGE_B(PG8_SB(0, 0), b2); PG8_STAGE_B(PG8_SB(0, 1), b2 + hstep); PG8_STAGE_A(PG8_SA(0, 0), cA[0], k2);
            PG8_WAIT_V(8); PG8_WAIT_L(0); PG8_BAR; PG8_MMA(1, 0, At, B0); PG8_MMA(1, 1, At, B1); PG8_BAR; PG8_SCHED;
            PG8_LDB(B0, 1, 0); PG8_LDB(B1, 1, 1); PG8_SCHED; PG8_LDA(At, 1, 0); PG8_STAGE_A(PG8_SA(0, 1), cA[1], k2);
            PG8_WAIT_V(8); PG8_WAIT_L(0); PG8_BAR; PG8_MMA(0, 0, At, B0); PG8_MMA(0, 1, At, B1); PG8_BAR; PG8_SCHED;
            PG8_LDA(At, 1, 1); PG8_STAGE_B(PG8_SB(1, 0), b3); PG8_STAGE_B(PG8_SB(1, 1), b3 + hstep); PG8_STAGE_A(PG8_SA(1, 0), cA[0], k3);
            PG8_WAIT_V(8); PG8_WAIT_L(0); PG8_BAR; PG8_MMA(1, 0, At, B0); PG8_MMA(1, 1, At, B1); PG8_BAR; PG8_SCHED;
        }
        if constexpr (ALIGN_EPI) { if (wr == 0) PG8_BAR; }
        E(acc, cur, wr, wc, fr, fq);
        if (!has_next) break;
#pragma unroll
        for (int a = 0; a < 2; ++a)
#pragma unroll
            for (int b = 0; b < 2; ++b)
#pragma unroll
                for (int m = 0; m < 4; ++m)
#pragma unroll
                    for (int n = 0; n < 2; ++n) acc[a][b][m][n] = (f32x4){0.f, 0.f, 0.f, 0.f};
        cur = nxt; cB = nB; ++ui;
        if constexpr (ALIGN_EPI) { if (wr == 1) PG8_BAR; }
    }
    PG8_WAIT_V(0);
    if constexpr (!ALIGN_EPI) { if (wr == 0) PG8_BAR; }
    PG8_BAR;
#undef PG8_SA
#undef PG8_SB
#undef PG8_STAGE_A
#undef PG8_STAGE_B
#undef PG8_LDA
#undef PG8_LDB
#undef PG8_MMA
#undef PG8_WAIT_V
#undef PG8_WAIT_L
#undef PG8_BAR
#undef PG8_SCHED
#undef PG8_AOFF
}

template <int LAYER> struct EpiIn {
    static constexpr bool PERM = true;
    bf16* Y; const float* rstd; float* vss; const float* cs; const float* sn; const float* qn; const float* kn;
    __device__ __forceinline__ void operator()(const f32x4 (&acc)[2][2][4][2], const Unit& u, int wr, int wc, int fr, int fq) const {
        constexpr int LD = LAYER == 0 ? IN0 : IN1;
        int type; bool isq;
        if (LAYER == 0) { type = u.pn < 2 ? 0 : (u.pn < 4 ? 1 : (u.pn < 10 ? 2 : 3)); isq = u.pn < 7; }
        else { type = (u.pn < 4 || wc < 2) ? 2 : 3; isq = u.pn < 4; }
        f32x4 g[2][2];
        if (type == 2) { const float* gn = isq ? qn : kn;
#pragma unroll
            for (int bj = 0; bj < 2; ++bj)
#pragma unroll
                for (int n = 0; n < 2; ++n) { g[bj][n] = *(const f32x4*)(gn + 32 * bj + 8 * fq + 4 * n); if (isq) g[bj][n] = g[bj][n] * QSCALE; } }
        const int colb = u.pn * BM + 64 * wc + 8 * fq;
#pragma unroll
        for (int ai = 0; ai < 2; ++ai)
#pragma unroll
            for (int m = 0; m < 4; ++m) {
                const int row = u.pm * BM + ai * HALF + wr * 64 + m * 16 + fr;
                const float rs = rstd[row];
                f32x4 v[2][2];
#pragma unroll
                for (int bj = 0; bj < 2; ++bj)
#pragma unroll
                    for (int n = 0; n < 2; ++n) v[bj][n] = acc[ai][bj][m][n] * rs;
                if (type <= 1) {
#pragma unroll
                    for (int bj = 0; bj < 2; ++bj)
#pragma unroll
                        for (int n = 0; n < 2; ++n) { v[bj][n].x = gelu_fast(v[bj][n].x); v[bj][n].y = gelu_fast(v[bj][n].y); v[bj][n].z = gelu_fast(v[bj][n].z); v[bj][n].w = gelu_fast(v[bj][n].w); }
                } else if (type == 2) {
                    float ss = 0.f;
#pragma unroll
                    for (int bj = 0; bj < 2; ++bj)
#pragma unroll
                        for (int n = 0; n < 2; ++n) ss += (v[bj][n].x * v[bj][n].x + v[bj][n].y * v[bj][n].y) + (v[bj][n].z * v[bj][n].z + v[bj][n].w * v[bj][n].w);
                    ss += __shfl_xor(ss, 16); ss += __shfl_xor(ss, 32);
                    const float hr = 1.0f / sqrtf(ss * (1.0f / 64.0f) + EPS);
#pragma unroll
                    for (int bj = 0; bj < 2; ++bj)
#pragma unroll
                        for (int n = 0; n < 2; ++n) v[bj][n] = v[bj][n] * g[bj][n] * hr;
                    f32x4 o[2];
#pragma unroll
                    for (int n = 0; n < 2; ++n) { o[n].x = __shfl_xor(v[0][n].x, 16); o[n].y = __shfl_xor(v[0][n].y, 16); o[n].z = __shfl_xor(v[0][n].z, 16); o[n].w = __shfl_xor(v[0][n].w, 16); }
                    if (fq < 2) {
                        const f32x4 c0 = *(const f32x4*)(cs + (size_t)row * 8), c1 = *(const f32x4*)(cs + (size_t)row * 8 + 4);
                        f32x4 s0 = *(const f32x4*)(sn + (size_t)row * 8), s1 = *(const f32x4*)(sn + (size_t)row * 8 + 4);
                        if (fq == 0) { s0 = -s0; s1 = -s1; }
                        v[0][0] = v[0][0] * c0 + o[0] * s0; v[0][1] = v[0][1] * c1 + o[1] * s1;
                    }
                }
                bf16* rowp = Y + (size_t)row * LD + colb;
                float vsum = 0.f;
#pragma unroll
                for (int bj = 0; bj < 2; ++bj) {
                    u32x4 w; w.x = pk2(v[bj][0].x, v[bj][0].y); w.y = pk2(v[bj][0].z, v[bj][0].w); w.z = pk2(v[bj][1].x, v[bj][1].y); w.w = pk2(v[bj][1].z, v[bj][1].w);
                    *(u32x4*)(rowp + 32 * bj) = w;
                    if (LAYER == 0 && type == 1) {
#pragma unroll
                        for (int q = 0; q < 4; ++q) { const float lo = __uint_as_float(w[q] << 16), hi = __uint_as_float(w[q] & 0xffff0000u); vsum += lo * lo + hi * hi; }
                    }
                }
                if (LAYER == 0 && type == 1) { vsum += __shfl_xor(vsum, 16); vsum += __shfl_xor(vsum, 32); if (fq == 0) vss[(size_t)row * 8 + (u.pn - 2) * 4 + wc] = vsum; }
            }
    }
};
template <bool RESID_BF16> struct EpiRes {
    static constexpr bool PERM = true;
    const float* xres; bf16* hbuf;
    __device__ __forceinline__ void operator()(const f32x4 (&acc)[2][2][4][2], const Unit& u, int wr, int wc, int fr, int fq) const {
        const int row0 = u.pm * BM + wr * 64 + fr, col0 = u.pn * BM + wc * 32 + 8 * fq;
#pragma unroll
        for (int ai = 0; ai < 2; ++ai)
#pragma unroll
            for (int m = 0; m < 4; ++m) { const size_t off = (size_t)(row0 + ai * HALF + m * 16) * D + col0;
#pragma unroll
                for (int bj = 0; bj < 2; ++bj) {
                    f32x4 r0, r1;
                    if (RESID_BF16) { const u32x4 t = *(const u32x4*)(hbuf + off + bj * HALF);
                        r0 = (f32x4){__uint_as_float(t.x << 16), __uint_as_float(t.x & 0xffff0000u), __uint_as_float(t.y << 16), __uint_as_float(t.y & 0xffff0000u)};
                        r1 = (f32x4){__uint_as_float(t.z << 16), __uint_as_float(t.z & 0xffff0000u), __uint_as_float(t.w << 16), __uint_as_float(t.w & 0xffff0000u)}; }
                    else { r0 = *(const f32x4*)(xres + off + bj * HALF); r1 = *(const f32x4*)(xres + off + bj * HALF + 4); }
                    const f32x4 v0 = r0 + acc[ai][bj][m][0], v1 = r1 + acc[ai][bj][m][1];
                    u32x4 w; w.x = pk2(v0.x, v0.y); w.y = pk2(v0.z, v0.w); w.z = pk2(v1.x, v1.y); w.w = pk2(v1.z, v1.w);
                    *(u32x4*)(hbuf + off + bj * HALF) = w; } }
    }
};
__device__ __forceinline__ void moe_setup(volatile LAS int* tb, const int* counts) {
    const int t = opaque_tid();
    if (t < 64) {
        const int nt = (t < NE) ? ((counts[t] + 255) >> 8) : 0; int incl = nt;
#pragma unroll
        for (int o = 1; o < 32; o <<= 1) { const int v = __shfl_up(incl, o); if ((t & 63) >= o) incl += v; }
        if (t < NE) tb[t] = incl - nt;
        if (t == NE - 1) tb[NE] = incl;
    }
    __syncthreads();
}
template <int NPN, bool GATHER> struct MoeOrder {
    const volatile LAS int* tb; const int* counts; const int* elist; int K, brows; const bf16* Bt;
    int tile0, ntiles, cc, nwg;
    __device__ __forceinline__ bool next(int i, Unit& u) const {
        const int L = i * nwg + cc; if (L >= ntiles * NPN) return false;
        const int tile = tile0 + L / NPN; int e = 0, te = 0;
#pragma unroll 1
        for (int x = 1; x < NE; ++x) { const int v = __builtin_amdgcn_readfirstlane(tb[x]); if (v <= tile) { e = x; te = v; } }
        u.e = e; u.pm = tile - te; u.pn = L % NPN; u.aux = tile; return true;
    }
    __device__ __forceinline__ unsigned a_rowoff(const Unit& u, int r) const {
        if (GATHER) { const int pos = u.pm * BM + r; const int tok = pos < counts[u.e] ? (elist[u.e * T + pos] >> 1) : 0; return (unsigned)tok * (unsigned)(K * 2); }
        return (unsigned)(u.aux * BM + r) * (unsigned)(K * 2);
    }
    __device__ __forceinline__ const char* b_base(const Unit& u) const { return (const char*)Bt + ((size_t)u.e * brows + (size_t)u.pn * BM) * K * 2; }
};
struct EpiGU {
    static constexpr bool PERM = true;
    bf16* hid; const float* rstd; const int* counts; const int* elist;
    __device__ __forceinline__ void operator()(const f32x4 (&acc)[2][2][4][2], const Unit& u, int wr, int wc, int fr, int fq) const {
        const int cnt = counts[u.e];
        int tok[8]; float rsv[8];
#pragma unroll
        for (int i = 0; i < 8; ++i) { const int pos = u.pm * BM + (i >> 2) * HALF + wr * 64 + (i & 3) * 16 + fr; tok[i] = (pos < cnt) ? (elist[u.e * T + pos] >> 1) : -1; }
#pragma unroll
        for (int i = 0; i < 8; ++i) rsv[i] = (tok[i] >= 0) ? rstd[tok[i]] : 0.f;
#pragma unroll
        for (int ai = 0; ai < 2; ++ai)
#pragma unroll
            for (int m = 0; m < 4; ++m) {
                const int r = ai * HALF + wr * 64 + m * 16 + fr;
                if (tok[ai * 4 + m] >= 0) {
                    const float rs = rsv[ai * 4 + m];
                    u32x4 w;
#pragma unroll
                    for (int n = 0; n < 2; ++n) {
                        const f32x4 g = acc[ai][0][m][n] * rs, up = acc[ai][1][m][n] * rs; f32x4 h;
                        h.x = g.x * __builtin_amdgcn_rcpf(1.0f + __builtin_amdgcn_exp2f(-1.4426950408889634f * g.x)) * up.x;
                        h.y = g.y * __builtin_amdgcn_rcpf(1.0f + __builtin_amdgcn_exp2f(-1.4426950408889634f * g.y)) * up.y;
                        h.z = g.z * __builtin_amdgcn_rcpf(1.0f + __builtin_amdgcn_exp2f(-1.4426950408889634f * g.z)) * up.z;
                        h.w = g.w * __builtin_amdgcn_rcpf(1.0f + __builtin_amdgcn_exp2f(-1.4426950408889634f * g.w)) * up.w;
                        if (n == 0) { w.x = pk2(h.x, h.y); w.y = pk2(h.z, h.w); } else { w.z = pk2(h.x, h.y); w.w = pk2(h.z, h.w); }
                    }
                    *(u32x4*)(hid + (size_t)(u.aux * BM + r) * FF + u.pn * HALF + wc * 32 + 8 * fq) = w;
                }
            }
    }
};
struct EpiDown {
    static constexpr bool PERM = true;
    bf16* yp; const float* gw; const int* counts; const int* elist;
    __device__ __forceinline__ void operator()(const f32x4 (&acc)[2][2][4][2], const Unit& u, int wr, int wc, int fr, int fq) const {
        const int cnt = counts[u.e];
        int pr[8]; float gv8[8];
#pragma unroll
        for (int i = 0; i < 8; ++i) { const int pos = u.pm * BM + (i >> 2) * HALF + wr * 64 + (i & 3) * 16 + fr; pr[i] = (pos < cnt) ? elist[u.e * T + pos] : -1; }
#pragma unroll
        for (int i = 0; i < 8; ++i) gv8[i] = (pr[i] >= 0) ? gw[pr[i]] : 0.f;
#pragma unroll
        for (int ai = 0; ai < 2; ++ai)
#pragma unroll
            for (int m = 0; m < 4; ++m) {
                const int pair = pr[ai * 4 + m];
                if (pair >= 0) {
                    const float gv = gv8[ai * 4 + m];
                    bf16* rowp = yp + (size_t)pair * D + u.pn * BM + wc * 32 + 8 * fq;
#pragma unroll
                    for (int bj = 0; bj < 2; ++bj) { const f32x4 v0 = acc[ai][bj][m][0] * gv, v1 = acc[ai][bj][m][1] * gv;
                        u32x4 w; w.x = pk2(v0.x, v0.y); w.y = pk2(v0.z, v0.w); w.z = pk2(v1.x, v1.y); w.w = pk2(v1.z, v1.w);
                        *(u32x4*)(rowp + bj * HALF) = w; }
                }
            }
    }
};
}


typedef float f32x16 __attribute__((ext_vector_type(16)));
typedef short s16x4 __attribute__((ext_vector_type(4)));
__device__ __forceinline__ int crow(int r, int hi) { return (r & 3) + 8 * (r >> 2) + 4 * hi; }
__device__ __forceinline__ s16x4 lds_tr(LAS unsigned char* p) { return __builtin_bit_cast(s16x4, __builtin_amdgcn_ds_read_tr16_b64_v4i16((LAS s16x4*)p)); }
__device__ __forceinline__ float xhalf_max(float v) { auto rr = __builtin_amdgcn_permlane32_swap(__float_as_uint(v), __float_as_uint(v), false, false); return fmaxf(__uint_as_float(rr[0]), __uint_as_float(rr[1])); }
__device__ __forceinline__ float xhalf_sum(float v) { auto rr = __builtin_amdgcn_permlane32_swap(__float_as_uint(v), __float_as_uint(v), false, false); return __uint_as_float(rr[0]) + __uint_as_float(rr[1]); }
constexpr int VST_PITCH = 144, VST_BYTES = 32 * VST_PITCH;
template <int W> __device__ __forceinline__ void attn_tile(const bf16* __restrict__ Qp, size_t qstride, const bf16* __restrict__ Kp, const bf16* __restrict__ Vp, size_t kvstride, int q0,
                                                          LAS unsigned char* vst, float sinkv, f32x16 (&o)[2], float& m_out, float& l_out, const int lane) {
    const int r32 = lane & 31, hi = lane >> 5;
    bf16x8 qf[4], kf[3][4], kg[2][4];
#pragma unroll
    for (int d0 = 0; d0 < 4; ++d0) qf[d0] = *(const bf16x8*)(Qp + (size_t)r32 * qstride + d0 * 16 + hi * 8);
#pragma unroll
    for (int c = 0; c < 3; ++c) {
        int ki = q0 - 128 + 32 * c + r32; ki = ki < 0 ? 0 : ki;
        const bf16* kp = Kp + (size_t)ki * kvstride + hi * 8;
#pragma unroll
        for (int d0 = 0; d0 < 4; ++d0) kf[c][d0] = *(const bf16x8*)(kp + d0 * 16);
    }
    __builtin_amdgcn_sched_barrier(0);
    f32x16 sc[5];
#pragma unroll
    for (int c = 0; c < 2; ++c) {
        f32x16 acc = {};
#pragma unroll
        for (int d0 = 0; d0 < 4; ++d0) acc = __builtin_amdgcn_mfma_f32_32x32x16_bf16(kf[c][d0], qf[d0], acc, 0, 0, 0);
        sc[c] = acc;
    }
#pragma unroll
    for (int c = 3; c < 5; ++c) {
        const int ki = q0 - 128 + 32 * c + r32;
        const bf16* kp = Kp + (size_t)ki * kvstride + hi * 8;
#pragma unroll
        for (int d0 = 0; d0 < 4; ++d0) kg[c - 3][d0] = *(const bf16x8*)(kp + d0 * 16);
    }
    __builtin_amdgcn_sched_barrier(0);
    {
        f32x16 acc = {};
#pragma unroll
        for (int d0 = 0; d0 < 4; ++d0) acc = __builtin_amdgcn_mfma_f32_32x32x16_bf16(kf[2][d0], qf[d0], acc, 0, 0, 0);
        sc[2] = acc;
    }
#pragma unroll
    for (int c = 3; c < 5; ++c) {
        f32x16 acc = {};
#pragma unroll
        for (int d0 = 0; d0 < 4; ++d0) acc = __builtin_amdgcn_mfma_f32_32x32x16_bf16(kg[c - 3][d0], qf[d0], acc, 0, 0, 0);
        sc[c] = acc;
    }
    const int vr = lane >> 1, vcb = (lane & 1) * 64;
    u32x4 vreg[5][4];
#pragma unroll
    for (int c = 0; c < 3; ++c) {
        int ki = q0 - 128 + 32 * c + vr; ki = ki < 0 ? 0 : ki;
        const u32x4* vp = (const u32x4*)((const unsigned char*)(Vp + (size_t)ki * kvstride) + vcb);
#pragma unroll
        for (int i = 0; i < 4; ++i) vreg[c][i] = vp[i];
    }
    __builtin_amdgcn_sched_barrier(0);
    float m = sinkv;
#pragma unroll
    for (int c = 0; c < 5; ++c)
#pragma unroll
        for (int r = 0; r < 16; ++r) {
            const int kk = 32 * c + crow(r, hi), rel = 128 + r32 - kk;
            const bool ok = (rel >= 0) && (rel <= W) && (q0 - 128 + kk >= 0);
            const float v = ok ? sc[c][r] : -INFINITY; sc[c][r] = v; m = fmaxf(m, v);
        }
    m = xhalf_max(m);
    float l = 0.f;
    bf16x8 pb[5][2];
#pragma unroll
    for (int c = 0; c < 5; ++c)
#pragma unroll
        for (int ks = 0; ks < 2; ++ks) {
            u32x4 w;
#pragma unroll
            for (int j = 0; j < 4; ++j) { const float p0 = __builtin_amdgcn_exp2f(sc[c][8 * ks + 2 * j] - m), p1 = __builtin_amdgcn_exp2f(sc[c][8 * ks + 2 * j + 1] - m); l += p0 + p1; w[j] = pk2(p0, p1); }
            pb[c][ks] = __builtin_bit_cast(bf16x8, w);
        }
    l = xhalf_sum(l);
    l += __builtin_amdgcn_exp2f(sinkv - m);
    o[0] = (f32x16){}; o[1] = (f32x16){};
    __builtin_amdgcn_sched_barrier(0);
#pragma unroll
    for (int c = 3; c < 5; ++c) {
        int ki = q0 - 128 + 32 * c + vr; ki = ki < 0 ? 0 : ki;
        const u32x4* vp = (const u32x4*)((const unsigned char*)(Vp + (size_t)ki * kvstride) + vcb);
#pragma unroll
        for (int i = 0; i < 4; ++i) vreg[c][i] = vp[i];
    }
    __builtin_amdgcn_sched_barrier(0);
    const int g16 = lane >> 4, q4 = (lane & 15) >> 2, p4 = lane & 3;
    LAS unsigned char* trbase = vst + (4 * (g16 >> 1) + q4) * VST_PITCH + (16 * (g16 & 1) + 4 * p4) * 2;
#pragma unroll
    for (int c = 0; c < 5; ++c) {
        LAS u32x4* wp = (LAS u32x4*)(vst + (c & 1) * VST_BYTES + vr * VST_PITCH + vcb);
#pragma unroll
        for (int i = 0; i < 4; ++i) wp[i] = vreg[c][i];
#pragma unroll
        for (int ks = 0; ks < 2; ++ks)
#pragma unroll
            for (int db = 0; db < 2; ++db) {
                LAS unsigned char* tp = trbase + (c & 1) * VST_BYTES + (16 * ks) * VST_PITCH + db * 64;
                const s16x4 lo = lds_tr(tp), hi4 = lds_tr(tp + 8 * VST_PITCH);
                const bf16x8 vf = {lo[0], lo[1], lo[2], lo[3], hi4[0], hi4[1], hi4[2], hi4[3]};
                o[db] = __builtin_amdgcn_mfma_f32_32x32x16_bf16(vf, pb[c][ks], o[db], 0, 0, 0);
            }
    }
    m_out = m; l_out = l;
}
constexpr int SWA_SLOT = 32 * VST_PITCH, SWA_K = 0, SWA_V = 5 * SWA_SLOT;
template <int W> __device__ __forceinline__ void attn_tile_ring(const bf16x8 (&qf)[4], LAS unsigned char* ring, int slot0, int q0, float sinkv, f32x16 (&o)[2], float& m_out, float& l_out, const int lane) {
    const int r32 = lane & 31, hi = lane >> 5;
    f32x16 sc[5];
#pragma unroll
    for (int c = 0; c < 5; ++c) {
        int sl = slot0 + c; sl = sl >= 5 ? sl - 5 : sl;
        const LAS unsigned char* kp = ring + SWA_K + sl * SWA_SLOT + r32 * VST_PITCH + 16 * hi;
        f32x16 acc = {};
#pragma unroll
        for (int d0 = 0; d0 < 4; ++d0) { const bf16x8 kf = *(const LAS bf16x8*)(kp + 32 * d0); acc = __builtin_amdgcn_mfma_f32_32x32x16_bf16(kf, qf[d0], acc, 0, 0, 0); }
        sc[c] = acc;
    }
    float m = sinkv;
#pragma unroll
    for (int c = 0; c < 5; ++c)
#pragma unroll
        for (int r = 0; r < 16; ++r) {
            const int kk = 32 * c + crow(r, hi), rel = 128 + r32 - kk;
            const bool ok = (rel >= 0) && (rel <= W) && (q0 - 128 + kk >= 0);
            const float v = ok ? sc[c][r] : -INFINITY; sc[c][r] = v; m = fmaxf(m, v);
        }
    m = xhalf_max(m);
    float l = 0.f;
    bf16x8 pb[5][2];
#pragma unroll
    for (int c = 0; c < 5; ++c)
#pragma unroll
        for (int ks = 0; ks < 2; ++ks) {
            u32x4 w;
#pragma unroll
            for (int j = 0; j < 4; ++j) { const float p0 = __builtin_amdgcn_exp2f(sc[c][8 * ks + 2 * j] - m), p1 = __builtin_amdgcn_exp2f(sc[c][8 * ks + 2 * j + 1] - m); l += p0 + p1; w[j] = pk2(p0, p1); }
            pb[c][ks] = __builtin_bit_cast(bf16x8, w);
        }
    l = xhalf_sum(l);
    l += __builtin_amdgcn_exp2f(sinkv - m);
    o[0] = (f32x16){}; o[1] = (f32x16){};
    const int g16 = lane >> 4, q4 = (lane & 15) >> 2, p4 = lane & 3;
    LAS unsigned char* trbase = ring + SWA_V + (4 * (g16 >> 1) + q4) * VST_PITCH + (16 * (g16 & 1) + 4 * p4) * 2;
#pragma unroll
    for (int c = 0; c < 5; ++c) {
        int sl = slot0 + c; sl = sl >= 5 ? sl - 5 : sl;
#pragma unroll
        for (int ks = 0; ks < 2; ++ks)
#pragma unroll
            for (int db = 0; db < 2; ++db) {
                LAS unsigned char* tp = trbase + sl * SWA_SLOT + (16 * ks) * VST_PITCH + db * 64;
                const s16x4 lo = lds_tr(tp), hi4 = lds_tr(tp + 8 * VST_PITCH);
                const bf16x8 vf = {lo[0], lo[1], lo[2], lo[3], hi4[0], hi4[1], hi4[2], hi4[3]};
                o[db] = __builtin_amdgcn_mfma_f32_32x32x16_bf16(vf, pb[c][ks], o[db], 0, 0, 0);
            }
    }
    m_out = m; l_out = l;
}
__device__ __forceinline__ void f_swa(LAS unsigned char* lds, const bf16* __restrict__ Y1, const float* __restrict__ sinks, bf16* __restrict__ O) {
    const int tid = opaque_tid(), lane = tid & 63, wave = __builtin_amdgcn_readfirstlane(tid >> 6), r32 = lane & 31, hi = lane >> 5;
    const int st = tid >> 8, srow = (tid >> 3) & 31, sp = tid & 7;
    for (int grp = vcu_id(); grp < 256; grp += gridDim.x) {
        const int kvh = grp & 1, qg = (grp >> 1) & 63, b = grp >> 7, hq = kvh * 8 + wave;
        const bf16* rowb = Y1 + (size_t)b * SEQ * IN1;
        const bf16* kvcol = rowb + 1024 + 128 * st + kvh * 64 + 8 * sp;
        LAS unsigned char* stdst = lds + (st ? SWA_V : SWA_K) + srow * VST_PITCH + 16 * sp;
        const float sinkv = sinks[hq] * 1.4426950408889634f;
        __syncthreads();
        const int qt0 = qg * 4;
        u32x4 pre[5];
#pragma unroll
        for (int c = 0; c < 5; ++c) { int row = (qt0 - 4 + c) * 32 + srow; row = row < 0 ? 0 : row; pre[c] = *(const u32x4*)(kvcol + (size_t)row * IN1); }
#pragma unroll
        for (int c = 0; c < 5; ++c) *(LAS u32x4*)(stdst + c * SWA_SLOT) = pre[c];
        bf16x8 qf[4];
        { const bf16* qp = rowb + (size_t)(qt0 * 32 + r32) * IN1 + hq * 64 + 8 * hi;
#pragma unroll
          for (int d0 = 0; d0 < 4; ++d0) qf[d0] = *(const bf16x8*)(qp + 16 * d0); }
        __syncthreads();
#pragma unroll 1
        for (int j = 0; j < 4; ++j) {
            const int q0 = (qt0 + j) * 32, slot0 = j % 5;
            u32x4 nxt; bf16x8 qn[4];
            if (j < 3) {
                nxt = *(const u32x4*)(kvcol + (size_t)((qt0 + j + 1) * 32 + srow) * IN1);
                const bf16* qp = rowb + (size_t)(q0 + 32 + r32) * IN1 + hq * 64 + 8 * hi;
#pragma unroll
                for (int d0 = 0; d0 < 4; ++d0) qn[d0] = *(const bf16x8*)(qp + 16 * d0);
            }
            f32x16 o[2]; float m, l;
            attn_tile_ring<127>(qf, lds, slot0, q0, sinkv, o, m, l, lane);
            const float inv = 1.0f / l;
            bf16* op = O + (size_t)(b * SEQ + q0 + r32) * D + hq * 64 + 4 * hi;
#pragma unroll
            for (int db = 0; db < 2; ++db)
#pragma unroll
                for (int g4 = 0; g4 < 4; ++g4) { u32x2 w; w.x = pk2(o[db][4 * g4] * inv, o[db][4 * g4 + 1] * inv); w.y = pk2(o[db][4 * g4 + 2] * inv, o[db][4 * g4 + 3] * inv);
                    *(u32x2*)(op + 32 * db + 8 * g4) = w; }
            if (j < 3) {
                __syncthreads();
                *(LAS u32x4*)(stdst + (j % 5) * SWA_SLOT) = nxt;
#pragma unroll
                for (int d0 = 0; d0 < 4; ++d0) qf[d0] = qn[d0];
                __syncthreads();
            }
        }
    }
    __syncthreads();
}
constexpr int OB_OFF = 73728, OB_PITCH = 136, LSE_OFF = 143360;
__device__ __forceinline__ void dil_item(LAS unsigned char* lds, const bf16* __restrict__ Y, bf16* __restrict__ A2, int item) {
    const int tid = opaque_tid(), lane = tid & 63, wave = __builtin_amdgcn_readfirstlane(tid >> 6), r32 = lane & 31, hi = lane >> 5;
    const int blk = item & 15, j = (item >> 4) & 3, b = item >> 6;
    LAS unsigned char* vst = lds + wave * (2 * VST_BYTES);
    LAS unsigned char* OB = lds + OB_OFF; LAS float* LSE = (LAS float*)(lds + LSE_OFF);
    const bf16* rowb = Y + (size_t)b * SEQ * IN0;
#pragma unroll 1
    for (int pass = 0; pass < 3; ++pass) {
        const int g = 2 - pass, dil = 1 << (2 * g), tpc = 16 >> (2 * g), h = g * 4 + j;
#pragma unroll 1
        for (int tt = 0; tt < 2; ++tt) {
            const int tile = wave + 8 * tt, r = tile / tpc, ti = tile % tpc;
            const int q0 = (blk * 512) / dil + 32 * ti;
            const bf16* base = rowb + (size_t)r * IN0;
            f32x16 o[2]; float m, l;
            attn_tile<128>(base + (size_t)q0 * dil * IN0 + 1024 + h * 64, (size_t)dil * IN0, base + 1792 + h * 64, base + 2560 + h * 64, (size_t)dil * IN0, q0, vst, -INFINITY, o, m, l, lane);
            const int tok = r + dil * (32 * ti + r32);
            float lse = m + __builtin_amdgcn_logf(l);
            float wb = 1.0f / l, wa = 0.f;
            if (pass > 0) {
                const float lp = LSE[tok], M = fmaxf(lp, lse);
                const float ea = __builtin_amdgcn_exp2f(lp - M), eb = __builtin_amdgcn_exp2f(lse - M), inv = 1.0f / (ea + eb);
                wa = ea * inv; wb = eb * inv / l; lse = M + __builtin_amdgcn_logf(ea + eb);
            }
            LAS unsigned char* ob = OB + tok * OB_PITCH + 8 * hi;
            bf16* gp = A2 + (size_t)(b * SEQ + blk * 512 + tok) * OUT0K + 512 + j * 64 + 4 * hi;
#pragma unroll
            for (int db = 0; db < 2; ++db)
#pragma unroll
                for (int g4 = 0; g4 < 4; ++g4) {
                    float v0 = o[db][4 * g4] * wb, v1 = o[db][4 * g4 + 1] * wb, v2 = o[db][4 * g4 + 2] * wb, v3 = o[db][4 * g4 + 3] * wb;
                    LAS u32x2* q = (LAS u32x2*)(ob + 64 * db + 16 * g4);
                    if (pass > 0) { const u32x2 pw = *q;
                        v0 += wa * __uint_as_float(pw.x << 16); v1 += wa * __uint_as_float(pw.x & 0xffff0000u); v2 += wa * __uint_as_float(pw.y << 16); v3 += wa * __uint_as_float(pw.y & 0xffff0000u); }
                    u32x2 w; w.x = pk2(v0, v1); w.y = pk2(v2, v3);
                    if (pass < 2) *q = w; else *(u32x2*)(gp + 32 * db + 8 * g4) = w;
                }
            if (pass < 2) LSE[tok] = lse;
        }
        __syncthreads();
    }
}
__device__ __forceinline__ void sgu_item(LAS unsigned char* lds, const bf16* __restrict__ Y, const float* __restrict__ vss, const float* __restrict__ gn, const float* __restrict__ w, const float* __restrict__ bs,
                                         bf16* __restrict__ A2, int cidx) {
    const int tid = opaque_tid(), lane = tid & 63, g = __builtin_amdgcn_readfirstlane(tid >> 6), r32 = lane & 31, hi = lane >> 5;
    LAS unsigned char* vst = lds + g * (2 * VST_BYTES);
    const int r0 = cidx * 128;
    f32x16 acc[4][2];
#pragma unroll
    for (int a = 0; a < 4; ++a) { acc[a][0] = (f32x16){}; acc[a][1] = (f32x16){}; }
    const int vr = lane >> 1, vhalf = lane & 1;
    const int g16 = lane >> 4, q4 = (lane & 15) >> 2, p4 = lane & 3;
    LAS unsigned char* trbase = vst + (4 * (g16 >> 1) + q4) * VST_PITCH + (16 * (g16 & 1) + 4 * p4) * 2;
#pragma unroll
    for (int sc = 0; sc < 4; ++sc) {
        LAS unsigned char* buf = vst + (sc & 1) * VST_BYTES;
        {
            const int row = r0 + 32 * sc + vr;
            const f32x4 p0 = *(const f32x4*)(vss + (size_t)row * 8), p1 = *(const f32x4*)(vss + (size_t)row * 8 + 4);
            const float rs = 1.0f / sqrtf(((p0.x + p0.y) + (p0.z + p0.w) + (p1.x + p1.y) + (p1.z + p1.w)) * (1.0f / 512.0f) + EPS);
            const u32x4* vp = (const u32x4*)(Y + (size_t)row * IN0 + 512 + g * 64 + 32 * vhalf);
            const float* gp = gn + g * 64 + 32 * vhalf;
            LAS u32x4* wp = (LAS u32x4*)(buf + vr * VST_PITCH + 64 * vhalf);
#pragma unroll
            for (int i = 0; i < 4; ++i) { const u32x4 t = vp[i]; const f32x4 ga = *(const f32x4*)(gp + 8 * i), gb = *(const f32x4*)(gp + 8 * i + 4); u32x4 o;
                o.x = pk2(__uint_as_float(t.x << 16) * rs * ga.x, __uint_as_float(t.x & 0xffff0000u) * rs * ga.y);
                o.y = pk2(__uint_as_float(t.y << 16) * rs * ga.z, __uint_as_float(t.y & 0xffff0000u) * rs * ga.w);
                o.z = pk2(__uint_as_float(t.z << 16) * rs * gb.x, __uint_as_float(t.z & 0xffff0000u) * rs * gb.y);
                o.w = pk2(__uint_as_float(t.w << 16) * rs * gb.z, __uint_as_float(t.w & 0xffff0000u) * rs * gb.w);
                wp[i] = o; }
        }
#pragma unroll
        for (int ks = 0; ks < 2; ++ks) {
            bf16x8 vf[2];
#pragma unroll
            for (int db = 0; db < 2; ++db) { LAS unsigned char* tp = trbase + (sc & 1) * VST_BYTES + (16 * ks) * VST_PITCH + db * 64;
                const s16x4 lo = lds_tr(tp), hi4 = lds_tr(tp + 8 * VST_PITCH); vf[db] = (bf16x8){lo[0], lo[1], lo[2], lo[3], hi4[0], hi4[1], hi4[2], hi4[3]}; }
#pragma unroll
            for (int tt = sc; tt < 4; ++tt) {
                const int t = 32 * tt + r32, s0 = 32 * sc + 16 * ks + 4 * hi;
                const float* wrow = w + ((size_t)(g * 128 + t) * 128 + s0);
                f32x4 w0 = *(const f32x4*)wrow, w1 = *(const f32x4*)(wrow + 8);
                if (tt == sc) {
                    w0.x = (s0 + 0 <= t) ? w0.x : 0.f; w0.y = (s0 + 1 <= t) ? w0.y : 0.f; w0.z = (s0 + 2 <= t) ? w0.z : 0.f; w0.w = (s0 + 3 <= t) ? w0.w : 0.f;
                    w1.x = (s0 + 8 <= t) ? w1.x : 0.f; w1.y = (s0 + 9 <= t) ? w1.y : 0.f; w1.z = (s0 + 10 <= t) ? w1.z : 0.f; w1.w = (s0 + 11 <= t) ? w1.w : 0.f;
                }
                const unsigned a0 = pk2(w0.x, w0.y), a1 = pk2(w0.z, w0.w), a2 = pk2(w1.x, w1.y), a3 = pk2(w1.z, w1.w);
                const bf16x8 wf = {(short)(a0 & 0xffffu), (short)(a0 >> 16), (short)(a1 & 0xffffu), (short)(a1 >> 16), (short)(a2 & 0xffffu), (short)(a2 >> 16), (short)(a3 & 0xffffu), (short)(a3 >> 16)};
#pragma unroll
                for (int db = 0; db < 2; ++db) acc[tt][db] = __builtin_amdgcn_mfma_f32_32x32x16_bf16(vf[db], wf, acc[tt][db], 0, 0, 0);
            }
        }
    }
#pragma unroll
    for (int tt = 0; tt < 4; ++tt) {
        const int t = 32 * tt + r32; const float bias = bs[g * 128 + t];
        const size_t row = (size_t)(r0 + t);
        const bf16* up = Y + row * IN0 + g * 64 + 4 * hi; bf16* op = A2 + row * OUT0K + g * 64 + 4 * hi;
#pragma unroll
        for (int db = 0; db < 2; ++db)
#pragma unroll
            for (int g4 = 0; g4 < 4; ++g4) { const u32x2 uu = *(const u32x2*)(up + 32 * db + 8 * g4); u32x2 o;
                o.x = pk2((acc[tt][db][4 * g4] + bias) * __uint_as_float(uu.x << 16), (acc[tt][db][4 * g4 + 1] + bias) * __uint_as_float(uu.x & 0xffff0000u));
                o.y = pk2((acc[tt][db][4 * g4 + 2] + bias) * __uint_as_float(uu.y << 16), (acc[tt][db][4 * g4 + 3] + bias) * __uint_as_float(uu.y & 0xffff0000u));
                *(u32x2*)(op + 32 * db + 8 * g4) = o; }
    }
}
__device__ __forceinline__ void f_mixers0(LAS unsigned char* lds, const bf16* Y, const float* vss, const float* gn, const float* w, const float* bs, bf16* A2) {
    for (int id = vcu_id(); id < 256; id += gridDim.x) {
        if (id < 128) dil_item(lds, Y, A2, id);
        else sgu_item(lds, Y, vss, gn, w, bs, A2, id - 128);
    }
}


__device__ __forceinline__ void build_router_tab(const float* __restrict__ gf, const float* __restrict__ wrg, const float* __restrict__ wre, bf16* __restrict__ RT) {
    for (int i = blockIdx.x * NTHR + opaque_tid(); i < 64 * D; i += gridDim.x * NTHR) {
        const int n = i >> 10, k = i & 1023; float v = 0.f;
        if (n < 36) v = ((n < 4) ? wrg[k * 4 + n] : wre[((size_t)((n - 4) >> 3) * D + k) * 8 + ((n - 4) & 7)]) * gf[k];
        const bf16 hi = f2bf(v); RT[i] = hi; RT[64 * D + i] = f2bf(v - bf2f(hi));
    }
}
__device__ __forceinline__ void f_router(LAS unsigned char* lds, const bf16* __restrict__ hb, const bf16* __restrict__ RT, const float* __restrict__ brg, const float* __restrict__ bre,
                                         float* __restrict__ rstd, int* __restrict__ eid, float* __restrict__ gw, int* counts, int* __restrict__ elist) {
    const int tid = opaque_tid(), lane = tid & 63, r32 = lane & 31, hi = lane >> 5, wv = __builtin_amdgcn_readfirstlane(tid >> 6);
    LAS float* Ps = (LAS float*)lds;
    LAS float* Qs = Ps + 8 * 64 * 37;
    LAS float* Ls = Qs + 8 * 2 * 64;
    LAS float* Ss = Ls + 64 * 37;
    LAS int* Hc = (LAS int*)(Ss + 64);
    for (int tile = vcu_id(); tile < T / 64; tile += gridDim.x) {
        const int r0 = tile * 64;
        if (tid < 64) Hc[tid] = 0;
        f32x16 acc[2][2];
#pragma unroll
        for (int x = 0; x < 2; ++x) { acc[x][0] = (f32x16){}; acc[x][1] = (f32x16){}; }
        float ssq[2] = {0.f, 0.f};
#pragma unroll 4
        for (int ks = 0; ks < 8; ++ks) {
            const int k0 = wv * 128 + ks * 16 + 8 * hi;
            bf16x8 ah[2], bh[2], bl[2];
#pragma unroll
            for (int rb = 0; rb < 2; ++rb) {
                const u32x4 t = *(const u32x4*)(hb + (size_t)(r0 + 32 * rb + r32) * D + k0);
                ah[rb] = __builtin_bit_cast(bf16x8, t);
#pragma unroll
                for (int q = 0; q < 4; ++q) { const float lo = __uint_as_float(t[q] << 16), hf = __uint_as_float(t[q] & 0xffff0000u); ssq[rb] += lo * lo + hf * hf; }
            }
#pragma unroll
            for (int cb = 0; cb < 2; ++cb) { const bf16* wp = RT + (size_t)(32 * cb + r32) * D + k0; bh[cb] = *(const bf16x8*)wp; bl[cb] = *(const bf16x8*)(wp + 64 * D); }
#pragma unroll
            for (int rb = 0; rb < 2; ++rb)
#pragma unroll
                for (int cb = 0; cb < 2; ++cb) {
                    acc[rb][cb] = __builtin_amdgcn_mfma_f32_32x32x16_bf16(ah[rb], bh[cb], acc[rb][cb], 0, 0, 0);
                    acc[rb][cb] = __builtin_amdgcn_mfma_f32_32x32x16_bf16(ah[rb], bl[cb], acc[rb][cb], 0, 0, 0);
                }
        }
#pragma unroll
        for (int rb = 0; rb < 2; ++rb) {
#pragma unroll
            for (int r = 0; r < 16; ++r) { LAS float* pr = Ps + (wv * 64 + 32 * rb + crow(r, hi)) * 37; pr[r32] = acc[rb][0][r]; if (r32 < 4) pr[32 + r32] = acc[rb][1][r]; }
            Qs[(wv * 2 + hi) * 64 + 32 * rb + r32] = ssq[rb];
        }
        __syncthreads();
        {
            const int row = tid & 63, cg = tid >> 6;
#pragma unroll
            for (int c = 0; c < 5; ++c) { const int n = cg * 5 + c; if (n < 36) { float v = 0.f;
#pragma unroll
                for (int w8 = 0; w8 < 8; ++w8) v += Ps[(w8 * 64 + row) * 37 + n]; Ls[row * 37 + n] = v; } }
            if (cg == 7) { float v = 0.f;
#pragma unroll
                for (int w8 = 0; w8 < 16; ++w8) v += Qs[w8 * 64 + row]; Ss[row] = v; }
        }
        __syncthreads();
        int e0 = 0, e1 = 0, k0r = 0, k1r = 0;
        if (tid < 64) {
            const int r = r0 + tid; const LAS float* L = Ls + tid * 37;
            const float rs = 1.0f / sqrtf(Ss[tid] * (1.0f / D) + EPS);
            float lg[4];
#pragma unroll
            for (int g = 0; g < 4; ++g) lg[g] = L[g] * rs + brg[g];
            int gi = 0; float lmax = lg[0];
#pragma unroll
            for (int g = 1; g < 4; ++g) if (lg[g] > lmax) { lmax = lg[g]; gi = g; }
            float zs = 0.f;
#pragma unroll
            for (int g = 0; g < 4; ++g) zs += expf(lg[g] - lmax);
            const float ptop = 1.0f / zs;
            int i0 = 0, i1 = -1; float l0 = -INFINITY, l1 = -INFINITY;
#pragma unroll 1
            for (int e = 0; e < 8; ++e) { const float v = L[4 + gi * 8 + e] * rs + bre[gi * 8 + e];
                if (v > l0) { l1 = l0; i1 = i0; l0 = v; i0 = e; } else if (v > l1) { l1 = v; i1 = e; } }
            const float r1 = expf(l1 - l0); const float g0 = ptop / (1.0f + r1), g1 = ptop * r1 / (1.0f + r1);
            rstd[r] = rs; e0 = gi * 8 + i0; e1 = gi * 8 + i1;
            eid[r * 2] = e0; eid[r * 2 + 1] = e1; gw[r * 2] = g0; gw[r * 2 + 1] = g1;
            k0r = __hip_atomic_fetch_add(&Hc[e0], 1, __ATOMIC_RELAXED, __HIP_MEMORY_SCOPE_WORKGROUP); k1r = __hip_atomic_fetch_add(&Hc[e1], 1, __ATOMIC_RELAXED, __HIP_MEMORY_SCOPE_WORKGROUP);
        }
        __syncthreads();
        if (tid < 32) { const int c = Hc[tid]; Hc[32 + tid] = c ? atomicAdd(&counts[tid], c) : 0; }
        __syncthreads();
        if (tid < 64) { const int r = r0 + tid; elist[e0 * T + Hc[32 + e0] + k0r] = r * 2; elist[e1 * T + Hc[32 + e1] + k1r] = r * 2 + 1; }
        __syncthreads();
    }
}
__device__ __forceinline__ void f_combine(bf16* hb, const bf16* __restrict__ yp, float* __restrict__ rstd, float* __restrict__ outf) {
    const int tid = opaque_tid(), lane = tid & 63;
    const int gwv = blockIdx.x * NWAVES + (tid >> 6), nw = gridDim.x * NWAVES;
    for (int r = gwv; r < T; r += nw) {
        u32x4* hr = (u32x4*)(hb + (size_t)r * D) + lane;
        const u32x4* y0 = (const u32x4*)(yp + (size_t)(2 * r) * D) + lane; const u32x4* y1 = (const u32x4*)(yp + (size_t)(2 * r + 1) * D) + lane;
        float s = 0.f;
#pragma unroll
        for (int j = 0; j < 2; ++j) { const u32x4 hv = hr[64 * j], a = y0[64 * j], b = y1[64 * j]; float v[8];
#pragma unroll
            for (int q = 0; q < 4; ++q) { v[2 * q] = __uint_as_float(hv[q] << 16) + __uint_as_float(a[q] << 16) + __uint_as_float(b[q] << 16);
                v[2 * q + 1] = __uint_as_float(hv[q] & 0xffff0000u) + __uint_as_float(a[q] & 0xffff0000u) + __uint_as_float(b[q] & 0xffff0000u); }
            if (outf) { f32x4* o = (f32x4*)(outf + (size_t)r * D + 512 * j) + 2 * lane; o[0] = (f32x4){v[0], v[1], v[2], v[3]}; o[1] = (f32x4){v[4], v[5], v[6], v[7]}; }
            else { u32x4 w; w.x = pk2(v[0], v[1]); w.y = pk2(v[2], v[3]); w.z = pk2(v[4], v[5]); w.w = pk2(v[6], v[7]); hr[64 * j] = w;
#pragma unroll
                for (int q = 0; q < 4; ++q) { const float lo = __uint_as_float(w[q] << 16), hf = __uint_as_float(w[q] & 0xffff0000u); s += lo * lo + hf * hf; } } }
        if (rstd) { s = wave_sum(s); if (lane == 0) rstd[r] = 1.0f / sqrtf(s * (1.0f / D) + EPS); }
    }
}

__device__ __forceinline__ float gelu_tanh(float x) { const float u = 0.7978845608028654f * (x + 0.044715f * x * x * x); return 0.5f * x * (1.0f + tanhf(u)); }
__device__ void n_rowprep(const float* __restrict__ src, bf16* __restrict__ hb, float* __restrict__ rstd) {
    const int gw = blockIdx.x * NWAVES + (threadIdx.x >> 6), lane = threadIdx.x & 63, nw = gridDim.x * NWAVES;
    for (int r = gw; r < T; r += nw) {
        const float* p = src + (size_t)r * D; float s = 0.f;
        for (int c = lane; c < D; c += 64) { float v = p[c]; s += v * v; hb[(size_t)r * D + c] = f2bf(v); }
        for (int o = 1; o < 64; o <<= 1) s += __shfl_xor(s, o);
        if (lane == 0) rstd[r] = 1.0f / sqrtf(s * (1.0f / D) + EPS);
    }
}
__device__ __forceinline__ void n_rope_tab(const int* __restrict__ pos, float* __restrict__ cs, float* __restrict__ sn) {
    for (int i = blockIdx.x * NTHR + opaque_tid(); i < T * 8; i += gridDim.x * NTHR) {
        const int t = i >> 3, f = i & 7;
        const float inv = powf(500000.0f, -(float)f / 8.0f);
        const float ang = (float)pos[t] * inv;
        const double rev = (double)ang * 0.15915494309189535;
        const float fr = (float)(rev - floor(rev));
        cs[i] = __builtin_amdgcn_cosf(fr); sn[i] = __builtin_amdgcn_sinf(fr);
    }
}
__device__ void n_gemm(LAS unsigned char* lds, const bf16* __restrict__ A, int lda, const float* __restrict__ W, int M, int N, int K, const float* __restrict__ gain,
                       const float* __restrict__ rowscale, const float* resid, bf16* __restrict__ outb, int ldo, float* outf) {
    const int half = threadIdx.x >> 8, tid = threadIdx.x & 255;
    LAS float* sA = (LAS float*)(lds + half * 16384); LAS float* sB = sA + 16 * 65;
    const int tx = tid & 15, ty = tid >> 4, ntn = N / 64, nvb = ntn * (M / 64);
    for (int it = 0; (it * (int)gridDim.x) * 2 < nvb; ++it) {
        const int vb = (it * gridDim.x + blockIdx.x) * 2 + half; const bool ok = vb < nvb;
        const int m0 = ok ? (vb / ntn) * 64 : 0, n0 = ok ? (vb % ntn) * 64 : 0;
        float acc[4][4] = {};
        for (int k0 = 0; k0 < K; k0 += 16) {
            for (int e = tid; e < 1024; e += 256) { const int r = e >> 4, c = e & 15; sA[c * 65 + r] = bf2f(A[(size_t)(m0 + r) * lda + k0 + c]); }
            for (int e = tid; e < 1024; e += 256) { const int r = e >> 6, c = e & 63; sB[r * 65 + c] = W[(size_t)(k0 + r) * N + n0 + c] * (gain ? gain[k0 + r] : 1.0f); }
            __syncthreads();
#pragma unroll
            for (int k = 0; k < 16; ++k) {
                float a[4], b[4];
#pragma unroll
                for (int i = 0; i < 4; ++i) { a[i] = sA[k * 65 + ty * 4 + i]; b[i] = sB[k * 65 + tx * 4 + i]; }
#pragma unroll
                for (int i = 0; i < 4; ++i)
#pragma unroll
                    for (int j = 0; j < 4; ++j) acc[i][j] += a[i] * b[j];
            }
            __syncthreads();
        }
        if (ok)
#pragma unroll
        for (int i = 0; i < 4; ++i)
#pragma unroll
            for (int j = 0; j < 4; ++j) {
            const int m = m0 + ty * 4 + i, n = n0 + tx * 4 + j; float v = acc[i][j];
            if (rowscale) v *= rowscale[m];
            if (resid) v += resid[(size_t)m * N + n];
            if (outb) outb[(size_t)m * ldo + n] = f2bf(v);
            if (outf) outf[(size_t)m * N + n] = v;
        }
    }
}
__device__ void n_post(LAS unsigned char* lds, bf16* __restrict__ Y, int ld, int ngelu, int nq, int nk, float* __restrict__ vss, const float* __restrict__ cs, const float* __restrict__ sn,
                       const float* __restrict__ qn, const float* __restrict__ kn) {
    const int half = threadIdx.x >> 8, tid = threadIdx.x & 255;
    LAS float* red = (LAS float*)(lds + half * 16384); LAS float* hv = red + 256;
    const int nqk = (nq + nk) * 64;
    for (int it = 0; it * (int)gridDim.x * 2 < T; ++it) {
        const int t = (it * gridDim.x + blockIdx.x) * 2 + half; bf16* y = Y + (size_t)t * ld;
        if (ngelu) {
            float ss = 0.f;
            for (int c = tid; c < ngelu; c += 256) { float g = gelu_tanh(bf2f(y[c])); bf16 gb = f2bf(g); y[c] = gb; if (c >= ngelu / 2) { float gr = bf2f(gb); ss += gr * gr; } }
            red[tid] = ss; __syncthreads();
            for (int o = 128; o > 0; o >>= 1) { if (tid < o) red[tid] += red[tid + o]; __syncthreads(); }
            if (tid < 8) vss[(size_t)t * 8 + tid] = (tid == 0) ? red[0] : 0.f;
        }
        __syncthreads();
        for (int c = tid; c < nqk; c += 256) hv[c] = bf2f(y[ngelu + c]);
        __syncthreads();
        for (int c = tid; c < nqk; c += 256) {
            const int h = c >> 6, d = c & 63; const bool isq = h < nq; const float* gn = isq ? qn : kn;
            float s = 0.f; for (int j = 0; j < 64; ++j) { float v = hv[h * 64 + j]; s += v * v; }
            const float rs = 1.0f / sqrtf(s * (1.0f / 64.0f) + EPS);
            float o = hv[c] * rs * gn[d];
            if (d < 16) { const int f = d & 7; const float co = cs[t * 8 + f], si = sn[t * 8 + f];
                const float x1 = hv[h * 64 + f] * rs * gn[f], x2 = hv[h * 64 + 8 + f] * rs * gn[8 + f];
                o = (d < 8) ? (x1 * co - x2 * si) : (x2 * co + x1 * si); }
            if (isq) o *= QSCALE;
            y[ngelu + c] = f2bf(o);
        }
        __syncthreads();
    }
}
__device__ void n_sgu(const bf16* __restrict__ Y, const float* __restrict__ vss, const float* __restrict__ gn, const float* __restrict__ w, const float* __restrict__ bs, bf16* __restrict__ A2) {
    for (int i = blockIdx.x * NTHR + threadIdx.x; i < T * 512; i += gridDim.x * NTHR) {
        const int row = i >> 9, ch = i & 511, g = ch >> 6, tt = row & 127, r0 = row - tt;
        float acc = 0.f;
        for (int s = 0; s <= tt; ++s) {
            const int rs_ = r0 + s; float sum = 0.f; for (int j = 0; j < 8; ++j) sum += vss[(size_t)rs_ * 8 + j];
            const float rstd = 1.0f / sqrtf(sum * (1.0f / 512.0f) + EPS);
            const float v = bf2f(f2bf(bf2f(Y[(size_t)rs_ * IN0 + 512 + ch]) * rstd * gn[ch]));
            acc += bf2f(f2bf(w[(g * 128 + tt) * 128 + s])) * v;
        }
        acc += bs[g * 128 + tt];
        A2[(size_t)row * OUT0K + ch] = f2bf(bf2f(Y[(size_t)row * IN0 + ch]) * acc);
    }
}
__device__ void n_dil(const bf16* __restrict__ Y, bf16* __restrict__ A2) {
    const int d = threadIdx.x & 63;
    for (int i = blockIdx.x * NWAVES + (threadIdx.x >> 6); i < T * 4; i += gridDim.x * NWAVES) {
        const int row = i >> 2, j = i & 3, b = row / SEQ, t = row % SEQ;
        float m = -INFINITY, l = 0.f, o = 0.f;
        for (int g = 0; g < 3; ++g) {
            const int dil = (g == 0) ? 1 : (g == 1 ? 4 : 16), h = g * 4 + j;
            const float q = bf2f(Y[(size_t)row * IN0 + 1024 + h * 64 + d]);
            for (int n = 0; n <= 128; ++n) {
                const int tk = t - n * dil; if (tk < 0) break;
                const size_t kr = (size_t)(b * SEQ + tk) * IN0;
                float s = q * bf2f(Y[kr + 1792 + h * 64 + d]);
                for (int x = 1; x < 64; x <<= 1) s += __shfl_xor(s, x);
                const float mn = fmaxf(m, s), a = exp2f(m - mn), p = exp2f(s - mn);
                l = l * a + p; o = o * a + p * bf2f(Y[kr + 2560 + h * 64 + d]);
                m = mn;
            }
        }
        A2[(size_t)row * OUT0K + 512 + j * 64 + d] = f2bf(o / l);
    }
}
__device__ void n_swa(const bf16* __restrict__ Y, const float* __restrict__ sinks, bf16* __restrict__ O) {
    const int d = threadIdx.x & 63;
    for (int i = blockIdx.x * NWAVES + (threadIdx.x >> 6); i < T * 16; i += gridDim.x * NWAVES) {
        const int row = i >> 4, h = i & 15, kvh = h >> 3, b = row / SEQ, t = row % SEQ;
        const float q = bf2f(Y[(size_t)row * IN1 + h * 64 + d]);
        float m = sinks[h] * 1.4426950408889634f, l = 1.0f, o = 0.f;
        for (int n = 0; n < 128; ++n) {
            const int tk = t - n; if (tk < 0) break;
            const size_t kr = (size_t)(b * SEQ + tk) * IN1;
            float s = q * bf2f(Y[kr + 1024 + kvh * 64 + d]);
            for (int x = 1; x < 64; x <<= 1) s += __shfl_xor(s, x);
            const float mn = fmaxf(m, s), a = exp2f(m - mn), p = exp2f(s - mn);
            l = l * a + p; o = o * a + p * bf2f(Y[kr + 1152 + kvh * 64 + d]);
            m = mn;
        }
        O[(size_t)row * D + h * 64 + d] = f2bf(o / l);
    }
}
__device__ void n_router(const float* h, const float* __restrict__ gf, const float* __restrict__ wrg, const float* __restrict__ brg, const float* __restrict__ wre, const float* __restrict__ bre,
                         bf16* __restrict__ hb, float* __restrict__ rstd, int* __restrict__ eid, float* __restrict__ gw, int* counts, int* __restrict__ elist) {
    const int gwv = blockIdx.x * NWAVES + (threadIdx.x >> 6), lane = threadIdx.x & 63, nw = gridDim.x * NWAVES;
    for (int r = gwv; r < T; r += nw) {
        const float* p = h + (size_t)r * D; float s = 0.f;
        for (int c = lane; c < D; c += 64) { float v = p[c]; s += v * v; hb[(size_t)r * D + c] = f2bf(v); }
        for (int o = 1; o < 64; o <<= 1) s += __shfl_xor(s, o);
        const float rs = 1.0f / sqrtf(s * (1.0f / D) + EPS);
        float lg[4] = {0.f, 0.f, 0.f, 0.f};
        for (int c = lane; c < D; c += 64) { const float xn = p[c] * rs * gf[c];
#pragma unroll
            for (int g = 0; g < 4; ++g) lg[g] += xn * wrg[c * 4 + g]; }
#pragma unroll
        for (int g = 0; g < 4; ++g) { for (int o = 1; o < 64; o <<= 1) lg[g] += __shfl_xor(lg[g], o); lg[g] += brg[g]; }
        int gi = 0; float lmax = lg[0];
#pragma unroll
        for (int g = 1; g < 4; ++g) if (lg[g] > lmax) { lmax = lg[g]; gi = g; }
        float zs = 0.f;
#pragma unroll
        for (int g = 0; g < 4; ++g) zs += expf(lg[g] - lmax);
        const float ptop = 1.0f / zs;
        float le[8] = {0.f, 0.f, 0.f, 0.f, 0.f, 0.f, 0.f, 0.f};
        for (int c = lane; c < D; c += 64) { const float xn = p[c] * rs * gf[c];
#pragma unroll
            for (int e = 0; e < 8; ++e) le[e] += xn * wre[((size_t)gi * D + c) * 8 + e]; }
#pragma unroll
        for (int e = 0; e < 8; ++e) { for (int o = 1; o < 64; o <<= 1) le[e] += __shfl_xor(le[e], o); le[e] += bre[gi * 8 + e]; }
        int i0 = 0; float l0 = le[0];
#pragma unroll
        for (int e = 1; e < 8; ++e) if (le[e] > l0) { l0 = le[e]; i0 = e; }
        int i1 = -1; float l1 = -INFINITY;
#pragma unroll
        for (int e = 0; e < 8; ++e) if (e != i0 && le[e] > l1) { l1 = le[e]; i1 = e; }
        const float r1 = expf(l1 - l0); const float g0 = ptop / (1.0f + r1), g1 = ptop * r1 / (1.0f + r1);
        if (lane == 0) {
            rstd[r] = rs; const int e0 = gi * 8 + i0, e1 = gi * 8 + i1;
            eid[r * 2] = e0; eid[r * 2 + 1] = e1; gw[r * 2] = g0; gw[r * 2 + 1] = g1;
            const int p0 = atomicAdd(&counts[e0], 1); elist[e0 * T + p0] = r * 2;
            const int p1 = atomicAdd(&counts[e1], 1); elist[e1 * T + p1] = r * 2 + 1;
        }
    }
}
__device__ __forceinline__ bool slot_lookup(const int* counts, int slot, int& e, int& pos) {
    int base = 0; e = -1; pos = 0; bool ok = false;
    for (int x = 0; x < NE; ++x) { const int c = counts[x], pc = (c + 255) & ~255; if (e < 0 && slot < base + pc) { e = x; pos = slot - base; ok = pos < c; } base += pc; }
    if (e < 0) e = 0;
    return ok;
}
__device__ void n_gateup(LAS unsigned char* lds, const bf16* __restrict__ hb, const float* __restrict__ rstd, const float* __restrict__ gf, const float* __restrict__ wg, const float* __restrict__ wu,
                         const int* counts, const int* elist, bf16* __restrict__ hid) {
    const int half = threadIdx.x >> 8, j = threadIdx.x & 255; LAS float* xs = (LAS float*)(lds + half * 16384);
    for (int it = 0; it * (int)gridDim.x * 2 < SLOT_CAP; ++it) {
        const int slot = (it * gridDim.x + blockIdx.x) * 2 + half; int e, pos; const bool ok = slot_lookup(counts, slot, e, pos);
        const int pair = ok ? elist[e * T + pos] : 0, t = pair >> 1;
        for (int c = j; c < D; c += 256) xs[c] = bf2f(hb[(size_t)t * D + c]);
        __syncthreads();
        if (ok) {
            float g = 0.f, u = 0.f; const float* pg = wg + (size_t)e * D * FF + j; const float* pu = wu + (size_t)e * D * FF + j;
            for (int k = 0; k < D; ++k) { const float gk = gf[k]; g += xs[k] * bf2f(f2bf(pg[(size_t)k * FF] * gk)); u += xs[k] * bf2f(f2bf(pu[(size_t)k * FF] * gk)); }
            const float rs = rstd[t]; g *= rs; u *= rs;
            hid[(size_t)slot * FF + j] = f2bf(g / (1.0f + expf(-g)) * u);
        }
        __syncthreads();
    }
}
__device__ void n_down(LAS unsigned char* lds, const bf16* __restrict__ hid, const float* __restrict__ wd, const float* __restrict__ gw, const int* counts, const int* elist, bf16* __restrict__ yp) {
    const int half = threadIdx.x >> 8, tid = threadIdx.x & 255; LAS float* hs = (LAS float*)(lds + half * 16384);
    for (int it = 0; it * (int)gridDim.x * 2 < SLOT_CAP; ++it) {
        const int slot = (it * gridDim.x + blockIdx.x) * 2 + half; int e, pos; const bool ok = slot_lookup(counts, slot, e, pos);
        const int pair = ok ? elist[e * T + pos] : 0;
        hs[tid] = ok ? bf2f(hid[(size_t)slot * FF + tid]) : 0.f;
        __syncthreads();
        if (ok) {
            const float gwt = gw[pair];
            for (int n = tid; n < D; n += 256) {
                float a = 0.f; const float* p = wd + (size_t)e * FF * D + n;
                for (int k = 0; k < FF; ++k) a += hs[k] * bf2f(f2bf(p[(size_t)k * D]));
                yp[(size_t)pair * D + n] = f2bf(a * gwt);
            }
        }
        __syncthreads();
    }
}
__device__ void n_combine(float* h, const bf16* __restrict__ yp, bf16* __restrict__ hb, float* __restrict__ rstd) {
    const int gwv = blockIdx.x * NWAVES + (threadIdx.x >> 6), lane = threadIdx.x & 63, nw = gridDim.x * NWAVES;
    for (int r = gwv; r < T; r += nw) {
        float s = 0.f;
        for (int c = lane; c < D; c += 64) { const float v = h[(size_t)r * D + c] + bf2f(yp[(size_t)(2 * r) * D + c]) + bf2f(yp[(size_t)(2 * r + 1) * D + c]);
            h[(size_t)r * D + c] = v; s += v * v; if (hb) hb[(size_t)r * D + c] = f2bf(v); }
        for (int o = 1; o < 64; o <<= 1) s += __shfl_xor(s, o);
        if (rstd && lane == 0) rstd[r] = 1.0f / sqrtf(s * (1.0f / D) + EPS);
    }
}


__device__ __forceinline__ void cvt_experts(const float* wg, const float* wu, const float* wd, const float* gain, bf16* WGU, bf16* WDT, LAS unsigned char* lds, int wg0, int nwg) {
    const int tid = opaque_tid(), lane = tid & 63, wave = tid >> 6;
    LAS float* scr = (LAS float*)(lds + wave * 9216);
    const int gwv = ((int)blockIdx.x - wg0) * NWAVES + wave, NGW = nwg * NWAVES;
    const CvtFam g0{wg, WGU, gain, D, FF, NE, 2, 512};
    const CvtFam g1{wu, WGU, gain, D, FF, NE, 3, 512};
    const CvtFam g2{wd, WDT, nullptr, FF, D, NE, 0, 1024};
    const int n0 = cvt_fam_items(g0), n1 = n0 + cvt_fam_items(g1), n2 = n1 + cvt_fam_items(g2);
    cvt_run(g0, g1, g2, g2, n0, n1, n2, n2, gwv, NGW, scr, lane);
}

enum { A_X, A_POS, A_NMIX, A_NFFN, A_WINE, A_WOUTE, A_SGUN, A_SGUW, A_SGUB, A_QND, A_KND, A_WINO, A_WOUTO, A_QNS, A_KNS, A_SINK, A_WRG, A_BRG, A_WRE, A_BRE, A_WG, A_WU, A_WD, A_OUT, A_WS, A_N };
struct Args { const void* p[A_N]; };
constexpr int LDS_ARGS = LDS_MISC + 1024;
__device__ __forceinline__ const void* ldarg(int i) {
    volatile LAS unsigned* q = (volatile LAS unsigned*)((LAS unsigned char*)0 + LDS_ARGS) + 2 * i;
    const unsigned lo = __builtin_amdgcn_readfirstlane(q[0]), hi = __builtin_amdgcn_readfirstlane(q[1]);
    typedef const __attribute__((address_space(1))) void* gptr_t;
    return (const void*)(gptr_t)(((unsigned long long)hi << 32) | lo);
}
#define ARGF(i) ((const float*)ldarg(i))
#define WSP(T, off) ((T*)((unsigned char*)ldarg(A_WS) + (off)))
__device__ __forceinline__ void grid_bar() {
    XcdBarrier b; b.bar = WSP(unsigned, WS_CTL) + CW_BAR; b.x = xb_xcc_id(); b.st = (volatile LAS unsigned*)((LAS unsigned char*)0 + LDS_MISC) + 8;
    xcd_barrier(b);
}
__device__ __forceinline__ void moe_phases(LAS unsigned char* lds, int cofs) {
    volatile LAS int* tb = (volatile LAS int*)(lds + LDS_MISC + 256);
    pg8::moe_setup(tb, WSP(int, WS_CTL) + cofs);
    const int G = gridDim.x, c = vcu_id();
    const int NT = __builtin_amdgcn_readfirstlane(tb[NE]), S1 = NT < G / 2 ? NT : G / 2, R = NT - S1;
    const int nGUw = (2 * R < G / 2) ? 2 * R : G / 2;
#pragma unroll 1
    for (int step = 0; step < 3; ++step) {
        int gt0 = 0, gnt = 0, gc = 0, gn = 1, dt0 = 0, dnt = 0, dc = 0, dn = 1; bool doG = false, doD = false;
        if (step == 0) { gt0 = 0; gnt = S1; gc = c; gn = G; doG = true; }
        else if (step == 1) { if (c < nGUw) { gt0 = S1; gnt = R; gc = c; gn = nGUw; doG = true; } else { dt0 = 0; dnt = S1; dc = c - nGUw; dn = G - nGUw; doD = true; } }
        else { dt0 = S1; dnt = R; dc = c; dn = G; doD = true; }
        if (step == 2 && R == 0) break;
        if (doG) {
            pg8::MoeOrder<2, true> S{tb, WSP(int, WS_CTL) + cofs, WSP(int, WS_ELIST), D, 512, WSP(bf16, WS_WGU), gt0, gnt, gc, gn};
            pg8::EpiGU E{WSP(bf16, WS_HID), WSP(float, WS_RSTD), WSP(int, WS_CTL) + cofs, WSP(int, WS_ELIST)};
            pg8::gemm_phase<pg8::EpiGU, pg8::MoeOrder<2, true>, true>(lds, WSP(bf16, WS_HB), D, S, E);
        }
        if (doD) {
            pg8::MoeOrder<4, false> S{tb, WSP(int, WS_CTL) + cofs, WSP(int, WS_ELIST), FF, 1024, WSP(bf16, WS_WD), dt0, dnt, dc, dn};
            pg8::EpiDown E{WSP(bf16, WS_YP), WSP(float, WS_GW), WSP(int, WS_CTL) + cofs, WSP(int, WS_ELIST)};
            pg8::gemm_phase<pg8::EpiDown, pg8::MoeOrder<4, false>, true>(lds, WSP(bf16, WS_HID), FF, S, E);
        }
        if (step < 2 && !(step == 1 && R == 0)) grid_bar();
    }
}
__global__ void __launch_bounds__(NTHR, 2) mega_fwd(Args a) {
    extern __shared__ __attribute__((aligned(16))) unsigned char lds_raw[];
    LAS unsigned char* lds = (LAS unsigned char*)lds_raw;
    {
        volatile LAS unsigned* MISC = (volatile LAS unsigned*)(lds + LDS_MISC);
        if (threadIdx.x < 64) MISC[threadIdx.x] = 0u;
        if (threadIdx.x < 2 * A_N) ((volatile LAS unsigned*)(lds + LDS_ARGS))[threadIdx.x] = ((const unsigned*)&a)[threadIdx.x];
        if ((threadIdx.x & 63) == 0) ((volatile LAS int*)(lds + LDS_WID))[hw_wave_slot()] = threadIdx.x >> 6;
        __syncthreads();
        (void)xcd_barrier_post(WSP(unsigned, WS_CTL) + CW_BAR, MISC + 8);
    }
    constexpr size_t SN_OFF = WS_CS + (size_t)T * 8 * 4;
    constexpr size_t EW1 = (size_t)NE * D * FF;
#define PH(k) (pass_ == 0 || (k) <= STOP_AT)
#pragma unroll 1
    for (int pass_ = 0; pass_ < NPASS; ++pass_) {
    const int cb = 128 * pass_;
    if (pass_) grid_bar();
    if (PH(0)) {
        {
            const int tid = opaque_tid(), lane = tid & 63, wave = tid >> 6;
            LAS float* scr = (LAS float*)(lds + wave * 9216);
            const int gwv = blockIdx.x * NWAVES + wave, NGW = gridDim.x * NWAVES;
            const CvtFam f0{ARGF(A_WINE), WSP(bf16, WS_WIN0), ARGF(A_NMIX), D, IN0, 1, 1, 0};
            const CvtFam f1{ARGF(A_WOUTE), WSP(bf16, WS_WOUT0), nullptr, OUT0K, D, 1, 0, 0};
            const CvtFam f2{ARGF(A_WINO), WSP(bf16, WS_WIN1), ARGF(A_NMIX) + D, D, IN1, 1, 1, 0};
            const CvtFam f3{ARGF(A_WOUTO), WSP(bf16, WS_WOUT1), nullptr, D, D, 1, 0, 0};
            const int n0 = cvt_fam_items(f0), n1 = n0 + cvt_fam_items(f1), n2 = n1 + cvt_fam_items(f2), n3 = n2 + cvt_fam_items(f3);
            cvt_run(f0, f1, f2, f3, n0, n1, n2, n3, gwv, NGW, scr, lane);
        }
        build_router_tab(ARGF(A_NFFN), ARGF(A_WRG), ARGF(A_WRE), WSP(bf16, WS_RTAB));
        build_router_tab(ARGF(A_NFFN) + D, ARGF(A_WRG) + D * 4, ARGF(A_WRE) + (size_t)4 * D * 8, WSP(bf16, WS_RTAB) + 2 * 64 * D);
        n_rope_tab((const int*)ldarg(A_POS), WSP(float, WS_CS), WSP(float, SN_OFF));
        f_rowprep(ARGF(A_X), WSP(bf16, WS_HB), WSP(float, WS_RSTD));
        grid_bar();
    }
    if (PH(1)) {
        const int G_ = gridDim.x, ng = (G_ == 256) ? 208 : G_;
        if ((int)blockIdx.x < ng) {
            pg8::DenseOrder S; S.init(T, IN0, D, WSP(bf16, WS_WIN0), ng, blockIdx.x);
            pg8::EpiIn<0> E{WSP(bf16, WS_Y), WSP(float, WS_RSTD), WSP(float, WS_VSS), WSP(float, WS_CS), WSP(float, SN_OFF), ARGF(A_QND), ARGF(A_KND)};
            pg8::gemm_phase<pg8::EpiIn<0>, pg8::DenseOrder, true>(lds, WSP(bf16, WS_HB), D, S, E);
        }
        if (ng == G_) cvt_experts(ARGF(A_WG), ARGF(A_WU), ARGF(A_WD), ARGF(A_NFFN), WSP(bf16, WS_WGU), WSP(bf16, WS_WD), lds, 0, G_);
        else if ((int)blockIdx.x >= ng) cvt_experts(ARGF(A_WG), ARGF(A_WU), ARGF(A_WD), ARGF(A_NFFN), WSP(bf16, WS_WGU), WSP(bf16, WS_WD), lds, ng, G_ - ng);
        grid_bar();
    }
    if (PH(2)) {
        f_mixers0(lds, WSP(bf16, WS_Y), WSP(float, WS_VSS), ARGF(A_SGUN), ARGF(A_SGUW), ARGF(A_SGUB), WSP(bf16, WS_A2));
        grid_bar();
    }
    if (PH(3)) {
        pg8::DenseOrder S; S.init(T, D, OUT0K, WSP(bf16, WS_WOUT0), gridDim.x, blockIdx.x);
        pg8::EpiRes<true> E{nullptr, WSP(bf16, WS_HB)};
        pg8::gemm_phase<pg8::EpiRes<true>, pg8::DenseOrder, true>(lds, WSP(bf16, WS_A2), OUT0K, S, E);
        grid_bar();
    }
    if (PH(4)) {
        f_router(lds, WSP(bf16, WS_HB), WSP(bf16, WS_RTAB), ARGF(A_BRG), ARGF(A_BRE), WSP(float, WS_RSTD), WSP(int, WS_EID), WSP(float, WS_GW), WSP(int, WS_CTL) + cb, WSP(int, WS_ELIST));
        grid_bar();
    }
    if (PH(5)) { moe_phases(lds, cb); grid_bar(); }
    if (PH(6)) {
        f_combine(WSP(bf16, WS_HB), WSP(bf16, WS_YP), WSP(float, WS_RSTD), nullptr);
        grid_bar();
    }
    if (PH(7)) {
        const int G_ = gridDim.x, ng = (G_ == 256) ? 160 : G_;
        if ((int)blockIdx.x < ng) {
            pg8::DenseOrder S; S.init(T, IN1, D, WSP(bf16, WS_WIN1), ng, blockIdx.x);
            pg8::EpiIn<1> E{WSP(bf16, WS_Y1), WSP(float, WS_RSTD), nullptr, WSP(float, WS_CS), WSP(float, SN_OFF), ARGF(A_QNS), ARGF(A_KNS)};
            pg8::gemm_phase<pg8::EpiIn<1>, pg8::DenseOrder, true>(lds, WSP(bf16, WS_HB), D, S, E);
        }
        if (ng == G_) cvt_experts(ARGF(A_WG) + EW1, ARGF(A_WU) + EW1, ARGF(A_WD) + EW1, ARGF(A_NFFN) + D, WSP(bf16, WS_WGU), WSP(bf16, WS_WD), lds, 0, G_);
        else if ((int)blockIdx.x >= ng) cvt_experts(ARGF(A_WG) + EW1, ARGF(A_WU) + EW1, ARGF(A_WD) + EW1, ARGF(A_NFFN) + D, WSP(bf16, WS_WGU), WSP(bf16, WS_WD), lds, ng, G_ - ng);
        grid_bar();
    }
    if (PH(8)) {
        f_swa(lds, WSP(bf16, WS_Y1), ARGF(A_SINK), WSP(bf16, WS_A2));
        grid_bar();
    }
    if (PH(9)) {
        pg8::DenseOrder S; S.init(T, D, D, WSP(bf16, WS_WOUT1), gridDim.x, blockIdx.x);
        pg8::EpiRes<true> E{nullptr, WSP(bf16, WS_HB)};
        pg8::gemm_phase<pg8::EpiRes<true>, pg8::DenseOrder, true>(lds, WSP(bf16, WS_A2), D, S, E);
        grid_bar();
    }
    if (PH(10)) {
        f_router(lds, WSP(bf16, WS_HB), WSP(bf16, WS_RTAB) + 2 * 64 * D, ARGF(A_BRG) + 4, ARGF(A_BRE) + 32, WSP(float, WS_RSTD), WSP(int, WS_EID), WSP(float, WS_GW), WSP(int, WS_CTL) + 64 + cb, WSP(int, WS_ELIST));
        grid_bar();
    }
    if (PH(11)) { moe_phases(lds, 64 + cb); grid_bar(); }
    if (PH(12)) f_combine(WSP(bf16, WS_HB), WSP(bf16, WS_YP), nullptr, (float*)ldarg(A_OUT));
    }
#undef PH
}

extern "C" void kernel_launch(void* const* d_in, const int* in_sizes, int n_in, void* d_out, int out_size, void* d_ws, size_t ws_size, hipStream_t stream) {
    static int grid = 0;
    if (grid == 0) {
        int dev = 0, cus = 0, per_cu = 0;
        if (hipGetDevice(&dev) != hipSuccess || hipDeviceGetAttribute(&cus, hipDeviceAttributeMultiprocessorCount, dev) != hipSuccess) { fprintf(stderr, "kernel_launch: device query failed\n"); grid = -1; return; }
        if (hipFuncSetAttribute((const void*)mega_fwd, hipFuncAttributeMaxDynamicSharedMemorySize, LDS_BYTES) != hipSuccess) { fprintf(stderr, "kernel_launch: hipFuncSetAttribute failed\n"); grid = -1; return; }
        if (hipOccupancyMaxActiveBlocksPerMultiprocessor(&per_cu, (const void*)mega_fwd, NTHR, LDS_BYTES) != hipSuccess || per_cu < 1) { fprintf(stderr, "kernel_launch: occupancy query says %d blocks/CU\n", per_cu); grid = -1; (void)hipGetLastError(); return; }
        grid = cus;
    }
    if (grid < 0) return;
    if (hipMemsetAsync((char*)d_ws + WS_CTL, 0, MiB, stream) != hipSuccess) return;
    Args a{};
    for (int i = 0; i < 23; ++i) a.p[i] = d_in[i];
    a.p[A_OUT] = d_out; a.p[A_WS] = d_ws;
    hipLaunchKernelGGL(mega_fwd, dim3(grid), dim3(NTHR), LDS_BYTES, stream, a);
}
```
